# Optimizing an MI355X kernel written in HIP

```python
import jax, jax.numpy as jnp
from jax import lax
import numpy as np

D_MODEL = 1024
BATCH = 16
SEQ = 256
DEPTH = 2
DEC_BATCH = 8
DEC_SEQ = 4096
PAST_LEN = 256

GRID_W = 64
DH = 64
NA_HEADS = 8
NA_WIN_ROWS = 8
NA_WIN_COLS = 16
GQA_HEADS = 8
GQA_KV = 2
SWA_HEADS = 8
SWA_KV = 2
SWA_WINDOW = 128
ML_HEADS = 4
ML_DH = 128
ML_CHUNK = 64
Q_BLOCK = 128
N_BRANCH = 4
BRANCH_W = NA_HEADS * DH
D_FF = ((8 * D_MODEL // 3 + 255) // 256) * 256
ROPE_BASE = 10000.0
NORM_EPS = 1e-6
IN_SIZES = (NA_HEADS * DH, NA_HEADS * DH, NA_HEADS * DH,
            GQA_HEADS * DH, GQA_KV * DH, GQA_KV * DH,
            SWA_HEADS * DH, SWA_KV * DH, SWA_KV * DH,
            ML_HEADS * ML_DH, ML_HEADS * ML_DH, ML_HEADS * ML_DH, ML_HEADS * ML_DH, 2 * ML_HEADS, 2 * ML_HEADS,
            N_BRANCH * D_MODEL)
N_IN = sum(IN_SIZES)
ML_F_OFFSET = sum(IN_SIZES[:14])

kernel_name = 'hybrid_flow_trunk_step'


def _rmsnorm(x, g):
    xf = x.astype(jnp.float32)
    y = xf * lax.rsqrt(jnp.mean(xf * xf, axis=-1, keepdims=True) + NORM_EPS)
    return (y * g.astype(jnp.float32)).astype(x.dtype)


def _headnorm(t, g):
    return t * lax.rsqrt(jnp.mean(t * t, axis=-1, keepdims=True) + NORM_EPS) * g.astype(jnp.float32)


def _adaln(cvec, w, b):
    m = jnp.dot(jax.nn.silu(cvec), w) + b
    return jnp.split(m, 6, axis=-1)


def _modulate(xn, shift, scale):
    return xn * (1 + scale) + shift


def _rope2d(x):
    S = x.shape[1]
    half = DH // 2
    t = jnp.arange(S)
    freqs = ROPE_BASE ** (-jnp.arange(0, half, 2, dtype=jnp.float32) / half)

    def rot(xa, pos):
        ang = pos.astype(jnp.float32)[:, None] * freqs
        cos = jnp.cos(ang)[None, :, None, :]
        sin = jnp.sin(ang)[None, :, None, :]
        x1, x2 = jnp.split(xa, 2, axis=-1)
        return jnp.concatenate([x1 * cos - x2 * sin, x2 * cos + x1 * sin], axis=-1)

    return jnp.concatenate([rot(x[..., :half], t // GRID_W), rot(x[..., half:], t % GRID_W)], axis=-1)


def _branch_inputs(h, w_in, b_in, q_g, k_g, latent):
    z = (jnp.dot(h, w_in) + b_in).astype(jnp.float32)
    parts = []
    off = 0
    for size in IN_SIZES:
        parts.append(z[..., off:off + size])
        off += size
    (na_q, na_k, na_v, g_q, g_k, g_v, s_q, s_k, s_v, m_q, m_k, m_v, m_o, m_i, m_f, gates) = parts

    def heads(t, n):
        return t.reshape(t.shape[:-1] + (n, t.shape[-1] // n))

    g_q = _headnorm(heads(g_q, GQA_HEADS), q_g)
    g_k = _headnorm(heads(g_k, GQA_KV), k_g)
    s_q, s_k = heads(s_q, SWA_HEADS), heads(s_k, SWA_KV)
    if latent:
        g_q, g_k, s_q, s_k = _rope2d(g_q), _rope2d(g_k), _rope2d(s_q), _rope2d(s_k)
    lead = z.shape[:-1]
    return (heads(na_q, NA_HEADS), heads(na_k, NA_HEADS), heads(na_v, NA_HEADS),
            g_q, g_k, heads(g_v, GQA_KV),
            s_q, s_k, heads(s_v, SWA_KV),
            heads(m_q, ML_HEADS), heads(m_k, ML_HEADS) * ML_DH ** -0.5, heads(m_v, ML_HEADS), heads(m_o, ML_HEADS),
            m_i.reshape(lead + (2, ML_HEADS)),
            jax.nn.log_sigmoid(m_f).reshape(lead + (2, ML_HEADS)),
            jax.nn.sigmoid(gates).reshape(lead + (N_BRANCH, D_MODEL)))


def _attn_full(q, k, v, sink):
    B, L, HQ, _ = q.shape
    KV = k.shape[2]
    G = HQ // KV
    s = jnp.einsum('bqkgd,blkd->bkgql', q.reshape(B, L, KV, G, DH), k) * DH ** -0.5
    if sink is not None:
        s = jnp.concatenate([s, jnp.broadcast_to(sink.astype(jnp.float32).reshape(1, KV, G, 1, 1), s.shape[:-1] + (1,))], axis=-1)
    p = jax.nn.softmax(s, axis=-1)[..., :L]
    o = jnp.einsum('bkgql,blkd->bqkgd', p, v)
    return o.reshape(B, L, HQ * DH)


def _natten_latent(q, k, v, kc, vc, rpb):
    B, S, H, _ = q.shape
    rows = S // GRID_W
    wr = min(NA_WIN_ROWS, rows)
    wc = NA_WIN_COLS
    scale = DH ** -0.5
    qg = jnp.moveaxis(q.reshape(B, rows, GRID_W, H, DH), 1, 0)
    kg = k.reshape(B, rows, GRID_W, H, DH)
    vg = v.reshape(B, rows, GRID_W, H, DH)
    r_idx = jnp.arange(rows)
    row_start = jnp.clip(r_idx - wr // 2, 0, rows - wr)
    c_idx = jnp.arange(GRID_W)
    col_keys = jnp.clip(c_idx - wc // 2, 0, GRID_W - wc)[:, None] + jnp.arange(wc)[None, :]
    col_bias_idx = col_keys - c_idx[:, None] + (NA_WIN_COLS - 1)
    rpb = rpb.astype(jnp.float32)

    def row_block(args):
        q_r, r, rs = args
        k_sel = lax.dynamic_slice_in_dim(kg, rs, wr, axis=1)[:, :, col_keys]
        v_sel = lax.dynamic_slice_in_dim(vg, rs, wr, axis=1)[:, :, col_keys]
        row_bias_idx = rs + jnp.arange(wr) - r + (NA_WIN_ROWS - 1)
        bias = rpb[:, row_bias_idx[:, None, None], col_bias_idx[None, :, :]]
        s_nb = jnp.einsum('bqhd,brqchd->bhqrc', q_r, k_sel) * scale + jnp.transpose(bias, (0, 2, 1, 3))[None]
        s_nb = s_nb.reshape(B, H, GRID_W, wr * wc)
        s_ctx = jnp.einsum('bqhd,blhd->bhql', q_r, kc) * scale
        p = jax.nn.softmax(jnp.concatenate([s_nb, s_ctx], axis=-1), axis=-1)
        p_nb = p[..., :wr * wc].reshape(B, H, GRID_W, wr, wc)
        return (jnp.einsum('bhqrc,brqchd->bqhd', p_nb, v_sel)
                + jnp.einsum('bhql,blhd->bqhd', p[..., wr * wc:], vc))

    out = lax.map(row_block, (qg, r_idx, row_start))
    return jnp.moveaxis(out, 0, 1).reshape(B, S, H * DH)


def _gqa_dense_latent(q, k, v, kc, vc):
    B, S, HQ, _ = q.shape
    KV = k.shape[2]
    G = HQ // KV
    keys = jnp.concatenate([kc, k], axis=1)
    vals = jnp.concatenate([vc, v], axis=1)
    qb = jnp.moveaxis(q.reshape(B, S // Q_BLOCK, Q_BLOCK, KV, G, DH), 1, 0)

    def block(qi):
        s = jnp.einsum('bqkgd,bnkd->bkgqn', qi, keys) * DH ** -0.5
        return jnp.einsum('bkgqn,bnkd->bqkgd', jax.nn.softmax(s, axis=-1), vals)

    o = lax.map(block, qb)
    return jnp.moveaxis(o, 0, 1).reshape(B, S, HQ * DH)


def _swa_latent(q, k, v, kc, vc, sink):
    B, S, HQ, _ = q.shape
    KV = k.shape[2]
    G = HQ // KV
    BLK = SWA_WINDOW
    nb = S // BLK
    L = kc.shape[1]
    scale = DH ** -0.5

    def band(t):
        tb = jnp.pad(t, ((0, 0), (BLK, BLK), (0, 0), (0, 0))).reshape(B, nb + 2, BLK, KV, DH)
        return jnp.concatenate([tb[:, :-2], tb[:, 1:-1], tb[:, 2:]], axis=2)

    kb, vb = band(k), band(v)
    qb = q.reshape(B, nb, BLK, KV, G, DH)
    s_band = jnp.einsum('bnqkgd,bnjkd->bnkgqj', qb, kb) * scale
    blk = jnp.arange(nb)[:, None, None] * BLK
    qpos = blk + jnp.arange(BLK)[None, :, None]
    kpos = blk - BLK + jnp.arange(3 * BLK)[None, None, :]
    valid = (jnp.abs(qpos - kpos) <= SWA_WINDOW) & (kpos >= 0) & (kpos < S)
    s_band = jnp.where(valid[None, :, None, None], s_band, -jnp.inf)
    s_ctx = jnp.einsum('bnqkgd,blkd->bnkgql', qb, kc) * scale
    s_sink = jnp.broadcast_to(sink.astype(jnp.float32).reshape(1, 1, KV, G, 1, 1), s_ctx.shape[:-1] + (1,))
    p = jax.nn.softmax(jnp.concatenate([s_band, s_ctx, s_sink], axis=-1), axis=-1)
    nbk = 3 * BLK
    o = (jnp.einsum('bnkgqj,bnjkd->bnqkgd', p[..., :nbk], vb)
         + jnp.einsum('bnkgql,blkd->bnqkgd', p[..., nbk:nbk + L], vc))
    return o.reshape(B, S, HQ * DH)


def _mlstm_scan(q, k, v, i_pre, log_f, C0, n0, m0):
    B, S, H, d = q.shape
    nc = S // ML_CHUNK

    def chunks(t):
        t = t.reshape((B, nc, ML_CHUNK) + t.shape[2:])
        return jnp.moveaxis(jnp.moveaxis(t, 1, 0), 2, 3)

    tril = jnp.tril(jnp.ones((ML_CHUNK, ML_CHUNK), dtype=bool))

    def step(carry, xs):
        C, n, m = carry
        qc, kc, vc, ic, fc = xs
        b = jnp.cumsum(fc, axis=-1)
        Dm = jnp.where(tril, b[..., :, None] - b[..., None, :] + ic[..., None, :], -jnp.inf)
        inter = b + m[..., None]
        m_t = jnp.maximum(inter, jnp.max(Dm, axis=-1))
        w_intra = jnp.exp(Dm - m_t[..., None])
        w_inter = jnp.exp(inter - m_t)
        s = jnp.einsum('bhtd,bhsd->bhts', qc, kc) * w_intra
        num = w_inter[..., None] * jnp.einsum('bhtd,bhde->bhte', qc, C) + jnp.einsum('bhts,bhse->bhte', s, vc)
        den = w_inter * jnp.einsum('bhtd,bhd->bht', qc, n) + jnp.sum(s, axis=-1)
        h = num / jnp.maximum(jnp.abs(den), jnp.exp(-m_t))[..., None]
        b_last = b[..., -1]
        g = b_last[..., None] - b + ic
        m_new = jnp.maximum(b_last + m, jnp.max(g, axis=-1))
        w_s = jnp.exp(g - m_new[..., None])
        decay = jnp.exp(b_last + m - m_new)
        C_new = decay[..., None, None] * C + jnp.einsum('bhs,bhsd,bhse->bhde', w_s, kc, vc)
        n_new = decay[..., None] * n + jnp.einsum('bhs,bhsd->bhd', w_s, kc)
        return (C_new, n_new, m_new), h

    (C, n, m), h = lax.scan(step, (C0, n0, m0), tuple(chunks(t) for t in (q, k, v, i_pre, log_f)))
    h = jnp.moveaxis(jnp.moveaxis(h, 0, 1), 2, 3).reshape(B, S, H, d)
    return h, (C, n, m)


def _mlstm_bidir(q, k, v, i_pre, log_f, state_f, state_b):
    h_f, st_f = _mlstm_scan(q, k, v, i_pre[:, :, 0], log_f[:, :, 0], *state_f)
    rev = lambda t: jnp.flip(t, axis=1)
    h_b, st_b = _mlstm_scan(rev(q), rev(k), rev(v), rev(i_pre[:, :, 1]), rev(log_f[:, :, 1]), *state_b)
    return h_f + rev(h_b), st_f, st_b


def _mlstm_out(h, o_pre, g):
    y = h * jax.nn.sigmoid(o_pre)
    y = _headnorm(y, g.reshape(ML_HEADS, ML_DH))
    return y.reshape(y.shape[:-2] + (ML_HEADS * ML_DH,))


def _merge(outs, gates, w_b, w_o, dtype):
    merged = gates[..., 0, :] * jnp.dot(outs[0], w_b[0].astype(jnp.float32))
    for i in range(1, N_BRANCH):
        merged = merged + gates[..., i, :] * jnp.dot(outs[i], w_b[i].astype(jnp.float32))
    return jnp.dot(merged, w_o.astype(jnp.float32)).astype(dtype)


def _swiglu(h, w1, w2):
    a = jnp.dot(h, w1)
    gt, up = jnp.split(a, 2, axis=-1)
    return jnp.dot(jax.nn.silu(gt) * up, w2)


def setup_inputs(seed: int = 0) -> dict:
    key = jax.random.key(seed)
    ks = jax.random.split(key, 32)
    f32 = jnp.float32

    def nrm(k, shape, s):
        return jax.random.normal(k, shape, f32) * s

    f_bias = jnp.linspace(3.0, 6.0, 2 * ML_HEADS, dtype=f32)
    b_in = nrm(ks[15], (DEPTH, N_IN), 0.02).at[:, ML_F_OFFSET:ML_F_OFFSET + 2 * ML_HEADS].add(f_bias)
    return {
        'x_prompt': nrm(ks[0], (BATCH, SEQ, D_MODEL), 1.0),
        'x_sample': nrm(ks[1], (DEC_BATCH, DEC_SEQ, D_MODEL), 1.0),
        'cache_na_kv': nrm(ks[2], (DEC_BATCH, DEPTH, 2, PAST_LEN, NA_HEADS, DH), 1.0),
        'cache_gqa_kv': nrm(ks[3], (DEC_BATCH, DEPTH, 2, PAST_LEN, GQA_KV, DH), 1.0),
        'cache_swa_kv': nrm(ks[4], (DEC_BATCH, DEPTH, 2, PAST_LEN, SWA_KV, DH), 1.0),
        'state_mlstm_C': nrm(ks[5], (DEC_BATCH, DEPTH, 2, ML_HEADS, ML_DH, ML_DH), 0.1),
        'state_mlstm_n': nrm(ks[6], (DEC_BATCH, DEPTH, 2, ML_HEADS, ML_DH), 0.1),
        'state_mlstm_m': nrm(ks[7], (DEC_BATCH, DEPTH, 2, ML_HEADS), 1.0),
        'c': nrm(ks[8], (DEC_BATCH, D_MODEL), 1.0),
        'c_ctx': nrm(ks[9], (D_MODEL,), 1.0),
        'w_mod': nrm(ks[10], (DEPTH, D_MODEL, 6 * D_MODEL), 0.5 * D_MODEL ** -0.5),
        'b_mod': nrm(ks[11], (DEPTH, 6 * D_MODEL), 0.02),
        'norm1_g': 1.0 + nrm(ks[12], (DEPTH, D_MODEL), 0.02),
        'norm2_g': 1.0 + nrm(ks[13], (DEPTH, D_MODEL), 0.02),
        'w_in': nrm(ks[14], (DEPTH, D_MODEL, N_IN), D_MODEL ** -0.5),
        'b_in': b_in,
        'na_rpb': nrm(ks[16], (DEPTH, NA_HEADS, 2 * NA_WIN_ROWS - 1, 2 * NA_WIN_COLS - 1), 0.1),
        'gqa_q_g': 1.0 + nrm(ks[17], (DEPTH, DH), 0.02),
        'gqa_k_g': 1.0 + nrm(ks[18], (DEPTH, DH), 0.02),
        'swa_sink': nrm(ks[19], (DEPTH, SWA_HEADS), 1.0),
        'mlstm_norm_g': 1.0 + nrm(ks[20], (DEPTH, ML_HEADS * ML_DH), 0.02),
        'w_branch': nrm(ks[21], (DEPTH, N_BRANCH, BRANCH_W, D_MODEL), BRANCH_W ** -0.5),
        'w_out': nrm(ks[22], (DEPTH, D_MODEL, D_MODEL), D_MODEL ** -0.5),
        'w_ffn_in': nrm(ks[23], (DEPTH, D_MODEL, 2 * D_FF), D_MODEL ** -0.5),
        'w_ffn_out': nrm(ks[24], (DEPTH, D_FF, D_MODEL), D_FF ** -0.5),
        'final_norm_g': 1.0 + nrm(ks[25], (D_MODEL,), 0.02),
    }


def reference(x_prompt, x_sample, cache_na_kv, cache_gqa_kv, cache_swa_kv, state_mlstm_C, state_mlstm_n,
              state_mlstm_m, c, c_ctx, w_mod, b_mod, norm1_g, norm2_g, w_in, b_in, na_rpb, gqa_q_g, gqa_k_g,
              swa_sink, mlstm_norm_g, w_branch, w_out, w_ffn_in, w_ffn_out, final_norm_g):
    f32 = jnp.float32
    Bp = x_prompt.shape[0]
    zero_state = (jnp.zeros((Bp, ML_HEADS, ML_DH, ML_DH), f32), jnp.zeros((Bp, ML_HEADS, ML_DH), f32),
                  jnp.zeros((Bp, ML_HEADS), f32))
    xp, xs = x_prompt, x_sample
    na_list, gqa_list, swa_list, C_list, n_list, m_list = [], [], [], [], [], []
    for l in range(DEPTH):
        sh1, sc1, gt1, sh2, sc2, gt2 = _adaln(c_ctx, w_mod[l], b_mod[l])
        h = _modulate(_rmsnorm(xp, norm1_g[l]), sh1, sc1)
        (na_q, na_k, na_v, g_q, g_k, g_v, s_q, s_k, s_v, m_q, m_k, m_v, m_o, m_i, m_f, gates) = \
            _branch_inputs(h, w_in[l], b_in[l], gqa_q_g[l], gqa_k_g[l], False)
        o_na = _attn_full(na_q, na_k, na_v, None)
        o_gqa = _attn_full(g_q, g_k, g_v, None)
        o_swa = _attn_full(s_q, s_k, s_v, swa_sink[l])
        h_ml, st_f, st_b = _mlstm_bidir(m_q, m_k, m_v, m_i, m_f, zero_state, zero_state)
        o_ml = _mlstm_out(h_ml, m_o, mlstm_norm_g[l])
        xp = xp + gt1 * _merge((o_na, o_gqa, o_swa, o_ml), gates, w_branch[l], w_out[l], xp.dtype)
        xp = xp + gt2 * _swiglu(_modulate(_rmsnorm(xp, norm2_g[l]), sh2, sc2), w_ffn_in[l], w_ffn_out[l])
        na_list.append(jnp.stack([na_k, na_v], axis=1))
        gqa_list.append(jnp.stack([g_k, g_v], axis=1))
        swa_list.append(jnp.stack([s_k, s_v], axis=1))
        C_list.append(jnp.stack([st_f[0], st_b[0]], axis=1))
        n_list.append(jnp.stack([st_f[1], st_b[1]], axis=1))
        m_list.append(jnp.stack([st_f[2], st_b[2]], axis=1))

        sh1, sc1, gt1, sh2, sc2, gt2 = [m[:, None, :] for m in _adaln(c, w_mod[l], b_mod[l])]
        h = _modulate(_rmsnorm(xs, norm1_g[l]), sh1, sc1)
        (na_q, na_k, na_v, g_q, g_k, g_v, s_q, s_k, s_v, m_q, m_k, m_v, m_o, m_i, m_f, gates) = \
            _branch_inputs(h, w_in[l], b_in[l], gqa_q_g[l], gqa_k_g[l], True)
        kv_na = cache_na_kv[:, l].astype(f32)
        kv_g = cache_gqa_kv[:, l].astype(f32)
        kv_s = cache_swa_kv[:, l].astype(f32)
        o_na = _natten_latent(na_q, na_k, na_v, kv_na[:, 0], kv_na[:, 1], na_rpb[l])
        o_gqa = _gqa_dense_latent(g_q, g_k, g_v, kv_g[:, 0], kv_g[:, 1])
        o_swa = _swa_latent(s_q, s_k, s_v, kv_s[:, 0], kv_s[:, 1], swa_sink[l])
        lat_f = (state_mlstm_C[:, l, 0].astype(f32), state_mlstm_n[:, l, 0].astype(f32), state_mlstm_m[:, l, 0].astype(f32))
        lat_b = (state_mlstm_C[:, l, 1].astype(f32), state_mlstm_n[:, l, 1].astype(f32), state_mlstm_m[:, l, 1].astype(f32))
        h_ml, _, _ = _mlstm_bidir(m_q, m_k, m_v, m_i, m_f, lat_f, lat_b)
        o_ml = _mlstm_out(h_ml, m_o, mlstm_norm_g[l])
        xs = xs + gt1 * _merge((o_na, o_gqa, o_swa, o_ml), gates, w_branch[l], w_out[l], xs.dtype)
        xs = xs + gt2 * _swiglu(_modulate(_rmsnorm(xs, norm2_g[l]), sh2, sc2), w_ffn_in[l], w_ffn_out[l])

    y_prompt = _rmsnorm(xp, final_norm_g)
    y_sample = _rmsnorm(xs, final_norm_g)
    new_na_kv = jnp.stack(na_list, axis=1)
    new_gqa_kv = jnp.stack(gqa_list, axis=1)
    new_swa_kv = jnp.stack(swa_list, axis=1)
    new_ml_C = jnp.stack(C_list, axis=1)
    new_ml_n = jnp.stack(n_list, axis=1)
    new_ml_m = jnp.stack(m_list, axis=1)
    return (y_prompt, y_sample, new_na_kv, new_gqa_kv, new_swa_kv, new_ml_C, new_ml_n, new_ml_m)
```

```cpp
#include <hip/hip_runtime.h>
#include <hip/hip_cooperative_groups.h>
#include <stdint.h>
#include <stdio.h>
namespace cg = cooperative_groups;

#ifndef MK_COOP
#define MK_COOP 1
#endif

typedef unsigned short bf16_t;
typedef __attribute__((ext_vector_type(8))) short bf16x8;
typedef __attribute__((ext_vector_type(16))) float f32x16;
typedef __attribute__((ext_vector_type(4))) float f32x4;
typedef __attribute__((ext_vector_type(4))) unsigned u32x4;
typedef __attribute__((ext_vector_type(2))) unsigned u32x2;

#define DI __device__ __forceinline__
#define MFMA(a, b, c) __builtin_amdgcn_mfma_f32_32x32x16_bf16((a), (b), (c), 0, 0, 0)

typedef __attribute__((ext_vector_type(2))) __bf16 bf16x2_t;
typedef __attribute__((ext_vector_type(2))) float f32x2;
DI unsigned pk2(float lo, float hi) { f32x2 v = {lo, hi}; bf16x2_t b = __builtin_convertvector(v, bf16x2_t); return __builtin_bit_cast(unsigned, b); }
DI float bflo(unsigned u) { return __uint_as_float(u << 16); }
DI float bfhi(unsigned u) { return __uint_as_float(u & 0xffff0000u); }
DI bf16x8 as_bf8(u32x4 v) { return __builtin_bit_cast(bf16x8, v); }
DI int get_tid() { int t = (int)__builtin_amdgcn_workitem_id_x(); asm volatile("" : "+v"(t)); return t; }
DI float shfl_(float v, int src) { return __int_as_float(__builtin_amdgcn_ds_bpermute(src << 2, __float_as_int(v))); }
DI float shfl_xor_(float v, int o, int lane) { return shfl_(v, lane ^ o); }
DI float shfl_up_(float v, int o, int lane) { int s = lane - o; return shfl_(v, s < 0 ? lane : s); }
DI float sigmoidf_(float x) { return 1.f / (1.f + __expf(-x)); }

constexpr int TC = 4096;
constexpr int TL = 32768;
constexpr int TT = TC + TL;
constexpr int DM = 1024;
constexpr int NIN = 9232;
constexpr int NZ = 5136;
constexpr int ZW = 5120;
constexpr int DFF = 2816;
constexpr int NAQ = 0, NAK = 512, NAV = 1024, GQ = 1536, GK = 2048, GV = 2176, SQ = 2304, SK = 2816, SV = 2944,
              MQ = 3072, MK = 3584, MV = 4096, MO = 4608;
constexpr int MGC = 512;
constexpr size_t WS_WIN = 0;
constexpr size_t WS_WBR = WS_WIN + (size_t)NIN * DM * 2;
constexpr size_t WS_WOUT = WS_WBR + (size_t)4 * 1024 * 512 * 2;
constexpr size_t WS_WF1 = WS_WOUT + (size_t)1024 * 1024 * 2;
constexpr size_t WS_WF2 = WS_WF1 + (size_t)5632 * 1024 * 2;
constexpr size_t WS_Z = WS_WF2 + (size_t)1024 * DFF * 2;
constexpr size_t WS_H = WS_Z + (size_t)TT * ZW * 2;
constexpr size_t WS_HB = WS_H + (size_t)TT * DM * 2;
constexpr size_t WS_IF = WS_HB + (size_t)TT * 512 * 2;
constexpr size_t WS_MODS = WS_IF + (size_t)TT * 16 * 4;
constexpr size_t WS_ROPE = WS_MODS + (size_t)2 * 9 * 6144 * 4;
constexpr size_t WS_CNT = WS_ROPE + 2 * 1024 * 4;
constexpr size_t WS_BAR = WS_CNT + 4096;
constexpr size_t WS_END = WS_BAR + 16384;
constexpr size_t OUT_YP = 0, OUT_YS = 4194304, OUT_NA = 37748736, OUT_GQA = 46137344, OUT_SWA = 48234496,
                 OUT_C = 50331648, OUT_N = 54525952, OUT_M = 54558720;

constexpr int SMEM_BYTES = 74752;
constexpr float LOG2E = 1.4426950408889634f;

struct Params {
  const float *x_prompt, *x_sample, *cache_na, *cache_gqa, *cache_swa, *st_C, *st_n, *st_m, *c, *c_ctx,
      *w_mod, *b_mod, *norm1_g, *norm2_g, *w_in, *b_in, *na_rpb, *gqa_q_g, *gqa_k_g, *swa_sink, *ml_g,
      *w_branch, *w_out, *w_f1, *w_f2, *final_g;
  float* out;
  char* ws;
};

DI int cond_of_row(int grow) { return grow < TC ? 0 : 1 + ((grow - TC) >> 12); }

DI void phase0(const Params& p, char* smem) {
  const int tid = get_tid();
  if (blockIdx.x == 0) {
    int* cnt = (int*)(p.ws + WS_CNT);
    for (int i = tid; i < 1024 + 4096; i += 256) cnt[i] = 0;
    float* rc = (float*)(p.ws + WS_ROPE);
    for (int idx = tid; idx < 1024; idx += 256) {
      int pos = idx >> 4, j = idx & 15;
      float freq = exp2f(-(float)j * (13.287712379549449f / 16.f));
      float ang = (float)pos * freq;
      float k = rintf(ang * 0.15915494309189535f);
      float r = fmaf(-k, 6.2831854820251465f, ang);
      r = fmaf(k, 1.7484555e-7f, r);
      rc[idx] = __cosf(r);
      rc[1024 + idx] = __sinf(r);
    }
  }
  float* sS = (float*)smem;
  float* sR = (float*)(smem + 36864);
  for (int idx = tid; idx < 9 * 1024; idx += 256) {
    int cv = idx >> 10, k = idx & 1023;
    float v = cv == 0 ? p.c_ctx[k] : p.c[(cv - 1) * 1024 + k];
    sS[idx] = v / (1.f + __expf(-v));
  }
  __syncthreads();
  for (int item = blockIdx.x; item < 192; item += gridDim.x) {
    int l = item / 96, n0 = (item % 96) * 64, n = n0 + (tid & 63), kg = tid >> 6;
    const float* w = p.w_mod + (size_t)l * 1024 * 6144 + n;
    float acc[9];
#pragma unroll
    for (int cv = 0; cv < 9; ++cv) acc[cv] = 0.f;
#pragma unroll 4
    for (int k = kg * 256; k < kg * 256 + 256; ++k) {
      float wv = w[(size_t)k * 6144];
#pragma unroll
      for (int cv = 0; cv < 9; ++cv) acc[cv] = fmaf(sS[cv * 1024 + k], wv, acc[cv]);
    }
#pragma unroll
    for (int cv = 0; cv < 9; ++cv) sR[(kg * 9 + cv) * 64 + (tid & 63)] = acc[cv];
    __syncthreads();
    if (tid < 64) {
      float* mods = (float*)(p.ws + WS_MODS);
      float bm = p.b_mod[l * 6144 + n];
#pragma unroll
      for (int cv = 0; cv < 9; ++cv) {
        float s = sR[(0 * 9 + cv) * 64 + tid] + sR[(1 * 9 + cv) * 64 + tid] + sR[(2 * 9 + cv) * 64 + tid] + sR[(3 * 9 + cv) * 64 + tid];
        mods[(size_t)(l * 9 + cv) * 6144 + n] = s + bm;
      }
    }
    __syncthreads();
  }
}

DI void convert_tile(const float* __restrict__ src, int K, int N, bf16_t* __restrict__ dst, int kt, int nt, int f1perm, char* smem) {
  float* sT = (float*)smem;
  const int tid = get_tid();
  __syncthreads();
  {
    int n4 = (tid & 15) * 4, kr = tid >> 4;
#pragma unroll
    for (int i = 0; i < 4; ++i) {
      int k = kr + 16 * i;
      int n = nt * 64 + n4;
      f32x4 v = {0.f, 0.f, 0.f, 0.f};
      if (n < N) v = *(const f32x4*)(src + (size_t)(kt * 64 + k) * N + n);
      sT[k * 65 + n4 + 0] = v[0]; sT[k * 65 + n4 + 1] = v[1]; sT[k * 65 + n4 + 2] = v[2]; sT[k * 65 + n4 + 3] = v[3];
    }
  }
  __syncthreads();
  {
    int nl = tid >> 2, seg = (tid & 3) * 16;
    int n = nt * 64 + nl;
    if (n < N) {
      int drow = n;
      if (f1perm) { int j = n < DFF ? n : n - DFF; drow = (j >> 6) * 128 + (n < DFF ? 0 : 64) + (j & 63); }
      unsigned o[8];
#pragma unroll
      for (int q = 0; q < 8; ++q) o[q] = pk2(sT[(seg + 2 * q) * 65 + nl], sT[(seg + 2 * q + 1) * 65 + nl]);
      u32x4* d = (u32x4*)(dst + (size_t)drow * K + kt * 64 + seg);
      d[0] = u32x4{o[0], o[1], o[2], o[3]};
      d[1] = u32x4{o[4], o[5], o[6], o[7]};
    }
  }
}

DI void convert_weights(const Params& p, int l, char* smem) {
  for (int item = blockIdx.x; item < 5200; item += gridDim.x) {
    const float* src; bf16_t* dst; int K, N, kt, nt, perm = 0;
    int j = item;
    if (j < 2320) { src = p.w_in + (size_t)l * 1024 * NIN; K = 1024; N = NIN; dst = (bf16_t*)(p.ws + WS_WIN); kt = j / 145; nt = j % 145; }
    else if (j < 2832) { j -= 2320; int i = j >> 7; j &= 127; src = p.w_branch + (size_t)(l * 4 + i) * 512 * 1024; K = 512; N = 1024; dst = (bf16_t*)(p.ws + WS_WBR) + (size_t)i * 1024 * 512; kt = j >> 4; nt = j & 15; }
    else if (j < 3088) { j -= 2832; src = p.w_out + (size_t)l * 1024 * 1024; K = 1024; N = 1024; dst = (bf16_t*)(p.ws + WS_WOUT); kt = j >> 4; nt = j & 15; }
    else if (j < 4496) { j -= 3088; src = p.w_f1 + (size_t)l * 1024 * 5632; K = 1024; N = 5632; dst = (bf16_t*)(p.ws + WS_WF1); kt = j / 88; nt = j % 88; perm = 1; }
    else { j -= 4496; src = p.w_f2 + (size_t)l * DFF * 1024; K = DFF; N = 1024; dst = (bf16_t*)(p.ws + WS_WF2); kt = j >> 4; nt = j & 15; }
    convert_tile(src, K, N, dst, kt, nt, perm, smem);
  }
}

DI void norm_phase(const Params& p, int l, int which) {
  const int tid = get_tid(), lane = tid & 63, w = tid >> 6;
  const float* g = which == 0 ? p.norm1_g + l * 1024 : (which == 1 ? p.norm2_g + l * 1024 : p.final_g);
  const float* mods = (const float*)(p.ws + WS_MODS);
  bf16_t* H = (bf16_t*)(p.ws + WS_H);
  for (int row = blockIdx.x * 4 + w; row < TT; row += gridDim.x * 4) {
    const float* xr;
    if (which == 0 && l == 0) xr = row < TC ? p.x_prompt + (size_t)row * 1024 : p.x_sample + (size_t)(row - TC) * 1024;
    else xr = p.out + (size_t)row * 1024;
    f32x4 v[4];
    float ss = 0.f;
#pragma unroll
    for (int i = 0; i < 4; ++i) {
      v[i] = *(const f32x4*)(xr + 4 * lane + 256 * i);
      ss += v[i][0] * v[i][0] + v[i][1] * v[i][1] + v[i][2] * v[i][2] + v[i][3] * v[i][3];
    }
#pragma unroll
    for (int o = 32; o >= 1; o >>= 1) ss += shfl_xor_(ss, o, lane);
    float rstd = rsqrtf(ss * (1.f / 1024.f) + 1e-6f);
    if (which == 2) {
      float* yo = p.out + (size_t)row * 1024;
#pragma unroll
      for (int i = 0; i < 4; ++i) {
        int k = 4 * lane + 256 * i;
        f32x4 g4 = *(const f32x4*)(g + k);
        f32x4 y;
#pragma unroll
        for (int e = 0; e < 4; ++e) y[e] = v[i][e] * rstd * g4[e];
        *(f32x4*)(yo + k) = y;
      }
    } else {
      const float* mr = mods + (size_t)(l * 9 + cond_of_row(row)) * 6144 + (which == 0 ? 0 : 3072);
#pragma unroll
      for (int i = 0; i < 4; ++i) {
        int k = 4 * lane + 256 * i;
        f32x4 g4 = *(const f32x4*)(g + k);
        f32x4 sh = *(const f32x4*)(mr + k);
        f32x4 sc = *(const f32x4*)(mr + 1024 + k);
        float y[4];
#pragma unroll
        for (int e = 0; e < 4; ++e) y[e] = (v[i][e] * rstd * g4[e]) * (1.f + sc[e]) + sh[e];
        *(u32x2*)(H + (size_t)row * 1024 + k) = u32x2{pk2(y[0], y[1]), pk2(y[2], y[3])};
      }
    }
  }
}

template <bool DB = true>
DI void gemm_core(const bf16_t* __restrict__ A, int lda, const bf16_t* __restrict__ B, int ldb, int K, f32x16 (&acc)[2][2], char* smem) {
  bf16_t* sA = (bf16_t*)smem;
  bf16_t* sB = sA + (DB ? 2 : 1) * 128 * 72;
  const int tid = get_tid(), lane = tid & 63, w = tid >> 6, wm = w >> 1, wn = w & 1, l31 = lane & 31, hh = lane >> 5;
  const int lrow = tid >> 3, lseg = (tid & 7) * 8;
  const char* Ab = (const char*)A;
  const char* Bb = (const char*)B;
  const unsigned offA = (unsigned)(lrow * lda + lseg) * 2u, offB = (unsigned)(lrow * ldb + lseg) * 2u;
  const unsigned stepA = (unsigned)lda * 64u, stepB = (unsigned)ldb * 64u;
  u32x4 ra[4], rb[4];
#pragma unroll
  for (int i = 0; i < 4; ++i) { ra[i] = *(const u32x4*)(Ab + (offA + i * stepA)); rb[i] = *(const u32x4*)(Bb + (offB + i * stepB)); }
  __syncthreads();
#pragma unroll
  for (int i = 0; i < 4; ++i) { *(u32x4*)(sA + (lrow + 32 * i) * 72 + lseg) = ra[i]; *(u32x4*)(sB + (lrow + 32 * i) * 72 + lseg) = rb[i]; }
  __syncthreads();
  const int nk = K >> 6;
  for (int kt = 0; kt < nk; ++kt) {
    const int buf = DB ? (kt & 1) : 0;
    if (kt + 1 < nk) {
#pragma unroll
      for (int i = 0; i < 4; ++i) { ra[i] = *(const u32x4*)(Ab + (offA + i * stepA + (unsigned)(kt + 1) * 128u)); rb[i] = *(const u32x4*)(Bb + (offB + i * stepB + (unsigned)(kt + 1) * 128u)); }
    }
    __builtin_amdgcn_sched_barrier(0);
    const bf16_t* pa = sA + (buf * 128 + 64 * wm + l31) * 72 + 8 * hh;
    const bf16_t* pb = sB + (buf * 128 + 64 * wn + l31) * 72 + 8 * hh;
    bf16x8 a0 = *(const bf16x8*)(pa), a1 = *(const bf16x8*)(pa + 32 * 72);
    bf16x8 b0 = *(const bf16x8*)(pb), b1 = *(const bf16x8*)(pb + 32 * 72);
#pragma unroll
    for (int ks = 0; ks < 4; ++ks) {
      bf16x8 na0 = a0, na1 = a1, nb0 = b0, nb1 = b1;
      if (ks < 3) {
        na0 = *(const bf16x8*)(pa + (ks + 1) * 16); na1 = *(const bf16x8*)(pa + 32 * 72 + (ks + 1) * 16);
        nb0 = *(const bf16x8*)(pb + (ks + 1) * 16); nb1 = *(const bf16x8*)(pb + 32 * 72 + (ks + 1) * 16);
      }
      __builtin_amdgcn_sched_barrier(0);
      acc[0][0] = MFMA(a0, b0, acc[0][0]);
      acc[0][1] = MFMA(a0, b1, acc[0][1]);
      acc[1][0] = MFMA(a1, b0, acc[1][0]);
      acc[1][1] = MFMA(a1, b1, acc[1][1]);
      __builtin_amdgcn_sched_barrier(0);
      a0 = na0; a1 = na1; b0 = nb0; b1 = nb1;
    }
    if (kt + 1 < nk) {
      const int nb = DB ? (buf ^ 1) : 0;
      if (!DB) __syncthreads();
#pragma unroll
      for (int i = 0; i < 4; ++i) { *(u32x4*)(sA + (nb * 128 + lrow + 32 * i) * 72 + lseg) = ra[i]; *(u32x4*)(sB + (nb * 128 + lrow + 32 * i) * 72 + lseg) = rb[i]; }
    }
    __syncthreads();
  }
}

DI void zero_acc(f32x16 (&acc)[2][2]) {
#pragma unroll
  for (int i = 0; i < 2; ++i)
#pragma unroll
    for (int j = 0; j < 2; ++j)
#pragma unroll
      for (int r = 0; r < 16; ++r) acc[i][j][r] = 0.f;
}

DI void acc_to_lds(const f32x16 (&acc)[2][2], float* sC) {
  const int tid = get_tid(), lane = tid & 63, w = tid >> 6, wm = w >> 1, wn = w & 1, l31 = lane & 31, hh = lane >> 5;
#pragma unroll
  for (int i = 0; i < 2; ++i)
#pragma unroll
    for (int j = 0; j < 2; ++j)
#pragma unroll
      for (int r = 0; r < 16; ++r) {
        int row = 64 * wm + 32 * i + 8 * (r >> 2) + 4 * hh + (r & 3), col = 64 * wn + 32 * j + l31;
        sC[row * 132 + col] = acc[i][j][r];
      }
  __syncthreads();
}

struct TileIter {
  int local, step, total, nN, xcd; bool swz;
  DI void init(int nN_) {
    nN = nN_;
    swz = (gridDim.x & 7) == 0;
    if (swz) { xcd = blockIdx.x & 7; local = blockIdx.x >> 3; step = gridDim.x >> 3; total = 36 * nN; }
    else { xcd = 0; local = blockIdx.x; step = gridDim.x; total = 288 * nN; }
  }
  DI bool next(int& mt, int& nt) {
    if (local >= total) return false;
    if (swz) {
      const int per_sr = 8 * nN;
      const int sr = local / per_sr, r = local - sr * per_sr;
      const int rows = (36 - 8 * sr) < 8 ? (36 - 8 * sr) : 8;
      nt = r / rows; mt = 36 * xcd + 8 * sr + (r - nt * rows);
    } else { mt = local / nN; nt = local - mt * nN; }
    local += step;
    return true;
  }
};

DI void epi_inproj(const Params& p, int l, int mt, int nt, const float* sC) {
  const int tid = get_tid();
  const int chunk = tid & 15, lane = tid & 63;
  const int half = chunk >> 3, d0 = (chunk & 7) * 8;
  const int c0 = nt * 128 + half * 64;
  if (c0 >= NZ && c0 != 5120) return;
  bf16_t* Z = (bf16_t*)(p.ws + WS_Z);
  const float* bias = p.b_in + (size_t)l * NIN + c0;
  if (c0 == 5120) {
    if (chunk >= 2) return;
    const f32x4 b0 = *(const f32x4*)(bias + d0), b1 = *(const f32x4*)(bias + d0 + 4);
#pragma unroll
    for (int it = 0; it < 8; ++it) {
      const int rt = (tid >> 4) + 16 * it, grow = mt * 128 + rt;
      const float* crow = sC + rt * 132 + d0;
      f32x4 v0 = *(const f32x4*)crow + b0, v1 = *(const f32x4*)(crow + 4) + b1;
      if (chunk == 1) {
#pragma unroll
        for (int e = 0; e < 4; ++e) {
          v0[e] = fminf(v0[e], 0.f) - log1pf(__expf(-fabsf(v0[e])));
          v1[e] = fminf(v1[e], 0.f) - log1pf(__expf(-fabsf(v1[e])));
        }
      }
      float* IF = (float*)(p.ws + WS_IF) + (size_t)grow * 16 + d0;
      *(f32x4*)IF = v0; *(f32x4*)(IF + 4) = v1;
    }
    return;
  }
  bool hn = false, rope = false;
  const float* hg = nullptr;
  float scale = 1.f;
  int kvsel = -1, kvh = 0, kvH = 0; size_t kvbase = 0;
  if (c0 < NAK) {}
  else if (c0 < NAV) { kvbase = OUT_NA; kvsel = 0; kvh = (c0 - NAK) >> 6; kvH = 8; }
  else if (c0 < GQ) { kvbase = OUT_NA; kvsel = 1; kvh = (c0 - NAV) >> 6; kvH = 8; }
  else if (c0 < GK) { hn = true; hg = p.gqa_q_g + l * 64; rope = true; }
  else if (c0 < GV) { hn = true; hg = p.gqa_k_g + l * 64; rope = true; kvbase = OUT_GQA; kvsel = 0; kvh = (c0 - GK) >> 6; kvH = 2; }
  else if (c0 < SQ) { kvbase = OUT_GQA; kvsel = 1; kvh = (c0 - GV) >> 6; kvH = 2; }
  else if (c0 < SK) { rope = true; }
  else if (c0 < SV) { rope = true; kvbase = OUT_SWA; kvsel = 0; kvh = (c0 - SK) >> 6; kvH = 2; }
  else if (c0 < MQ) { kvbase = OUT_SWA; kvsel = 1; kvh = (c0 - SV) >> 6; kvH = 2; }
  else if (c0 >= MK && c0 < MV) { scale = 0.08838834764831845f; }
  if (c0 < NAK || (c0 >= GQ && c0 < GK) || (c0 >= SQ && c0 < SK)) scale = 0.125f * LOG2E;
  const bool latent_tile = mt >= 32;
  if (latent_tile) kvsel = -1; else rope = false;
  const int dp = d0 ^ 16;
  const bool second = (d0 & 16) != 0;
  const f32x4 b0 = *(const f32x4*)(bias + d0), b1 = *(const f32x4*)(bias + d0 + 4);
  f32x4 pb0 = b0, pb1 = b1, g0 = {1.f, 1.f, 1.f, 1.f}, g1 = g0, pg0 = g0, pg1 = g0;
  if (rope) { pb0 = *(const f32x4*)(bias + dp); pb1 = *(const f32x4*)(bias + dp + 4); }
  if (hn) {
    g0 = *(const f32x4*)(hg + d0); g1 = *(const f32x4*)(hg + d0 + 4);
    pg0 = *(const f32x4*)(hg + dp); pg1 = *(const f32x4*)(hg + dp + 4);
  }
  const float* rcos = (const float*)(p.ws + WS_ROPE);
  const float* rsin = rcos + 1024;
#pragma unroll 4
  for (int it = 0; it < 8; ++it) {
    const int rt = (tid >> 4) + 16 * it, grow = mt * 128 + rt;
    const float* crow = sC + rt * 132 + half * 64;
    f32x4 x0 = *(const f32x4*)(crow + d0) + b0, x1 = *(const f32x4*)(crow + d0 + 4) + b1;
    float rs = 1.f;
    if (hn) {
      float ss = x0[0] * x0[0] + x0[1] * x0[1] + x0[2] * x0[2] + x0[3] * x0[3] + x1[0] * x1[0] + x1[1] * x1[1] + x1[2] * x1[2] + x1[3] * x1[3];
      ss += shfl_xor_(ss, 1, lane); ss += shfl_xor_(ss, 2, lane); ss += shfl_xor_(ss, 4, lane);
      rs = rsqrtf(ss * (1.f / 64.f) + 1e-6f);
    }
    const float sc = rs * scale;
    x0 = x0 * sc * g0; x1 = x1 * sc * g1;
    if (rope) {
      f32x4 y0 = (*(const f32x4*)(crow + dp) + pb0) * sc * pg0, y1 = (*(const f32x4*)(crow + dp + 4) + pb1) * sc * pg1;
      const int t = (grow - TC) & 4095;
      const int pos = (d0 & 32) ? (t & 63) : (t >> 6);
      const int fj = d0 & 15;
      const f32x4 c0v = *(const f32x4*)(rcos + pos * 16 + fj), c1v = *(const f32x4*)(rcos + pos * 16 + fj + 4);
      const f32x4 s0v = *(const f32x4*)(rsin + pos * 16 + fj), s1v = *(const f32x4*)(rsin + pos * 16 + fj + 4);
      if (second) { x0 = x0 * c0v + y0 * s0v; x1 = x1 * c1v + y1 * s1v; }
      else { x0 = x0 * c0v - y0 * s0v; x1 = x1 * c1v - y1 * s1v; }
    }
    __builtin_nontemporal_store(u32x4{pk2(x0[0], x0[1]), pk2(x0[2], x0[3]), pk2(x1[0], x1[1]), pk2(x1[2], x1[3])}, (u32x4*)(Z + (size_t)grow * ZW + c0 + d0));
    if (kvsel >= 0) {
      const int cb = grow >> 8, cs = grow & 255;
      float* kv = p.out + kvbase + ((((size_t)(cb * 2 + l) * 2 + kvsel) * 256 + cs) * kvH + kvh) * 64 + d0;
      *(f32x4*)kv = x0; *(f32x4*)(kv + 4) = x1;
    }
  }
}

DI void phase_inproj(const Params& p, int l, char* smem) {
  const bf16_t* H = (const bf16_t*)(p.ws + WS_H);
  const bf16_t* W = (const bf16_t*)(p.ws + WS_WIN);
  TileIter ti; ti.init(41);
  for (int mt, nt; ti.next(mt, nt);) {
    f32x16 acc[2][2];
    zero_acc(acc);
    gemm_core(H + (size_t)mt * 128 * DM, DM, W + (size_t)nt * 128 * DM, DM, DM, acc, smem);
    acc_to_lds(acc, (float*)smem);
    epi_inproj(p, l, mt, nt, (const float*)smem);
  }
}

DI void phase_merge(const Params& p, int l, char* smem) {
  const int tid = get_tid(), lane = tid & 63, w = tid >> 6, wn = w & 1, l31 = lane & 31;
  const bf16_t* H = (const bf16_t*)(p.ws + WS_H);
  const bf16_t* W = (const bf16_t*)(p.ws + WS_WIN);
  const bf16_t* WB = (const bf16_t*)(p.ws + WS_WBR);
  bf16_t* Z = (bf16_t*)(p.ws + WS_Z);
  TileIter ti; ti.init(8);
  for (int mt, nt; ti.next(mt, nt);) {
    f32x16 mg[2][2];
    zero_acc(mg);
#pragma unroll 1
    for (int i = 0; i < 4; ++i) {
      f32x16 acc[2][2];
      zero_acc(acc);
      gemm_core<false>(H + (size_t)mt * 128 * DM, DM, W + (size_t)(NZ + i * 1024 + nt * 128) * DM, DM, DM, acc, smem);
      unsigned* sG = (unsigned*)(smem + 36864) + tid;
#pragma unroll
      for (int j = 0; j < 2; ++j) {
        float bj = p.b_in[(size_t)l * NIN + NZ + i * 1024 + nt * 128 + 64 * wn + 32 * j + l31];
#pragma unroll
        for (int ii = 0; ii < 2; ++ii)
#pragma unroll
          for (int r = 0; r < 8; ++r) sG[((ii * 2 + j) * 8 + r) * 256] = pk2(sigmoidf_(acc[ii][j][2 * r] + bj), sigmoidf_(acc[ii][j][2 * r + 1] + bj));
      }
      zero_acc(acc);
      const int colA = i == 0 ? NAQ : (i == 1 ? GQ : (i == 2 ? SQ : MQ));
      gemm_core<false>(Z + (size_t)mt * 128 * ZW + colA, ZW, WB + (size_t)(i * 1024 + nt * 128) * 512, 512, 512, acc, smem);
#pragma unroll
      for (int ii = 0; ii < 2; ++ii)
#pragma unroll
        for (int j = 0; j < 2; ++j)
#pragma unroll
          for (int r = 0; r < 8; ++r) {
            const unsigned gpv = sG[((ii * 2 + j) * 8 + r) * 256];
            mg[ii][j][2 * r] += bflo(gpv) * acc[ii][j][2 * r];
            mg[ii][j][2 * r + 1] += bfhi(gpv) * acc[ii][j][2 * r + 1];
          }
    }
    float* sC = (float*)smem;
    __syncthreads();
    acc_to_lds(mg, sC);
#pragma unroll
    for (int it = 0; it < 8; ++it) {
      const int rt = (tid >> 4) + 16 * it, ch = (tid & 15) * 8;
      const float* crow = sC + rt * 132 + ch;
      f32x4 a = *(const f32x4*)crow, b = *(const f32x4*)(crow + 4);
      __builtin_nontemporal_store(u32x4{pk2(a[0], a[1]), pk2(a[2], a[3]), pk2(b[0], b[1]), pk2(b[2], b[3])}, (u32x4*)(Z + (size_t)(mt * 128 + rt) * ZW + MGC + nt * 128 + ch));
    }
  }
}

DI void phase_resid(const Params& p, int l, int which, char* smem) {
  const int tid = get_tid();
  const bf16_t* Z = (const bf16_t*)(p.ws + WS_Z);
  const bf16_t* W = (const bf16_t*)(p.ws + (which == 0 ? WS_WOUT : WS_WF2));
  const int K = which == 0 ? 1024 : DFF;
  const int acol = which == 0 ? MGC : 0;
  const int goff = which == 0 ? 2048 : 5120;
  const float* mods = (const float*)(p.ws + WS_MODS);
  TileIter ti; ti.init(8);
  for (int mt, nt; ti.next(mt, nt);) {
    f32x16 acc[2][2];
    zero_acc(acc);
    gemm_core(Z + (size_t)mt * 128 * ZW + acol, ZW, W + (size_t)nt * 128 * K, K, K, acc, smem);
    float* sC = (float*)smem;
    acc_to_lds(acc, sC);
#pragma unroll 4
    for (int it = 0; it < 16; ++it) {
      const int rt = (tid >> 5) + 8 * it, grow = mt * 128 + rt;
      const int n = nt * 128 + (tid & 31) * 4;
      const float* xr;
      if (which == 0 && l == 0) xr = grow < TC ? p.x_prompt + (size_t)grow * 1024 : p.x_sample + (size_t)(grow - TC) * 1024;
      else xr = p.out + (size_t)grow * 1024;
      const f32x4 x4 = *(const f32x4*)(xr + n);
      const f32x4 g4 = *(const f32x4*)(mods + (size_t)(l * 9 + cond_of_row(grow)) * 6144 + goff + n);
      const f32x4 c4 = *(const f32x4*)(sC + rt * 132 + (tid & 31) * 4);
      __builtin_nontemporal_store(x4 + g4 * c4, (f32x4*)(p.out + (size_t)grow * 1024 + n));
    }
  }
}

DI void phase_ffn1(const Params& p, int l, char* smem) {
  const int tid = get_tid();
  const bf16_t* H = (const bf16_t*)(p.ws + WS_H);
  const bf16_t* W = (const bf16_t*)(p.ws + WS_WF1);
  bf16_t* Z = (bf16_t*)(p.ws + WS_Z);
  TileIter ti; ti.init(44);
  for (int mt, nt; ti.next(mt, nt);) {
    f32x16 acc[2][2];
    zero_acc(acc);
    gemm_core(H + (size_t)mt * 128 * DM, DM, W + (size_t)nt * 128 * DM, DM, DM, acc, smem);
    float* sC = (float*)smem;
    acc_to_lds(acc, sC);
#pragma unroll
    for (int it = 0; it < 4; ++it) {
      const int rt = (tid >> 3) + 32 * it, ch = (tid & 7) * 8;
      const float* crow = sC + rt * 132 + ch;
      float o[8];
#pragma unroll
      for (int hq = 0; hq < 2; ++hq) {
        f32x4 gt = *(const f32x4*)(crow + 4 * hq), up = *(const f32x4*)(crow + 64 + 4 * hq);
#pragma unroll
        for (int e = 0; e < 4; ++e) o[4 * hq + e] = gt[e] / (1.f + __expf(-gt[e])) * up[e];
      }
      __builtin_nontemporal_store(u32x4{pk2(o[0], o[1]), pk2(o[2], o[3]), pk2(o[4], o[5]), pk2(o[6], o[7])}, (u32x4*)(Z + (size_t)(mt * 128 + rt) * ZW + nt * 64 + ch));
    }
  }
}

struct AttnArgs {
  const void* k1; const void* v1; int stride1; int f32_1; int nblk1;
  const bf16_t* k2; const bf16_t* v2; int blk0_2; int nblk2;
  bf16_t* qo;
  int qpos0;
  int mode;
  float m0, l0;
  const float* rpb;
};

DI void attn_item(const AttnArgs& a, char* smem) {
  bf16_t* sK = (bf16_t*)smem;
  bf16_t* sVt = sK + 2 * 64 * 72;
  float* sRpb = (float*)(smem + 4 * 64 * 72 * 2);
  const int tid = get_tid(), lane = tid & 63, l31 = lane & 31, hh = lane >> 5;
  const int dg = tid & 7, kp = tid >> 3;
  __syncthreads();
  if (a.mode == 2) for (int i = tid; i < 465; i += 256) sRpb[i] = a.rpb[i] * LOG2E;
  bf16x8 qf[4];
#pragma unroll
  for (int st = 0; st < 4; ++st) qf[st] = *(const bf16x8*)(a.qo + (size_t)l31 * ZW + 16 * st + 8 * hh);
  f32x16 o[2];
#pragma unroll
  for (int dt = 0; dt < 2; ++dt)
#pragma unroll
    for (int r = 0; r < 16; ++r) o[dt][r] = 0.f;
  float m_run = a.m0, l_run = a.l0;
  const int nblk = a.nblk1 + a.nblk2;
  u32x4 rk[2], rv[2];
  auto load_blk = [&](int b) {
    if (b < a.nblk1) {
      if (a.f32_1) {
        const float* kb = (const float*)a.k1 + (size_t)(b * 64 + 2 * kp) * a.stride1 + 8 * dg;
        const float* vb = (const float*)a.v1 + (size_t)(b * 64 + 2 * kp) * a.stride1 + 8 * dg;
#pragma unroll
        for (int i = 0; i < 2; ++i) {
          f32x4 k0 = *(const f32x4*)(kb + (size_t)i * a.stride1), k1 = *(const f32x4*)(kb + (size_t)i * a.stride1 + 4);
          f32x4 v0 = *(const f32x4*)(vb + (size_t)i * a.stride1), v1 = *(const f32x4*)(vb + (size_t)i * a.stride1 + 4);
          rk[i] = u32x4{pk2(k0[0], k0[1]), pk2(k0[2], k0[3]), pk2(k1[0], k1[1]), pk2(k1[2], k1[3])};
          rv[i] = u32x4{pk2(v0[0], v0[1]), pk2(v0[2], v0[3]), pk2(v1[0], v1[1]), pk2(v1[2], v1[3])};
        }
      } else {
        const bf16_t* kb = (const bf16_t*)a.k1 + (size_t)(b * 64 + 2 * kp) * a.stride1 + 8 * dg;
        const bf16_t* vb = (const bf16_t*)a.v1 + (size_t)(b * 64 + 2 * kp) * a.stride1 + 8 * dg;
#pragma unroll
        for (int i = 0; i < 2; ++i) { rk[i] = *(const u32x4*)(kb + (size_t)i * a.stride1); rv[i] = *(const u32x4*)(vb + (size_t)i * a.stride1); }
      }
    } else {
      const int kb0 = (a.blk0_2 + (b - a.nblk1)) * 64 + 2 * kp;
      const bf16_t* kb = a.k2 + (size_t)kb0 * ZW + 8 * dg;
      const bf16_t* vb = a.v2 + (size_t)kb0 * ZW + 8 * dg;
#pragma unroll
      for (int i = 0; i < 2; ++i) { rk[i] = *(const u32x4*)(kb + (size_t)i * ZW); rv[i] = *(const u32x4*)(vb + (size_t)i * ZW); }
    }
  };
  auto store_blk = [&](int buf) {
    bf16_t* k = sK + buf * 64 * 72; bf16_t* v = sVt + buf * 64 * 72;
    *(u32x4*)(k + (2 * kp) * 72 + 8 * dg) = rk[0];
    *(u32x4*)(k + (2 * kp + 1) * 72 + 8 * dg) = rk[1];
#pragma unroll
    for (int e = 0; e < 4; ++e) {
      unsigned a0 = rv[0][e], a1 = rv[1][e];
      *(unsigned*)(v + (8 * dg + 2 * e) * 72 + 2 * (kp ^ (4 * dg))) = (a0 & 0xffffu) | (a1 << 16);
      *(unsigned*)(v + (8 * dg + 2 * e + 1) * 72 + 2 * (kp ^ (4 * dg))) = (a0 >> 16) | (a1 & 0xffff0000u);
    }
  };
  load_blk(0);
  store_blk(0);
  if (nblk > 1) load_blk(1);
  __syncthreads();
  for (int b = 0; b < nblk; ++b) {
    const bf16_t* cK = sK + (b & 1) * 64 * 72;
    const bf16_t* cV = sVt + (b & 1) * 64 * 72;
    f32x16 s[2];
#pragma unroll
    for (int kt = 0; kt < 2; ++kt)
#pragma unroll
      for (int r = 0; r < 16; ++r) s[kt][r] = 0.f;
#pragma unroll
    for (int st = 0; st < 4; ++st) {
      bf16x8 k0 = *(const bf16x8*)(cK + l31 * 72 + 16 * st + 8 * hh);
      bf16x8 k1 = *(const bf16x8*)(cK + (32 + l31) * 72 + 16 * st + 8 * hh);
      s[0] = MFMA(k0, qf[st], s[0]);
      s[1] = MFMA(k1, qf[st], s[1]);
    }
    const bool seg2 = b >= a.nblk1;
    if (seg2 && a.mode == 1) {
      const int kbase = (a.blk0_2 + (b - a.nblk1)) * 64;
      const int qpos = a.qpos0 + l31;
#pragma unroll
      for (int kt = 0; kt < 2; ++kt)
#pragma unroll
        for (int r = 0; r < 16; ++r) {
          int kpos = kbase + 32 * kt + 8 * (r >> 2) + 4 * hh + (r & 3);
          int dd = qpos - kpos; dd = dd < 0 ? -dd : dd;
          s[kt][r] = dd <= 128 ? s[kt][r] : -INFINITY;
        }
    } else if (seg2 && a.mode == 2) {
      const int kr = a.blk0_2 + (b - a.nblk1);
      const int qpos = a.qpos0 + l31;
      const int qr = qpos >> 6, qc = qpos & 63;
      int rs = qr - 4; rs = rs < 0 ? 0 : (rs > 56 ? 56 : rs);
      int cs = qc - 8; cs = cs < 0 ? 0 : (cs > 48 ? 48 : cs);
      const bool rowok = kr >= rs && kr <= rs + 7;
      const int bbase = (kr - qr + 7) * 31 - qc + 15;
#pragma unroll
      for (int kt = 0; kt < 2; ++kt)
#pragma unroll
        for (int r = 0; r < 16; ++r) {
          int kc = 32 * kt + 8 * (r >> 2) + 4 * hh + (r & 3);
          bool ok = rowok && (unsigned)(kc - cs) < 16u;
          const float bias = sRpb[ok ? bbase + kc : 0];
          s[kt][r] = ok ? s[kt][r] + bias : -INFINITY;
        }
    }
    float mx = -INFINITY;
#pragma unroll
    for (int kt = 0; kt < 2; ++kt)
#pragma unroll
      for (int r = 0; r < 16; ++r) mx = fmaxf(mx, s[kt][r]);
    mx = fmaxf(mx, shfl_xor_(mx, 32, lane));
    const float m_new = fmaxf(m_run, mx);
    if (__builtin_amdgcn_ballot_w64(m_new > m_run) != 0ull) {
      const float alpha = __builtin_amdgcn_exp2f(m_run - m_new);
      l_run *= alpha;
#pragma unroll
      for (int dt = 0; dt < 2; ++dt)
#pragma unroll
        for (int r = 0; r < 16; ++r) o[dt][r] *= alpha;
      m_run = m_new;
    }
    float ps = 0.f;
#pragma unroll
    for (int kt = 0; kt < 2; ++kt)
#pragma unroll
      for (int r = 0; r < 16; ++r) { float e = __builtin_amdgcn_exp2f(s[kt][r] - m_run); s[kt][r] = e; ps += e; }
    ps += shfl_xor_(ps, 32, lane);
    l_run += ps;
#pragma unroll
    for (int kt = 0; kt < 2; ++kt)
#pragma unroll
      for (int s2 = 0; s2 < 2; ++s2) {
        u32x4 pb = {pk2(s[kt][8 * s2 + 0], s[kt][8 * s2 + 1]), pk2(s[kt][8 * s2 + 2], s[kt][8 * s2 + 3]),
                    pk2(s[kt][8 * s2 + 4], s[kt][8 * s2 + 5]), pk2(s[kt][8 * s2 + 6], s[kt][8 * s2 + 7])};
#pragma unroll
        for (int dt = 0; dt < 2; ++dt) {
          const int rg = (4 * dt + (l31 >> 3)) & 7;
          const bf16_t* vrow = cV + (32 * dt + l31) * 72 + 4 * hh;
          u32x2 lo = *(const u32x2*)(vrow + 8 * ((4 * kt + 2 * s2) ^ rg)), hi = *(const u32x2*)(vrow + 8 * ((4 * kt + 2 * s2 + 1) ^ rg));
          o[dt] = MFMA(as_bf8(u32x4{lo[0], lo[1], hi[0], hi[1]}), as_bf8(pb), o[dt]);
        }
      }
    if (b + 1 < nblk) store_blk((b + 1) & 1);
    if (b + 2 < nblk) load_blk(b + 2);
    __builtin_amdgcn_sched_barrier(0);
    __syncthreads();
  }
  const float inv = 1.f / l_run;
#pragma unroll
  for (int dt = 0; dt < 2; ++dt)
#pragma unroll
    for (int g = 0; g < 4; ++g) {
      *(u32x2*)(a.qo + (size_t)l31 * ZW + 32 * dt + 8 * g + 4 * hh) =
          u32x2{pk2(o[dt][4 * g] * inv, o[dt][4 * g + 1] * inv), pk2(o[dt][4 * g + 2] * inv, o[dt][4 * g + 3] * inv)};
    }
}

DI float wave_scan_sum(float v, int lane) {
#pragma unroll
  for (int o = 1; o < 64; o <<= 1) { float t = shfl_up_(v, o, lane); if (lane >= o) v += t; }
  return v;
}
DI float wave_scan_max(float v, int lane) {
#pragma unroll
  for (int o = 1; o < 64; o <<= 1) { float t = shfl_up_(v, o, lane); if (lane >= o) v = fmaxf(v, t); }
  return v;
}

#define RLX_AGENT __ATOMIC_RELAXED, __HIP_MEMORY_SCOPE_AGENT
DI void mlstm_item(const Params& p, char* smem, int l, int b, int h, int eh, int dir, bool latent, int* prog_self, int* prog_partner) {
  bf16_t* sQ = (bf16_t*)smem;
  bf16_t* sK = sQ + 64 * 136;
  bf16_t* sKw = sK + 64 * 136;
  bf16_t* sVt = sKw + 128 * 72;
  float* sN = (float*)(sVt + 64 * 72);
  float* sA = sN + 128;
  const int tid = get_tid();
  const int S = latent ? 4096 : 256, nc = S >> 6, half = nc >> 1;
  const int rowbase = latent ? TC + b * 4096 : b * 256;
  bf16_t* Z = (bf16_t*)(p.ws + WS_Z);
  bf16_t* HB = (bf16_t*)(p.ws + WS_HB);
  const float* IF = (const float*)(p.ws + WS_IF);
  f32x16 C[4];
  float m_state = 0.f;
  __syncthreads();
  {
    const int lane = tid & 63, w = tid >> 6, l31 = lane & 31, hh = lane >> 5, et = w & 1;
    if (latent) {
      const size_t sidx = (size_t)((b * 2 + l) * 2 + dir) * 4 + h;
      const float* C0 = p.st_C + sidx * 128 * 128;
      int cidx0 = 4 * hh * 128 + 64 * eh + 32 * et + l31; asm volatile("" : "+v"(cidx0));
#pragma unroll
      for (int dt = 0; dt < 4; ++dt) {
#pragma unroll
        for (int r = 0; r < 16; ++r) C[dt][r] = C0[(unsigned)(cidx0 + (32 * dt + 8 * (r >> 2) + (r & 3)) * 128)];
        __builtin_amdgcn_sched_barrier(0);
      }
      if (tid < 128) sN[tid] = p.st_n[sidx * 128 + tid];
      m_state = p.st_m[sidx];
    } else {
#pragma unroll
      for (int dt = 0; dt < 4; ++dt)
#pragma unroll
        for (int r = 0; r < 16; ++r) C[dt][r] = 0.f;
      if (tid < 128) sN[tid] = 0.f;
    }
  }
  float ip_n, lf_n;
  u32x4 rq[4], rkk[4], rvv[2];
  auto prefetch = [&](int c) {
    const int cbase = rowbase + (dir ? (nc - 1 - c) * 64 : c * 64);
    int tidc = tid; asm volatile("" : "+v"(tidc));
    const int lane = tidc & 63;
    const int tokp = cbase + (dir ? 63 - lane : lane);
    ip_n = IF[(size_t)tokp * 16 + dir * 4 + h];
    lf_n = IF[(size_t)tokp * 16 + 8 + dir * 4 + h];
#pragma unroll
    for (int i = 0; i < 4; ++i) {
      int id = tidc + 256 * i, pr = id >> 4, seg = (id & 15) * 8;
      int tok = cbase + (dir ? 63 - pr : pr);
      rq[i] = *(const u32x4*)(Z + (size_t)tok * ZW + MQ + h * 128 + seg);
    }
    const int dgp = (tidc & 15) * 8;
#pragma unroll
    for (int i = 0; i < 2; ++i) {
      const int s0 = 2 * ((tidc >> 4) + 16 * i), s1 = s0 + 1;
      const int t0 = cbase + (dir ? 63 - s0 : s0), t1 = cbase + (dir ? 63 - s1 : s1);
      rkk[2 * i] = *(const u32x4*)(Z + (size_t)t0 * ZW + MK + h * 128 + dgp);
      rkk[2 * i + 1] = *(const u32x4*)(Z + (size_t)t1 * ZW + MK + h * 128 + dgp);
    }
    {
      const int dgv = (tidc & 7) * 8, s0 = 2 * (tidc >> 3), s1 = s0 + 1;
      const int t0 = cbase + (dir ? 63 - s0 : s0), t1 = cbase + (dir ? 63 - s1 : s1);
      rvv[0] = *(const u32x4*)(Z + (size_t)t0 * ZW + MV + h * 128 + 64 * eh + dgv);
      rvv[1] = *(const u32x4*)(Z + (size_t)t1 * ZW + MV + h * 128 + 64 * eh + dgv);
    }
  };
  prefetch(0);
#pragma unroll 1
  for (int c = 0; c < nc; ++c) {
    const int cbase = rowbase + (dir ? (nc - 1 - c) * 64 : c * 64);
    int tidc = tid; asm volatile("" : "+v"(tidc));
    const int lane = tidc & 63, w = tidc >> 6, l31 = lane & 31, hh = lane >> 5, et = w & 1, tt = w >> 1;
    const float ip = ip_n, lf = lf_n;
    const float bcum = wave_scan_sum(lf, lane);
    const float av = ip - bcum;
    const float pm = wave_scan_max(av, lane);
    const float Mv = fmaxf(m_state, pm);
    const float Mlast = shfl_(Mv, 63), blast = shfl_(bcum, 63);
    const float wsv = __expf(av - Mlast);
    const float decay = __expf(m_state - Mlast);
    __syncthreads();
#pragma unroll
    for (int i = 0; i < 4; ++i) {
      int id = tidc + 256 * i, pr = id >> 4, seg = (id & 15) * 8;
      *(u32x4*)(sQ + pr * 136 + seg) = rq[i];
    }
    {
      const int dgp = (tidc & 15) * 8;
#pragma unroll
      for (int i = 0; i < 2; ++i) {
        const int s0 = 2 * ((tidc >> 4) + 16 * i), s1 = s0 + 1;
        const u32x4 k0 = rkk[2 * i], k1 = rkk[2 * i + 1];
        *(u32x4*)(sK + s0 * 136 + dgp) = k0;
        *(u32x4*)(sK + s1 * 136 + dgp) = k1;
        const float w0 = shfl_(wsv, s0), w1 = shfl_(wsv, s1);
#pragma unroll
        for (int e = 0; e < 4; ++e) {
          const int sw = 2 * ((s0 >> 1) ^ (4 * ((tidc & 15) & 7)));
          *(unsigned*)(sKw + (dgp + 2 * e) * 72 + sw) = pk2(bflo(k0[e]) * w0, bflo(k1[e]) * w1);
          *(unsigned*)(sKw + (dgp + 2 * e + 1) * 72 + sw) = pk2(bfhi(k0[e]) * w0, bfhi(k1[e]) * w1);
        }
      }
      const int dgv = (tidc & 7) * 8, sv0 = 2 * (tidc >> 3);
#pragma unroll
      for (int e = 0; e < 4; ++e) {
        const int svw = 2 * ((sv0 >> 1) ^ (4 * (tidc & 7)));
        *(unsigned*)(sVt + (dgv + 2 * e) * 72 + svw) = (rvv[0][e] & 0xffffu) | (rvv[1][e] << 16);
        *(unsigned*)(sVt + (dgv + 2 * e + 1) * 72 + svw) = (rvv[0][e] >> 16) | (rvv[1][e] & 0xffff0000u);
      }
    }
    if (w == 0) sA[lane] = av;
    __syncthreads();
    if (c + 1 < nc) prefetch(c + 1);
    __builtin_amdgcn_sched_barrier(0);
    const int t = 32 * tt + l31;
    const int tok = cbase + (dir ? 63 - t : t);
    const bool finisher = c >= half;
    u32x2 og[4];
    if (finisher) {
#pragma unroll
      for (int g = 0; g < 4; ++g) og[g] = *(const u32x2*)(Z + (size_t)tok * ZW + MO + h * 128 + 64 * eh + 32 * et + 8 * g + 4 * hh);
    }
    float inv;
    f32x16 acc;
    {
      const float Mt = shfl_(Mv, t), bt = shfl_(bcum, t);
      const float winter = __expf(m_state - Mt);
#pragma unroll
      for (int r = 0; r < 16; ++r) acc[r] = 0.f;
#pragma unroll
      for (int dt = 0; dt < 4; ++dt)
#pragma unroll
        for (int s2 = 0; s2 < 2; ++s2) {
          u32x4 ca = {pk2(C[dt][8 * s2 + 0], C[dt][8 * s2 + 1]), pk2(C[dt][8 * s2 + 2], C[dt][8 * s2 + 3]),
                      pk2(C[dt][8 * s2 + 4], C[dt][8 * s2 + 5]), pk2(C[dt][8 * s2 + 6], C[dt][8 * s2 + 7])};
          const bf16_t* qp = sQ + t * 136 + 32 * dt + 16 * s2 + 4 * hh;
          u32x2 lo = *(const u32x2*)qp, hi = *(const u32x2*)(qp + 8);
          acc = MFMA(as_bf8(ca), as_bf8(u32x4{lo[0], lo[1], hi[0], hi[1]}), acc);
        }
#pragma unroll
      for (int r = 0; r < 16; ++r) acc[r] *= winter;
      float qv = 0.f;
#pragma unroll
      for (int j = 0; j < 8; ++j) {
        u32x4 q8 = *(const u32x4*)(sQ + t * 136 + 64 * hh + 8 * j);
        f32x4 n0 = *(const f32x4*)(sN + 64 * hh + 8 * j), n1 = *(const f32x4*)(sN + 64 * hh + 8 * j + 4);
        qv += bflo(q8[0]) * n0[0] + bfhi(q8[0]) * n0[1] + bflo(q8[1]) * n0[2] + bfhi(q8[1]) * n0[3] +
              bflo(q8[2]) * n1[0] + bfhi(q8[2]) * n1[1] + bflo(q8[3]) * n1[2] + bfhi(q8[3]) * n1[3];
      }
      qv += shfl_xor_(qv, 32, lane);
      float rsv = 0.f;
#pragma unroll
      for (int st = 0; st < 2; ++st) {
        f32x16 sm;
#pragma unroll
        for (int r = 0; r < 16; ++r) sm[r] = 0.f;
#pragma unroll
        for (int ks = 0; ks < 8; ++ks) {
          bf16x8 ka = *(const bf16x8*)(sK + (32 * st + l31) * 136 + 16 * ks + 8 * hh);
          bf16x8 qb = *(const bf16x8*)(sQ + t * 136 + 16 * ks + 8 * hh);
          sm = MFMA(ka, qb, sm);
        }
#pragma unroll
        for (int g = 0; g < 4; ++g) {
          f32x4 a4 = *(const f32x4*)(sA + 32 * st + 8 * g + 4 * hh);
#pragma unroll
          for (int e = 0; e < 4; ++e) {
            const int s = 32 * st + 8 * g + 4 * hh + e;
            float wgt = s <= t ? __expf(a4[e] - Mt) : 0.f;
            float v = sm[4 * g + e] * wgt;
            sm[4 * g + e] = v;
            rsv += v;
          }
        }
#pragma unroll
        for (int s2 = 0; s2 < 2; ++s2) {
          const int rgv = (4 * et + (l31 >> 3)) & 7;
          const bf16_t* vrow = sVt + (32 * et + l31) * 72 + 4 * hh;
          u32x2 lo = *(const u32x2*)(vrow + 8 * ((4 * st + 2 * s2) ^ rgv)), hi = *(const u32x2*)(vrow + 8 * ((4 * st + 2 * s2 + 1) ^ rgv));
          u32x4 pb = {pk2(sm[8 * s2 + 0], sm[8 * s2 + 1]), pk2(sm[8 * s2 + 2], sm[8 * s2 + 3]),
                      pk2(sm[8 * s2 + 4], sm[8 * s2 + 5]), pk2(sm[8 * s2 + 6], sm[8 * s2 + 7])};
          acc = MFMA(as_bf8(u32x4{lo[0], lo[1], hi[0], hi[1]}), as_bf8(pb), acc);
        }
      }
      rsv += shfl_xor_(rsv, 32, lane);
      const float den = winter * qv + rsv;
      inv = 1.f / fmaxf(fabsf(den), __expf(-(bt + Mt)));
    }
#pragma unroll
    for (int dt = 0; dt < 4; ++dt) {
#pragma unroll
      for (int r = 0; r < 16; ++r) C[dt][r] *= decay;
#pragma unroll
      for (int ks = 0; ks < 4; ++ks) {
        bf16x8 ka = *(const bf16x8*)(sKw + (32 * dt + l31) * 72 + 8 * ((2 * ks + hh) ^ ((4 * dt + (l31 >> 3)) & 7)));
        bf16x8 vb = *(const bf16x8*)(sVt + (32 * et + l31) * 72 + 8 * ((2 * ks + hh) ^ ((4 * et + (l31 >> 3)) & 7)));
        C[dt] = MFMA(ka, vb, C[dt]);
      }
    }
    {
      unsigned long long* hbp = (unsigned long long*)(HB + (size_t)tok * 512 + h * 128 + 64 * eh + 32 * et + 4 * hh);
      if (!finisher) {
#pragma unroll
        for (int g = 0; g < 4; ++g) {
          const unsigned lo = pk2(acc[4 * g] * inv, acc[4 * g + 1] * inv), hi = pk2(acc[4 * g + 2] * inv, acc[4 * g + 3] * inv);
          __hip_atomic_store(hbp + 2 * g, ((unsigned long long)hi << 32) | lo, RLX_AGENT);
        }
        asm volatile("s_waitcnt vmcnt(0)" ::: "memory");
      } else {
        const int need = nc - c;
        unsigned spins = 0;
        while (__builtin_amdgcn_readfirstlane(__hip_atomic_load(prog_partner, RLX_AGENT)) < need) {
          __builtin_amdgcn_s_sleep(1);
          if (++spins > (1u << 24)) break;
        }
        __builtin_amdgcn_fence(__ATOMIC_ACQUIRE, "agent");
#pragma unroll
        for (int g = 0; g < 4; ++g) {
          const unsigned long long hb = hbp[2 * g];
          const unsigned hlo = (unsigned)hb, hhi = (unsigned)(hb >> 32);
          const float y0 = (acc[4 * g] * inv + bflo(hlo)) * sigmoidf_(bflo(og[g][0]));
          const float y1 = (acc[4 * g + 1] * inv + bfhi(hlo)) * sigmoidf_(bfhi(og[g][0]));
          const float y2 = (acc[4 * g + 2] * inv + bflo(hhi)) * sigmoidf_(bflo(og[g][1]));
          const float y3 = (acc[4 * g + 3] * inv + bfhi(hhi)) * sigmoidf_(bfhi(og[g][1]));
          hbp[2 * g] = ((unsigned long long)pk2(y2, y3) << 32) | pk2(y0, y1);
        }
      }
    }
    __syncthreads();
    if (!finisher && tidc == 0) __hip_atomic_store(prog_self, c + 1, RLX_AGENT);
    if (tidc < 128) {
      float sum = 0.f;
#pragma unroll
      for (int j = 0; j < 8; ++j) {
        u32x4 k8 = *(const u32x4*)(sKw + tidc * 72 + 8 * j);
        sum += bflo(k8[0]) + bfhi(k8[0]) + bflo(k8[1]) + bfhi(k8[1]) + bflo(k8[2]) + bfhi(k8[2]) + bflo(k8[3]) + bfhi(k8[3]);
      }
      sN[tidc] = decay * sN[tidc] + sum;
    }
    m_state = blast + Mlast;
  }
  if (!latent) {
    const int lane = tid & 63, w = tid >> 6, l31 = lane & 31, hh = lane >> 5, et = w & 1, tt = w >> 1;
    const size_t sidx = (size_t)((b * 2 + l) * 2 + dir) * 4 + h;
    float* Co = p.out + OUT_C + sidx * 128 * 128;
    if (tt == 0) {
      int cidx1 = 4 * hh * 128 + 64 * eh + 32 * et + l31; asm volatile("" : "+v"(cidx1));
#pragma unroll
      for (int dt = 0; dt < 4; ++dt) {
#pragma unroll
        for (int r = 0; r < 16; ++r) Co[(unsigned)(cidx1 + (32 * dt + 8 * (r >> 2) + (r & 3)) * 128)] = C[dt][r];
        __builtin_amdgcn_sched_barrier(0);
      }
    }
    __syncthreads();
    if (eh == 0) {
      if (tid < 128) p.out[OUT_N + sidx * 128 + tid] = sN[tid];
      if (tid == 0) p.out[OUT_M + sidx] = m_state;
    }
  }
}

DI void mlstm_norm_phase(const Params& p, int l) {
  const int tid = get_tid(), lane = tid & 63, w = tid >> 6;
  const bf16_t* HB = (const bf16_t*)(p.ws + WS_HB);
  bf16_t* Z = (bf16_t*)(p.ws + WS_Z);
  const float* g = p.ml_g + l * 512 + lane * 8;
  const f32x4 g0 = *(const f32x4*)g, g1 = *(const f32x4*)(g + 4);
  for (int row = blockIdx.x * 4 + w; row < TT; row += gridDim.x * 4) {
    u32x4 y = *(const u32x4*)(HB + (size_t)row * 512 + lane * 8);
    float v[8] = {bflo(y[0]), bfhi(y[0]), bflo(y[1]), bfhi(y[1]), bflo(y[2]), bfhi(y[2]), bflo(y[3]), bfhi(y[3])};
    float ss = 0.f;
#pragma unroll
    for (int e = 0; e < 8; ++e) ss += v[e] * v[e];
#pragma unroll
    for (int o = 8; o >= 1; o >>= 1) ss += shfl_xor_(ss, o, lane);
    const float rstd = rsqrtf(ss * (1.f / 128.f) + 1e-6f);
    *(u32x4*)(Z + (size_t)row * ZW + MQ + lane * 8) =
        u32x4{pk2(v[0] * rstd * g0[0], v[1] * rstd * g0[1]), pk2(v[2] * rstd * g0[2], v[3] * rstd * g0[3]),
              pk2(v[4] * rstd * g1[0], v[5] * rstd * g1[1]), pk2(v[6] * rstd * g1[2], v[7] * rstd * g1[3])};
  }
}

constexpr int MIX_ITEMS = 7296;
DI void phase_mixers(const Params& p, int l, char* smem) {
  __shared__ int s_item;
  const int tid = get_tid();
  int* cnt = (int*)(p.ws + WS_CNT) + l;
  auto draw = [&]() -> int {
    __syncthreads();
    if (tid == 0) s_item = atomicAdd(cnt, 1);
    __syncthreads();
    return __builtin_amdgcn_readfirstlane(s_item);
  };
  int item = draw();
  while (item < 384) {
    const bool lat = item < 128;
    const int j = lat ? item : item - 128;
    int* prog = (int*)(p.ws + WS_CNT) + 16 + l * 384;
    mlstm_item(p, smem, l, j >> 4, (j >> 2) & 3, (j >> 1) & 1, j & 1, lat, prog + item, prog + (item ^ 1));
    item = draw();
  }
#ifndef NO_ATTN
  const int w = __builtin_amdgcn_readfirstlane(get_tid() >> 6);
  bf16_t* Z = (bf16_t*)(p.ws + WS_Z);
  for (; item < MIX_ITEMS; item = draw()) {
    AttnArgs a;
    a.k2 = nullptr; a.v2 = nullptr; a.blk0_2 = 0; a.nblk2 = 0; a.mode = 0; a.m0 = -INFINITY; a.l0 = 0.f; a.rpb = nullptr; a.qpos0 = 0;
    a.nblk1 = 4;
    if (item < 2432) {
      int j = item - 384, qt = j & 127, kv = (j >> 7) & 1, b = j >> 8;
      const float* cb = p.cache_gqa + (size_t)((b * 2 + l) * 2) * 256 * 128 + kv * 64;
      a.k1 = cb; a.v1 = cb + 256 * 128; a.stride1 = 128; a.f32_1 = 1;
      bf16_t* zb = Z + (size_t)(TC + b * 4096) * ZW;
      a.k2 = zb + GK + kv * 64; a.v2 = zb + GV + kv * 64; a.blk0_2 = 0; a.nblk2 = 64;
      a.qo = zb + (size_t)(qt * 32) * ZW + GQ + (kv * 4 + w) * 64;
    } else if (item < 4480) {
      int j = item - 2432, qt = j & 127, kv = (j >> 7) & 1, b = j >> 8;
      const float* cb = p.cache_swa + (size_t)((b * 2 + l) * 2) * 256 * 128 + kv * 64;
      a.k1 = cb; a.v1 = cb + 256 * 128; a.stride1 = 128; a.f32_1 = 1;
      bf16_t* zb = Z + (size_t)(TC + b * 4096) * ZW;
      a.k2 = zb + SK + kv * 64; a.v2 = zb + SV + kv * 64;
      const int q0 = qt * 32;
      int lo = q0 - 128; lo = lo < 0 ? 0 : lo;
      int hi = q0 + 31 + 128; hi = hi > 4095 ? 4095 : hi;
      a.blk0_2 = lo >> 6; a.nblk2 = (hi >> 6) - (lo >> 6) + 1;
      a.qo = zb + (size_t)q0 * ZW + SQ + (kv * 4 + w) * 64;
      a.qpos0 = q0; a.mode = 1;
      a.m0 = p.swa_sink[l * 8 + kv * 4 + w] * LOG2E; a.l0 = 1.f;
    } else if (item < 6528) {
      int j = item - 4480, rp = j & 31, h = (j >> 5) & 7, b = j >> 8;
      const float* cb = p.cache_na + (size_t)((b * 2 + l) * 2) * 256 * 512 + h * 64;
      a.k1 = cb; a.v1 = cb + 256 * 512; a.stride1 = 512; a.f32_1 = 1;
      bf16_t* zb = Z + (size_t)(TC + b * 4096) * ZW;
      a.k2 = zb + NAK + h * 64; a.v2 = zb + NAV + h * 64;
      int r0 = 2 * rp, r1 = r0 + 1;
      int rs0 = r0 - 4; rs0 = rs0 < 0 ? 0 : (rs0 > 56 ? 56 : rs0);
      int rs1 = r1 - 4; rs1 = rs1 < 0 ? 0 : (rs1 > 56 ? 56 : rs1);
      a.blk0_2 = rs0; a.nblk2 = rs1 + 8 - rs0;
      const int q0 = (r0 + (w >> 1)) * 64 + 32 * (w & 1);
      a.qo = zb + (size_t)q0 * ZW + NAQ + h * 64;
      a.qpos0 = q0; a.mode = 2; a.rpb = p.na_rpb + (size_t)(l * 8 + h) * 465;
    } else if (item < 6784) {
      int j = item - 6528, qtile = j & 1, h = (j >> 1) & 7, b = j >> 4;
      bf16_t* zb = Z + (size_t)(b * 256) * ZW;
      a.k1 = zb + NAK + h * 64; a.v1 = zb + NAV + h * 64; a.stride1 = ZW; a.f32_1 = 0;
      a.qo = zb + (size_t)(qtile * 128 + 32 * w) * ZW + NAQ + h * 64;
    } else if (item < 7040) {
      int j = item - 6784, qt = j & 7, kv = (j >> 3) & 1, b = j >> 4;
      bf16_t* zb = Z + (size_t)(b * 256) * ZW;
      a.k1 = zb + GK + kv * 64; a.v1 = zb + GV + kv * 64; a.stride1 = ZW; a.f32_1 = 0;
      a.qo = zb + (size_t)(qt * 32) * ZW + GQ + (kv * 4 + w) * 64;
    } else {
      int j = item - 7040, qt = j & 7, kv = (j >> 3) & 1, b = j >> 4;
      bf16_t* zb = Z + (size_t)(b * 256) * ZW;
      a.k1 = zb + SK + kv * 64; a.v1 = zb + SV + kv * 64; a.stride1 = ZW; a.f32_1 = 0;
      a.qo = zb + (size_t)(qt * 32) * ZW + SQ + (kv * 4 + w) * 64;
      a.m0 = p.swa_sink[l * 8 + kv * 4 + w] * LOG2E; a.l0 = 1.f;
    }
    attn_item(a, smem);
  }
#endif
}

#define XB_TMO      128
#define XB_XCNT(j)  (256  + 64 * (j))
#define XB_XSUB(j)  (1280 + 64 * (j))
#define XB_XGEN(j)  (2304 + 64 * (j))
#define XB_TOP      3328
#define XB_TOPGEN   3392
#define XCD_BAR_WORDS 3456
#define XB_SPIN_CAP (1u << 18)
#define LAS __attribute__((address_space(3)))
DI unsigned xb_ld(unsigned* p) { return __hip_atomic_load(p, __ATOMIC_RELAXED, __HIP_MEMORY_SCOPE_AGENT); }
DI unsigned xb_add(unsigned* p, unsigned v) { return __hip_atomic_fetch_add(p, v, __ATOMIC_RELAXED, __HIP_MEMORY_SCOPE_AGENT); }
DI unsigned xb_xcc_id() { return (unsigned)__builtin_amdgcn_s_getreg((3 << 11) | 20) & 0xFu; }
#define XB_SPIN(cond, bar) do { unsigned _sp = 0; while (cond) { __builtin_amdgcn_s_sleep(1); \
    if ((++_sp & 255u) == 0u) { if (xb_ld(&(bar)[XB_TMO])) break; if (_sp > XB_SPIN_CAP) { atomicAdd(&(bar)[XB_TMO], 1u); break; } } } } while (0)
struct XcdBarrier { unsigned* bar; unsigned x; volatile LAS unsigned* st; };
DI XcdBarrier xcd_barrier_post(unsigned* bar, volatile LAS unsigned* st) {
  XcdBarrier b; b.bar = bar; b.x = xb_xcc_id(); b.st = st;
  if (threadIdx.x == 0) (void)xb_add(&bar[XB_XCNT(b.x)], 1u);
  return b;
}
DI void xcd_barrier_complete(unsigned* bar, unsigned x, unsigned& nloc, unsigned& nx) {
  const unsigned G = gridDim.x * gridDim.y * gridDim.z;
  unsigned sum, cnt, mine, sp = 0u;
  for (;;) {
    sum = 0u; cnt = 0u; mine = 0u;
#pragma unroll
    for (unsigned j = 0; j < 16; ++j) { const unsigned c = xb_ld(&bar[XB_XCNT(j)]); sum += c; cnt += (c > 0u) ? 1u : 0u; mine = (j == x) ? c : mine; }
    if (sum == G) break;
    __builtin_amdgcn_s_sleep(1);
    if ((++sp & 255u) == 0u) { if (xb_ld(&bar[XB_TMO])) break; if (sp > XB_SPIN_CAP) { atomicAdd(&bar[XB_TMO], 1u); break; } }
  }
  nloc = mine > 0u ? mine : 1u; nx = cnt > 0u ? cnt : 1u;
}
DI void xcd_barrier(const XcdBarrier& b) {
  asm volatile("s_waitcnt vmcnt(0)" ::: "memory");
  __syncthreads();
  if (threadIdx.x == 0) {
    unsigned* bar = b.bar;
    __builtin_amdgcn_s_waitcnt(0);
    unsigned nloc = b.st[0], nx = b.st[1];
    if (nloc == 0u) { xcd_barrier_complete(bar, b.x, nloc, nx); b.st[0] = nloc; b.st[1] = nx; }
    const unsigned old = xb_add(&bar[XB_XSUB(b.x)], 1u);
    const unsigned gen = old / nloc;
    if (old + 1u == (gen + 1u) * nloc) {
      __builtin_amdgcn_fence(__ATOMIC_RELEASE, "agent");
      asm volatile("s_waitcnt vmcnt(0)" ::: "memory");
      const unsigned og = xb_add(&bar[XB_TOP], 1u);
      const unsigned tg = og / nx;
      if (og + 1u == (tg + 1u) * nx) xb_add(&bar[XB_TOPGEN], 1u);
      else XB_SPIN(xb_ld(&bar[XB_TOPGEN]) == tg, bar);
      __builtin_amdgcn_fence(__ATOMIC_ACQUIRE, "agent");
      xb_add(&bar[XB_XGEN(b.x)], 1u);
      asm volatile("s_waitcnt vmcnt(0)" ::: "memory");
    } else {
      XB_SPIN(xb_ld(&bar[XB_XGEN(b.x)]) == gen, bar);
      __builtin_amdgcn_fence(__ATOMIC_ACQUIRE, "agent");
      asm volatile("s_waitcnt vmcnt(0)" ::: "memory");
    }
  }
  __syncthreads();
}

constexpr int N_PHASES = 20;
DI void run_phase(const Params& p, int ph, char* smem) {
  if (ph == 0) { phase0(p, smem); return; }
  if (ph == 19) { norm_phase(p, 0, 2); return; }
  const int l = (ph - 1) / 9, s = (ph - 1) % 9;
  switch (s) {
    case 0: convert_weights(p, l, smem); norm_phase(p, l, 0); break;
    case 1: phase_inproj(p, l, smem); break;
    case 2: phase_mixers(p, l, smem); break;
    case 3: mlstm_norm_phase(p, l); break;
    case 4: phase_merge(p, l, smem); break;
    case 5: phase_resid(p, l, 0, smem); break;
    case 6: norm_phase(p, l, 1); break;
    case 7: phase_ffn1(p, l, smem); break;
    default: phase_resid(p, l, 1, smem); break;
  }
}

#ifndef MK_TEST
template <bool COOP>
__global__ void __launch_bounds__(256, 2) hybrid_fwd(Params p, int ph_lo, int ph_hi) {
  extern __shared__ __attribute__((aligned(16))) char smem[];
  __shared__ uint4 xb_words;
  if (COOP) {
    if (threadIdx.x == 0) xb_words = make_uint4(0u, 0u, 0u, 0u);
    __syncthreads();
    run_phase(p, 0, smem);
    cg::this_grid().sync();
    XcdBarrier xb = xcd_barrier_post((unsigned*)(p.ws + WS_BAR), (volatile LAS unsigned*)&xb_words);
    for (int ph = 1; ph < ph_hi; ++ph) {
      run_phase(p, ph, smem);
#ifdef PROBE_DUP
      if (ph >= 1 && ph <= 18 && ((PROBE_DUP >> ((ph - 1) % 9)) & 1)) run_phase(p, ph, smem);
#endif
      if (ph + 1 < ph_hi) xcd_barrier(xb);
    }
  } else {
    for (int ph = ph_lo; ph < ph_hi; ++ph) run_phase(p, ph, smem);
  }
}

extern "C" void kernel_launch(void* const* d_in, const int* in_sizes, int n_in, void* d_out, int out_size, void* d_ws, size_t ws_size, hipStream_t stream) {
  static int grid = 0;
  if (grid == 0) {
    if (n_in != 26 || ws_size < WS_END) { fprintf(stderr, "kernel_launch: bad n_in %d or ws_size %zu (need %zu)\n", n_in, ws_size, (size_t)WS_END); grid = -1; return; }
    int dev = 0, cus = 0, per_cu = 0;
    hipGetDevice(&dev);
    hipDeviceGetAttribute(&cus, hipDeviceAttributeMultiprocessorCount, dev);
    hipFuncSetAttribute((const void*)hybrid_fwd<true>, hipFuncAttributeMaxDynamicSharedMemorySize, SMEM_BYTES);
    hipFuncSetAttribute((const void*)hybrid_fwd<false>, hipFuncAttributeMaxDynamicSharedMemorySize, SMEM_BYTES);
    hipOccupancyMaxActiveBlocksPerMultiprocessor(&per_cu, (const void*)hybrid_fwd<true>, 256, SMEM_BYTES);
    if (per_cu < 1) per_cu = 1;
    if (per_cu > 2) per_cu = 2;
    grid = cus * per_cu;
  }
  if (grid < 0) return;
  Params p{};
  const float** pp = (const float**)&p;
  for (int i = 0; i < 26; ++i) pp[i] = (const float*)d_in[i];
  p.out = (float*)d_out;
  p.ws = (char*)d_ws;
#if MK_COOP
  int lo = 0, hi = N_PHASES;
  void* args[] = {&p, &lo, &hi};
  hipError_t e = hipLaunchCooperativeKernel((const void*)hybrid_fwd<true>, dim3(grid), dim3(256), args, SMEM_BYTES, stream);
  if (e != hipSuccess) fprintf(stderr, "cooperative launch failed: %s (grid %d)\n", hipGetErrorString(e), grid);
#else
  for (int ph = 0; ph < N_PHASES; ++ph) hybrid_fwd<false><<<grid, 256, SMEM_BYTES, stream>>>(p, ph, ph + 1);
#endif
}
#endif
```

```cpp
#include <hip/hip_runtime.h>
#include <hip/hip_cooperative_groups.h>
#include <stdint.h>
#include <stdio.h>
namespace cg = cooperative_groups;

#ifndef MK_COOP
#define MK_COOP 1
#endif

typedef unsigned short bf16_t;
typedef __attribute__((ext_vector_type(8))) short bf16x8;
typedef __attribute__((ext_vector_type(16))) float f32x16;
typedef __attribute__((ext_vector_type(4))) float f32x4;
typedef __attribute__((ext_vector_type(4))) unsigned u32x4;
typedef __attribute__((ext_vector_type(2))) unsigned u32x2;

#define DI __device__ __forceinline__
#define MFMA(a, b, c) __builtin_amdgcn_mfma_f32_32x32x16_bf16((a), (b), (c), 0, 0, 0)

typedef __attribute__((ext_vector_type(2))) __bf16 bf16x2_t;
typedef __attribute__((ext_vector_type(2))) float f32x2;
DI unsigned pk2(float lo, float hi) { f32x2 v = {lo, hi}; bf16x2_t b = __builtin_convertvector(v, bf16x2_t); return __builtin_bit_cast(unsigned, b); }
DI float bflo(unsigned u) { return __uint_as_float(u << 16); }
DI float bfhi(unsigned u) { return __uint_as_float(u & 0xffff0000u); }
DI bf16x8 as_bf8(u32x4 v) { return __builtin_bit_cast(bf16x8, v); }
DI int get_tid() { int t = (int)__builtin_amdgcn_workitem_id_x(); asm volatile("" : "+v"(t)); return t; }
DI float shfl_(float v, int src) { return __int_as_float(__builtin_amdgcn_ds_bpermute(src << 2, __float_as_int(v))); }
DI float shfl_xor_(float v, int o, int lane) { return shfl_(v, lane ^ o); }
DI float shfl_up_(float v, int o, int lane) { int s = lane - o; return shfl_(v, s < 0 ? lane : s); }
DI float sigmoidf_(float x) { return 1.f / (1.f + __expf(-x)); }

constexpr int TC = 4096;
constexpr int TL = 32768;
constexpr int TT = TC + TL;
constexpr int DM = 1024;
constexpr int NIN = 9232;
constexpr int NZ = 5136;
constexpr int ZW = 5120;
constexpr int DFF = 2816;
constexpr int NAQ = 0, NAK = 512, NAV = 1024, GQ = 1536, GK = 2048, GV = 2176, SQ = 2304, SK = 2816, SV = 2944,
              MQ = 3072, MK = 3584, MV = 4096, MO = 4608;
constexpr int MGC = 512;
constexpr size_t WS_WIN = 0;
constexpr size_t WS_WBR = WS_WIN + (size_t)NIN * DM * 2;
constexpr size_t WS_WOUT = WS_WBR + (size_t)4 * 1024 * 512 * 2;
constexpr size_t WS_WF1 = WS_WOUT + (size_t)1024 * 1024 * 2;
constexpr size_t WS_WF2 = WS_WF1 + (size_t)5632 * 1024 * 2;
constexpr size_t WS_Z = WS_WF2 + (size_t)1024 * DFF * 2;
constexpr size_t WS_H = WS_Z + (size_t)TT * ZW * 2;
constexpr size_t WS_HB = WS_H + (size_t)TT * DM * 2;
constexpr size_t WS_IF = WS_HB + (size_t)TT * 512 * 2;
constexpr size_t WS_MODS = WS_IF + (size_t)TT * 16 * 4;
constexpr size_t WS_ROPE = WS_MODS + (size_t)2 * 9 * 6144 * 4;
constexpr size_t WS_CNT = WS_ROPE + 2 * 1024 * 4;
constexpr size_t WS_BAR = WS_CNT + 4096;
constexpr size_t WS_END = WS_BAR + 16384;
constexpr size_t OUT_YP = 0, OUT_YS = 4194304, OUT_NA = 37748736, OUT_GQA = 46137344, OUT_SWA = 48234496,
                 OUT_C = 50331648, OUT_N = 54525952, OUT_M = 54558720;

constexpr int SMEM_BYTES = 74752;
constexpr float LOG2E = 1.4426950408889634f;

struct Params {
  const float *x_prompt, *x_sample, *cache_na, *cache_gqa, *cache_swa, *st_C, *st_n, *st_m, *c, *c_ctx,
      *w_mod, *b_mod, *norm1_g, *norm2_g, *w_in, *b_in, *na_rpb, *gqa_q_g, *gqa_k_g, *swa_sink, *ml_g,
      *w_branch, *w_out, *w_f1, *w_f2, *final_g;
  float* out;
  char* ws;
};

DI int cond_of_row(int grow) { return grow < TC ? 0 : 1 + ((grow - TC) >> 12); }

DI void phase0(const Params& p, char* smem) {
  const int tid = get_tid();
  if (blockIdx.x == 0) {
    int* cnt = (int*)(p.ws + WS_CNT);
    for (int i = tid; i < 1024 + 4096; i += 256) cnt[i] = 0;
    float* rc = (float*)(p.ws + WS_ROPE);
    for (int idx = tid; idx < 1024; idx += 256) {
      int pos = idx >> 4, j = idx & 15;
      float freq = exp2f(-(float)j * (13.287712379549449f / 16.f));
      float ang = (float)pos * freq;
      float k = rintf(ang * 0.15915494309189535f);
      float r = fmaf(-k, 6.2831854820251465f, ang);
      r = fmaf(k, 1.7484555e-7f, r);
      rc[idx] = __cosf(r);
      rc[1024 + idx] = __sinf(r);
    }
  }
  float* sS = (float*)smem;
  float* sR = (float*)(smem + 36864);
  for (int idx = tid; idx < 9 * 1024; idx += 256) {
    int cv = idx >> 10, k = idx & 1023;
    float v = cv == 0 ? p.c_ctx[k] : p.c[(cv - 1) * 1024 + k];
    sS[idx] = v / (1.f + __expf(-v));
  }
  __syncthreads();
  for (int item = blockIdx.x; item < 192; item += gridDim.x) {
    int l = item / 96, n0 = (item % 96) * 64, n = n0 + (tid & 63), kg = tid >> 6;
    const float* w = p.w_mod + (size_t)l * 1024 * 6144 + n;
    float acc[9];
#pragma unroll
    for (int cv = 0; cv < 9; ++cv) acc[cv] = 0.f;
#pragma unroll 4
    for (int k = kg * 256; k < kg * 256 + 256; ++k) {
      float wv = w[(size_t)k * 6144];
#pragma unroll
      for (int cv = 0; cv < 9; ++cv) acc[cv] = fmaf(sS[cv * 1024 + k], wv, acc[cv]);
    }
#pragma unroll
    for (int cv = 0; cv < 9; ++cv) sR[(kg * 9 + cv) * 64 + (tid & 63)] = acc[cv];
    __syncthreads();
    if (tid < 64) {
      float* mods = (float*)(p.ws + WS_MODS);
      float bm = p.b_mod[l * 6144 + n];
#pragma unroll
      for (int cv = 0; cv < 9; ++cv) {
        float s = sR[(0 * 9 + cv) * 64 + tid] + sR[(1 * 9 + cv) * 64 + tid] + sR[(2 * 9 + cv) * 64 + tid] + sR[(3 * 9 + cv) * 64 + tid];
        mods[(size_t)(l * 9 + cv) * 6144 + n] = s + bm;
      }
    }
    __syncthreads();
  }
}

DI void convert_tile(const float* __restrict__ src, int K, int N, bf16_t* __restrict__ dst, int kt, int nt, int f1perm, char* smem) {
  float* sT = (float*)smem;
  const int tid = get_tid();
  __syncthreads();
  {
    int n4 = (tid & 15) * 4, kr = tid >> 4;
#pragma unroll
    for (int i = 0; i < 4; ++i) {
      int k = kr + 16 * i;
      int n = nt * 64 + n4;
      f32x4 v = {0.f, 0.f, 0.f, 0.f};
      if (n < N) v = *(const f32x4*)(src + (size_t)(kt * 64 + k) * N + n);
      sT[k * 65 + n4 + 0] = v[0]; sT[k * 65 + n4 + 1] = v[1]; sT[k * 65 + n4 + 2] = v[2]; sT[k * 65 + n4 + 3] = v[3];
    }
  }
  __syncthreads();
  {
    int nl = tid >> 2, seg = (tid & 3) * 16;
    int n = nt * 64 + nl;
    if (n < N) {
      int drow = n;
      if (f1perm) { int j = n < DFF ? n : n - DFF; drow = (j >> 6) * 128 + (n < DFF ? 0 : 64) + (j & 63); }
      unsigned o[8];
#pragma unroll
      for (int q = 0; q < 8; ++q) o[q] = pk2(sT[(seg + 2 * q) * 65 + nl], sT[(seg + 2 * q + 1) * 65 + nl]);
      u32x4* d = (u32x4*)(dst + (size_t)drow * K + kt * 64 + seg);
      d[0] = u32x4{o[0], o[1], o[2], o[3]};
      d[1] = u32x4{o[4], o[5], o[6], o[7]};
    }
  }
}

DI void convert_weights(const Params& p, int l, char* smem) {
  for (int item = blockIdx.x; item < 5200; item += gridDim.x) {
    const float* src; bf16_t* dst; int K, N, kt, nt, perm = 0;
    int j = item;
    if (j < 2320) { src = p.w_in + (size_t)l * 1024 * NIN; K = 1024; N = NIN; dst = (bf16_t*)(p.ws + WS_WIN); kt = j / 145; nt = j % 145; }
    else if (j < 2832) { j -= 2320; int i = j >> 7; j &= 127; src = p.w_branch + (size_t)(l * 4 + i) * 512 * 1024; K = 512; N = 1024; dst = (bf16_t*)(p.ws + WS_WBR) + (size_t)i * 1024 * 512; kt = j >> 4; nt = j & 15; }
    else if (j < 3088) { j -= 2832; src = p.w_out + (size_t)l * 1024 * 1024; K = 1024; N = 1024; dst = (bf16_t*)(p.ws + WS_WOUT); kt = j >> 4; nt = j & 15; }
    else if (j < 4496) { j -= 3088; src = p.w_f1 + (size_t)l * 1024 * 5632; K = 1024; N = 5632; dst = (bf16_t*)(p.ws + WS_WF1); kt = j / 88; nt = j % 88; perm = 1; }
    else { j -= 4496; src = p.w_f2 + (size_t)l * DFF * 1024; K = DFF; N = 1024; dst = (bf16_t*)(p.ws + WS_WF2); kt = j >> 4; nt = j & 15; }
    convert_tile(src, K, N, dst, kt, nt, perm, smem);
  }
}

DI void norm_phase(const Params& p, int l, int which) {
  const int tid = get_tid(), lane = tid & 63, w = tid >> 6;
  const float* g = which == 0 ? p.norm1_g + l * 1024 : (which == 1 ? p.norm2_g + l * 1024 : p.final_g);
  const float* mods = (const float*)(p.ws + WS_MODS);
  bf16_t* H = (bf16_t*)(p.ws + WS_H);
  for (int row = blockIdx.x * 4 + w; row < TT; row += gridDim.x * 4) {
    const float* xr;
    if (which == 0 && l == 0) xr = row < TC ? p.x_prompt + (size_t)row * 1024 : p.x_sample + (size_t)(row - TC) * 1024;
    else xr = p.out + (size_t)row * 1024;
    f32x4 v[4];
    float ss = 0.f;
#pragma unroll
    for (int i = 0; i < 4; ++i) {
      v[i] = *(const f32x4*)(xr + 4 * lane + 256 * i);
      ss += v[i][0] * v[i][0] + v[i][1] * v[i][1] + v[i][2] * v[i][2] + v[i][3] * v[i][3];
    }
#pragma unroll
    for (int o = 32; o >= 1; o >>= 1) ss += shfl_xor_(ss, o, lane);
    float rstd = rsqrtf(ss * (1.f / 1024.f) + 1e-6f);
    if (which == 2) {
      float* yo = p.out + (size_t)row * 1024;
#pragma unroll
      for (int i = 0; i < 4; ++i) {
        int k = 4 * lane + 256 * i;
        f32x4 g4 = *(const f32x4*)(g + k);
        f32x4 y;
#pragma unroll
        for (int e = 0; e < 4; ++e) y[e] = v[i][e] * rstd * g4[e];
        *(f32x4*)(yo + k) = y;
      }
    } else {
      const float* mr = mods + (size_t)(l * 9 + cond_of_row(row)) * 6144 + (which == 0 ? 0 : 3072);
#pragma unroll
      for (int i = 0; i < 4; ++i) {
        int k = 4 * lane + 256 * i;
        f32x4 g4 = *(const f32x4*)(g + k);
        f32x4 sh = *(const f32x4*)(mr + k);
        f32x4 sc = *(const f32x4*)(mr + 1024 + k);
        float y[4];
#pragma unroll
        for (int e = 0; e < 4; ++e) y[e] = (v[i][e] * rstd * g4[e]) * (1.f + sc[e]) + sh[e];
        *(u32x2*)(H + (size_t)row * 1024 + k) = u32x2{pk2(y[0], y[1]), pk2(y[2], y[3])};
      }
    }
  }
}

template <bool DB = true>
DI void gemm_core(const bf16_t* __restrict__ A, int lda, const bf16_t* __restrict__ B, int ldb, int K, f32x16 (&acc)[2][2], char* smem) {
  bf16_t* sA = (bf16_t*)smem;
  bf16_t* sB = sA + (DB ? 2 : 1) * 128 * 72;
  const int tid = get_tid(), lane = tid & 63, w = tid >> 6, wm = w >> 1, wn = w & 1, l31 = lane & 31, hh = lane >> 5;
  const int lrow = tid >> 3, lseg = (tid & 7) * 8;
  const char* Ab = (const char*)A;
  const char* Bb = (const char*)B;
  const unsigned offA = (unsigned)(lrow * lda + lseg) * 2u, offB = (unsigned)(lrow * ldb + lseg) * 2u;
  const unsigned stepA = (unsigned)lda * 64u, stepB = (unsigned)ldb * 64u;
  u32x4 ra[4], rb[4];
#pragma unroll
  for (int i = 0; i < 4; ++i) { ra[i] = *(const u32x4*)(Ab + (offA + i * stepA)); rb[i] = *(const u32x4*)(Bb + (offB + i * stepB)); }
  __syncthreads();
#pragma unroll
  for (int i = 0; i < 4; ++i) { *(u32x4*)(sA + (lrow + 32 * i) * 72 + lseg) = ra[i]; *(u32x4*)(sB + (lrow + 32 * i) * 72 + lseg) = rb[i]; }
  __syncthreads();
  const int nk = K >> 6;
  for (int kt = 0; kt < nk; ++kt) {
    const int buf = DB ? (kt & 1) : 0;
    if (kt + 1 < nk) {
#pragma unroll
      for (int i = 0; i < 4; ++i) { ra[i] = *(const u32x4*)(Ab + (offA + i * stepA + (unsigned)(kt + 1) * 128u)); rb[i] = *(const u32x4*)(Bb + (offB + i * stepB + (unsigned)(kt + 1) * 128u)); }
    }
    __builtin_amdgcn_sched_barrier(0);
    const bf16_t* pa = sA + (buf * 128 + 64 * wm + l31) * 72 + 8 * hh;
    const bf16_t* pb = sB + (buf * 128 + 64 * wn + l31) * 72 + 8 * hh;
    bf16x8 a0 = *(const bf16x8*)(pa), a1 = *(const bf16x8*)(pa + 32 * 72);
    bf16x8 b0 = *(const bf16x8*)(pb), b1 = *(const bf16x8*)(pb + 32 * 72);
#pragma unroll
    for (int ks = 0; ks < 4; ++ks) {
      bf16x8 na0 = a0, na1 = a1, nb0 = b0, nb1 = b1;
      if (ks < 3) {
        na0 = *(const bf16x8*)(pa + (ks + 1) * 16); na1 = *(const bf16x8*)(pa + 32 * 72 + (ks + 1) * 16);
        nb0 = *(const bf16x8*)(pb + (ks + 1) * 16); nb1 = *(const bf16x8*)(pb + 32 * 72 + (ks + 1) * 16);
      }
      __builtin_amdgcn_sched_barrier(0);
      acc[0][0] = MFMA(a0, b0, acc[0][0]);
      acc[0][1] = MFMA(a0, b1, acc[0][1]);
      acc[1][0] = MFMA(a1, b0, acc[1][0]);
      acc[1][1] = MFMA(a1, b1, acc[1][1]);
      __builtin_amdgcn_sched_barrier(0);
      a0 = na0; a1 = na1; b0 = nb0; b1 = nb1;
    }
    if (kt + 1 < nk) {
      const int nb = DB ? (buf ^ 1) : 0;
      if (!DB) __syncthreads();
#pragma unroll
      for (int i = 0; i < 4; ++i) { *(u32x4*)(sA + (nb * 128 + lrow + 32 * i) * 72 + lseg) = ra[i]; *(u32x4*)(sB + (nb * 128 + lrow + 32 * i) * 72 + lseg) = rb[i]; }
    }
    __syncthreads();
  }
}

DI void zero_acc(f32x16 (&acc)[2][2]) {
#pragma unroll
  for (int i = 0; i < 2; ++i)
#pragma unroll
    for (int j = 0; j < 2; ++j)
#pragma unroll
      for (int r = 0; r < 16; ++r) acc[i][j][r] = 0.f;
}

DI void acc_to_lds(const f32x16 (&acc)[2][2], float* sC) {
  const int tid = get_tid(), lane = tid & 63, w = tid >> 6, wm = w >> 1, wn = w & 1, l31 = lane & 31, hh = lane >> 5;
#pragma unroll
  for (int i = 0; i < 2; ++i)
#pragma unroll
    for (int j = 0; j < 2; ++j)
#pragma unroll
      for (int r = 0; r < 16; ++r) {
        int row = 64 * wm + 32 * i + 8 * (r >> 2) + 4 * hh + (r & 3), col = 64 * wn + 32 * j + l31;
        sC[row * 132 + col] = acc[i][j][r];
      }
  __syncthreads();
}

struct TileIter {
  int local, step, total, nN, xcd; bool swz;
  DI void init(int nN_) {
    nN = nN_;
    swz = (gridDim.x & 7) == 0;
    if (swz) { xcd = blockIdx.x & 7; local = blockIdx.x >> 3; step = gridDim.x >> 3; total = 36 * nN; }
    else { xcd = 0; local = blockIdx.x; step = gridDim.x; total = 288 * nN; }
  }
  DI bool next(int& mt, int& nt) {
    if (local >= total) return false;
    if (swz) {
      const int per_sr = 8 * nN;
      const int sr = local / per_sr, r = local - sr * per_sr;
      const int rows = (36 - 8 * sr) < 8 ? (36 - 8 * sr) : 8;
      nt = r / rows; mt = 36 * xcd + 8 * sr + (r - nt * rows);
    } else { mt = local / nN; nt = local - mt * nN; }
    local += step;
    return true;
  }
};

DI void epi_inproj(const Params& p, int l, int mt, int nt, const float* sC) {
  const int tid = get_tid();
  const int chunk = tid & 15, lane = tid & 63;
  const int half = chunk >> 3, d0 = (chunk & 7) * 8;
  const int c0 = nt * 128 + half * 64;
  if (c0 >= NZ && c0 != 5120) return;
  bf16_t* Z = (bf16_t*)(p.ws + WS_Z);
  const float* bias = p.b_in + (size_t)l * NIN + c0;
  if (c0 == 5120) {
    if (chunk >= 2) return;
    const f32x4 b0 = *(const f32x4*)(bias + d0), b1 = *(const f32x4*)(bias + d0 + 4);
#pragma unroll
    for (int it = 0; it < 8; ++it) {
      const int rt = (tid >> 4) + 16 * it, grow = mt * 128 + rt;
      const float* crow = sC + rt * 132 + d0;
      f32x4 v0 = *(const f32x4*)crow + b0, v1 = *(const f32x4*)(crow + 4) + b1;
      if (chunk == 1) {
#pragma unroll
        for (int e = 0; e < 4; ++e) {
          v0[e] = fminf(v0[e], 0.f) - log1pf(__expf(-fabsf(v0[e])));
          v1[e] = fminf(v1[e], 0.f) - log1pf(__expf(-fabsf(v1[e])));
        }
      }
      float* IF = (float*)(p.ws + WS_IF) + (size_t)grow * 16 + d0;
      *(f32x4*)IF = v0; *(f32x4*)(IF + 4) = v1;
    }
    return;
  }
  bool hn = false, rope = false;
  const float* hg = nullptr;
  float scale = 1.f;
  int kvsel = -1, kvh = 0, kvH = 0; size_t kvbase = 0;
  if (c0 < NAK) {}
  else if (c0 < NAV) { kvbase = OUT_NA; kvsel = 0; kvh = (c0 - NAK) >> 6; kvH = 8; }
  else if (c0 < GQ) { kvbase = OUT_NA; kvsel = 1; kvh = (c0 - NAV) >> 6; kvH = 8; }
  else if (c0 < GK) { hn = true; hg = p.gqa_q_g + l * 64; rope = true; }
  else if (c0 < GV) { hn = true; hg = p.gqa_k_g + l * 64; rope = true; kvbase = OUT_GQA; kvsel = 0; kvh = (c0 - GK) >> 6; kvH = 2; }
  else if (c0 < SQ) { kvbase = OUT_GQA; kvsel = 1; kvh = (c0 - GV) >> 6; kvH = 2; }
  else if (c0 < SK) { rope = true; }
  else if (c0 < SV) { rope = true; kvbase = OUT_SWA; kvsel = 0; kvh = (c0 - SK) >> 6; kvH = 2; }
  else if (c0 < MQ) { kvbase = OUT_SWA; kvsel = 1; kvh = (c0 - SV) >> 6; kvH = 2; }
  else if (c0 >= MK && c0 < MV) { scale = 0.08838834764831845f; }
  if (c0 < NAK || (c0 >= GQ && c0 < GK) || (c0 >= SQ && c0 < SK)) scale = 0.125f * LOG2E;
  const bool latent_tile = mt >= 32;
  if (latent_tile) kvsel = -1; else rope = false;
  const int dp = d0 ^ 16;
  const bool second = (d0 & 16) != 0;
  const f32x4 b0 = *(const f32x4*)(bias + d0), b1 = *(const f32x4*)(bias + d0 + 4);
  f32x4 pb0 = b0, pb1 = b1, g0 = {1.f, 1.f, 1.f, 1.f}, g1 = g0, pg0 = g0, pg1 = g0;
  if (rope) { pb0 = *(const f32x4*)(bias + dp); pb1 = *(const f32x4*)(bias + dp + 4); }
  if (hn) {
    g0 = *(const f32x4*)(hg + d0); g1 = *(const f32x4*)(hg + d0 + 4);
    pg0 = *(const f32x4*)(hg + dp); pg1 = *(const f32x4*)(hg + dp + 4);
  }
  const float* rcos = (const float*)(p.ws + WS_ROPE);
  const float* rsin = rcos + 1024;
#pragma unroll 4
  for (int it = 0; it < 8; ++it) {
    const int rt = (tid >> 4) + 16 * it, grow = mt * 128 + rt;
    const float* crow = sC + rt * 132 + half * 64;
    f32x4 x0 = *(const f32x4*)(crow + d0) + b0, x1 = *(const f32x4*)(crow + d0 + 4) + b1;
    float rs = 1.f;
    if (hn) {
      float ss = x0[0] * x0[0] + x0[1] * x0[1] + x0[2] * x0[2] + x0[3] * x0[3] + x1[0] * x1[0] + x1[1] * x1[1] + x1[2] * x1[2] + x1[3] * x1[3];
      ss += shfl_xor_(ss, 1, lane); ss += shfl_xor_(ss, 2, lane); ss += shfl_xor_(ss, 4, lane);
      rs = rsqrtf(ss * (1.f / 64.f) + 1e-6f);
    }
    const float sc = rs * scale;
    x0 = x0 * sc * g0; x1 = x1 * sc * g1;
    if (rope) {
      f32x4 y0 = (*(const f32x4*)(crow + dp) + pb0) * sc * pg0, y1 = (*(const f32x4*)(crow + dp + 4) + pb1) * sc * pg1;
      const int t = (grow - TC) & 4095;
      const int pos = (d0 & 32) ? (t & 63) : (t >> 6);
      const int fj = d0 & 15;
      const f32x4 c0v = *(const f32x4*)(rcos + pos * 16 + fj), c1v = *(const f32x4*)(rcos + pos * 16 + fj + 4);
      const f32x4 s0v = *(const f32x4*)(rsin + pos * 16 + fj), s1v = *(const f32x4*)(rsin + pos * 16 + fj + 4);
      if (second) { x0 = x0 * c0v + y0 * s0v; x1 = x1 * c1v + y1 * s1v; }
      else { x0 = x0 * c0v - y0 * s0v; x1 = x1 * c1v - y1 * s1v; }
    }
    __builtin_nontemporal_store(u32x4{pk2(x0[0], x0[1]), pk2(x0[2], x0[3]), pk2(x1[0], x1[1]), pk2(x1[2], x1[3])}, (u32x4*)(Z + (size_t)grow * ZW + c0 + d0));
    if (kvsel >= 0) {
      const int cb = grow >> 8, cs = grow & 255;
      float* kv = p.out + kvbase + ((((size_t)(cb * 2 + l) * 2 + kvsel) * 256 + cs) * kvH + kvh) * 64 + d0;
      *(f32x4*)kv = x0; *(f32x4*)(kv + 4) = x1;
    }
  }
}

DI void phase_inproj(const Params& p, int l, char* smem) {
  const bf16_t* H = (const bf16_t*)(p.ws + WS_H);
  const bf16_t* W = (const bf16_t*)(p.ws + WS_WIN);
  TileIter ti; ti.init(41);
  for (int mt, nt; ti.next(mt, nt);) {
    f32x16 acc[2][2];
    zero_acc(acc);
    gemm_core(H + (size_t)mt * 128 * DM, DM, W + (size_t)nt * 128 * DM, DM, DM, acc, smem);
    acc_to_lds(acc, (float*)smem);
    epi_inproj(p, l, mt, nt, (const float*)smem);
  }
}

DI void phase_merge(const Params& p, int l, char* smem) {
  const int tid = get_tid(), lane = tid & 63, w = tid >> 6, wn = w & 1, l31 = lane & 31;
  const bf16_t* H = (const bf16_t*)(p.ws + WS_H);
  const bf16_t* W = (const bf16_t*)(p.ws + WS_WIN);
  const bf16_t* WB = (const bf16_t*)(p.ws + WS_WBR);
  bf16_t* Z = (bf16_t*)(p.ws + WS_Z);
  TileIter ti; ti.init(8);
  for (int mt, nt; ti.next(mt, nt);) {
    f32x16 mg[2][2];
    zero_acc(mg);
#pragma unroll 1
    for (int i = 0; i < 4; ++i) {
      f32x16 acc[2][2];
      zero_acc(acc);
      gemm_core<false>(H + (size_t)mt * 128 * DM, DM, W + (size_t)(NZ + i * 1024 + nt * 128) * DM, DM, DM, acc, smem);
      unsigned* sG = (unsigned*)(smem + 36864) + tid;
#pragma unroll
      for (int j = 0; j < 2; ++j) {
        float bj = p.b_in[(size_t)l * NIN + NZ + i * 1024 + nt * 128 + 64 * wn + 32 * j + l31];
#pragma unroll
        for (int ii = 0; ii < 2; ++ii)
#pragma unroll
          for (int r = 0; r < 8; ++r) sG[((ii * 2 + j) * 8 + r) * 256] = pk2(sigmoidf_(acc[ii][j][2 * r] + bj), sigmoidf_(acc[ii][j][2 * r + 1] + bj));
      }
      zero_acc(acc);
      const int colA = i == 0 ? NAQ : (i == 1 ? GQ : (i == 2 ? SQ : MQ));
      gemm_core<false>(Z + (size_t)mt * 128 * ZW + colA, ZW, WB + (size_t)(i * 1024 + nt * 128) * 512, 512, 512, acc, smem);
#pragma unroll
      for (int ii = 0; ii < 2; ++ii)
#pragma unroll
        for (int j = 0; j < 2; ++j)
#pragma unroll
          for (int r = 0; r < 8; ++r) {
            const unsigned gpv = sG[((ii * 2 + j) * 8 + r) * 256];
            mg[ii][j][2 * r] += bflo(gpv) * acc[ii][j][2 * r];
            mg[ii][j][2 * r + 1] += bfhi(gpv) * acc[ii][j][2 * r + 1];
          }
    }
    float* sC = (float*)smem;
    __syncthreads();
    acc_to_lds(mg, sC);
#pragma unroll
    for (int it = 0; it < 8; ++it) {
      const int rt = (tid >> 4) + 16 * it, ch = (tid & 15) * 8;
      const float* crow = sC + rt * 132 + ch;
      f32x4 a = *(const f32x4*)crow, b = *(const f32x4*)(crow + 4);
      __builtin_nontemporal_store(u32x4{pk2(a[0], a[1]), pk2(a[2], a[3]), pk2(b[0], b[1]), pk2(b[2], b[3])}, (u32x4*)(Z + (size_t)(mt * 128 + rt) * ZW + MGC + nt * 128 + ch));
    }
  }
}

DI void phase_resid(const Params& p, int l, int which, char* smem) {
  const int tid = get_tid();
  const bf16_t* Z = (const bf16_t*)(p.ws + WS_Z);
  const bf16_t* W = (const bf16_t*)(p.ws + (which == 0 ? WS_WOUT : WS_WF2));
  const int K = which == 0 ? 1024 : DFF;
  const int acol = which == 0 ? MGC : 0;
  const int goff = which == 0 ? 2048 : 5120;
  const float* mods = (const float*)(p.ws + WS_MODS);
  TileIter ti; ti.init(8);
  for (int mt, nt; ti.next(mt, nt);) {
    f32x16 acc[2][2];
    zero_acc(acc);
    gemm_core(Z + (size_t)mt * 128 * ZW + acol, ZW, W + (size_t)nt * 128 * K, K, K, acc, smem);
    float* sC = (float*)smem;
    acc_to_lds(acc, sC);
    const int n = nt * 128 + (tid & 31) * 4;
    const f32x4 g4 = *(const f32x4*)(mods + (size_t)(l * 9 + cond_of_row(mt * 128)) * 6144 + goff + n);
    const float* xbase = (which == 0 && l == 0) ? (mt < 32 ? p.x_prompt + (size_t)mt * 128 * 1024 : p.x_sample + (size_t)(mt * 128 - TC) * 1024)
                                                : p.out + (size_t)mt * 128 * 1024;
#pragma unroll 4
    for (int it = 0; it < 16; ++it) {
      const int rt = (tid >> 5) + 8 * it, grow = mt * 128 + rt;
      const f32x4 x4 = *(const f32x4*)(xbase + (size_t)rt * 1024 + n);
      const f32x4 c4 = *(const f32x4*)(sC + rt * 132 + (tid & 31) * 4);
      __builtin_nontemporal_store(x4 + g4 * c4, (f32x4*)(p.out + (size_t)grow * 1024 + n));
    }
  }
}

DI void phase_ffn1(const Params& p, int l, char* smem) {
  const int tid = get_tid();
  const bf16_t* H = (const bf16_t*)(p.ws + WS_H);
  const bf16_t* W = (const bf16_t*)(p.ws + WS_WF1);
  bf16_t* Z = (bf16_t*)(p.ws + WS_Z);
  TileIter ti; ti.init(44);
  for (int mt, nt; ti.next(mt, nt);) {
    f32x16 acc[2][2];
    zero_acc(acc);
    gemm_core(H + (size_t)mt * 128 * DM, DM, W + (size_t)nt * 128 * DM, DM, DM, acc, smem);
    float* sC = (float*)smem;
    acc_to_lds(acc, sC);
#pragma unroll
    for (int it = 0; it < 4; ++it) {
      const int rt = (tid >> 3) + 32 * it, ch = (tid & 7) * 8;
      const float* crow = sC + rt * 132 + ch;
      float o[8];
#pragma unroll
      for (int hq = 0; hq < 2; ++hq) {
        f32x4 gt = *(const f32x4*)(crow + 4 * hq), up = *(const f32x4*)(crow + 64 + 4 * hq);
#pragma unroll
        for (int e = 0; e < 4; ++e) o[4 * hq + e] = gt[e] / (1.f + __expf(-gt[e])) * up[e];
      }
      __builtin_nontemporal_store(u32x4{pk2(o[0], o[1]), pk2(o[2], o[3]), pk2(o[4], o[5]), pk2(o[6], o[7])}, (u32x4*)(Z + (size_t)(mt * 128 + rt) * ZW + nt * 64 + ch));
    }
  }
}

struct AttnArgs {
  const void* k1; const void* v1; int stride1; int f32_1; int nblk1;
  const bf16_t* k2; const bf16_t* v2; int blk0_2; int nblk2;
  bf16_t* qo;
  int qpos0;
  int mode;
  float m0, l0;
  const float* rpb;
};

DI void attn_item(const AttnArgs& a, char* smem) {
  bf16_t* sK = (bf16_t*)smem;
  bf16_t* sVt = sK + 2 * 64 * 72;
  float* sRpb = (float*)(smem + 4 * 64 * 72 * 2);
  const int tid = get_tid(), lane = tid & 63, l31 = lane & 31, hh = lane >> 5;
  const int dg = tid & 7, kp = tid >> 3;
  __syncthreads();
  if (a.mode == 2) for (int i = tid; i < 465; i += 256) sRpb[i] = a.rpb[i] * LOG2E;
  bf16x8 qf[4];
#pragma unroll
  for (int st = 0; st < 4; ++st) qf[st] = *(const bf16x8*)(a.qo + (size_t)l31 * ZW + 16 * st + 8 * hh);
  f32x16 o[2];
#pragma unroll
  for (int dt = 0; dt < 2; ++dt)
#pragma unroll
    for (int r = 0; r < 16; ++r) o[dt][r] = 0.f;
  float m_run = a.m0, l_run = a.l0;
  const int nblk = a.nblk1 + a.nblk2;
  u32x4 rk[2], rv[2];
  auto load_blk = [&](int b) {
    if (b < a.nblk1) {
      if (a.f32_1) {
        const float* kb = (const float*)a.k1 + (size_t)(b * 64 + 2 * kp) * a.stride1 + 8 * dg;
        const float* vb = (const float*)a.v1 + (size_t)(b * 64 + 2 * kp) * a.stride1 + 8 * dg;
#pragma unroll
        for (int i = 0; i < 2; ++i) {
          f32x4 k0 = *(const f32x4*)(kb + (size_t)i * a.stride1), k1 = *(const f32x4*)(kb + (size_t)i * a.stride1 + 4);
          f32x4 v0 = *(const f32x4*)(vb + (size_t)i * a.stride1), v1 = *(const f32x4*)(vb + (size_t)i * a.stride1 + 4);
          rk[i] = u32x4{pk2(k0[0], k0[1]), pk2(k0[2], k0[3]), pk2(k1[0], k1[1]), pk2(k1[2], k1[3])};
          rv[i] = u32x4{pk2(v0[0], v0[1]), pk2(v0[2], v0[3]), pk2(v1[0], v1[1]), pk2(v1[2], v1[3])};
        }
      } else {
        const bf16_t* kb = (const bf16_t*)a.k1 + (size_t)(b * 64 + 2 * kp) * a.stride1 + 8 * dg;
        const bf16_t* vb = (const bf16_t*)a.v1 + (size_t)(b * 64 + 2 * kp) * a.stride1 + 8 * dg;
#pragma unroll
        for (int i = 0; i < 2; ++i) { rk[i] = *(const u32x4*)(kb + (size_t)i * a.stride1); rv[i] = *(const u32x4*)(vb + (size_t)i * a.stride1); }
      }
    } else {
      const int kb0 = (a.blk0_2 + (b - a.nblk1)) * 64 + 2 * kp;
      const bf16_t* kb = a.k2 + (size_t)kb0 * ZW + 8 * dg;
      const bf16_t* vb = a.v2 + (size_t)kb0 * ZW + 8 * dg;
#pragma unroll
      for (int i = 0; i < 2; ++i) { rk[i] = *(const u32x4*)(kb + (size_t)i * ZW); rv[i] = *(const u32x4*)(vb + (size_t)i * ZW); }
    }
  };
  auto store_blk = [&](int buf) {
    bf16_t* k = sK + buf * 64 * 72; bf16_t* v = sVt + buf * 64 * 72;
    *(u32x4*)(k + (2 * kp) * 72 + 8 * dg) = rk[0];
    *(u32x4*)(k + (2 * kp + 1) * 72 + 8 * dg) = rk[1];
#pragma unroll
    for (int e = 0; e < 4; ++e) {
      unsigned a0 = rv[0][e], a1 = rv[1][e];
      *(unsigned*)(v + (8 * dg + 2 * e) * 72 + 2 * (kp ^ (4 * dg))) = (a0 & 0xffffu) | (a1 << 16);
      *(unsigned*)(v + (8 * dg + 2 * e + 1) * 72 + 2 * (kp ^ (4 * dg))) = (a0 >> 16) | (a1 & 0xffff0000u);
    }
  };
  load_blk(0);
  store_blk(0);
  if (nblk > 1) load_blk(1);
  __syncthreads();
  for (int b = 0; b < nblk; ++b) {
    const bf16_t* cK = sK + (b & 1) * 64 * 72;
    const bf16_t* cV = sVt + (b & 1) * 64 * 72;
    f32x16 s[2];
#pragma unroll
    for (int kt = 0; kt < 2; ++kt)
#pragma unroll
      for (int r = 0; r < 16; ++r) s[kt][r] = 0.f;
#pragma unroll
    for (int st = 0; st < 4; ++st) {
      bf16x8 k0 = *(const bf16x8*)(cK + l31 * 72 + 16 * st + 8 * hh);
      bf16x8 k1 = *(const bf16x8*)(cK + (32 + l31) * 72 + 16 * st + 8 * hh);
      s[0] = MFMA(k0, qf[st], s[0]);
      s[1] = MFMA(k1, qf[st], s[1]);
    }
    const bool seg2 = b >= a.nblk1;
    if (seg2 && a.mode == 1) {
      const int kbase = (a.blk0_2 + (b - a.nblk1)) * 64;
      const int qpos = a.qpos0 + l31;
#pragma unroll
      for (int kt = 0; kt < 2; ++kt)
#pragma unroll
        for (int r = 0; r < 16; ++r) {
          int kpos = kbase + 32 * kt + 8 * (r >> 2) + 4 * hh + (r & 3);
          int dd = qpos - kpos; dd = dd < 0 ? -dd : dd;
          s[kt][r] = dd <= 128 ? s[kt][r] : -INFINITY;
        }
    } else if (seg2 && a.mode == 2) {
      const int kr = a.blk0_2 + (b - a.nblk1);
      const int qpos = a.qpos0 + l31;
      const int qr = qpos >> 6, qc = qpos & 63;
      int rs = qr - 4; rs = rs < 0 ? 0 : (rs > 56 ? 56 : rs);
      int cs = qc - 8; cs = cs < 0 ? 0 : (cs > 48 ? 48 : cs);
      const bool rowok = kr >= rs && kr <= rs + 7;
      const int bbase = (kr - qr + 7) * 31 - qc + 15;
#pragma unroll
      for (int kt = 0; kt < 2; ++kt)
#pragma unroll
        for (int r = 0; r < 16; ++r) {
          int kc = 32 * kt + 8 * (r >> 2) + 4 * hh + (r & 3);
          bool ok = rowok && (unsigned)(kc - cs) < 16u;
          const float bias = sRpb[ok ? bbase + kc : 0];
          s[kt][r] = ok ? s[kt][r] + bias : -INFINITY;
        }
    }
    float mx = -INFINITY;
#pragma unroll
    for (int kt = 0; kt < 2; ++kt)
#pragma unroll
      for (int r = 0; r < 16; ++r) mx = fmaxf(mx, s[kt][r]);
    mx = fmaxf(mx, shfl_xor_(mx, 32, lane));
    const float m_new = fmaxf(m_run, mx);
    if (__builtin_amdgcn_ballot_w64(m_new > m_run) != 0ull) {
      const float alpha = __builtin_amdgcn_exp2f(m_run - m_new);
      l_run *= alpha;
#pragma unroll
      for (int dt = 0; dt < 2; ++dt)
#pragma unroll
        for (int r = 0; r < 16; ++r) o[dt][r] *= alpha;
      m_run = m_new;
    }
    float ps = 0.f;
#pragma unroll
    for (int kt = 0; kt < 2; ++kt)
#pragma unroll
      for (int r = 0; r < 16; ++r) { float e = __builtin_amdgcn_exp2f(s[kt][r] - m_run); s[kt][r] = e; ps += e; }
    ps += shfl_xor_(ps, 32, lane);
    l_run += ps;
#pragma unroll
    for (int kt = 0; kt < 2; ++kt)
#pragma unroll
      for (int s2 = 0; s2 < 2; ++s2) {
        u32x4 pb = {pk2(s[kt][8 * s2 + 0], s[kt][8 * s2 + 1]), pk2(s[kt][8 * s2 + 2], s[kt][8 * s2 + 3]),
                    pk2(s[kt][8 * s2 + 4], s[kt][8 * s2 + 5]), pk2(s[kt][8 * s2 + 6], s[kt][8 * s2 + 7])};
#pragma unroll
        for (int dt = 0; dt < 2; ++dt) {
          const int rg = (4 * dt + (l31 >> 3)) & 7;
          const bf16_t* vrow = cV + (32 * dt + l31) * 72 + 4 * hh;
          u32x2 lo = *(const u32x2*)(vrow + 8 * ((4 * kt + 2 * s2) ^ rg)), hi = *(const u32x2*)(vrow + 8 * ((4 * kt + 2 * s2 + 1) ^ rg));
          o[dt] = MFMA(as_bf8(u32x4{lo[0], lo[1], hi[0], hi[1]}), as_bf8(pb), o[dt]);
        }
      }
    if (b + 1 < nblk) store_blk((b + 1) & 1);
    if (b + 2 < nblk) load_blk(b + 2);
    __builtin_amdgcn_sched_barrier(0);
    __syncthreads();
  }
  const float inv = 1.f / l_run;
#pragma unroll
  for (int dt = 0; dt < 2; ++dt)
#pragma unroll
    for (int g = 0; g < 4; ++g) {
      *(u32x2*)(a.qo + (size_t)l31 * ZW + 32 * dt + 8 * g + 4 * hh) =
          u32x2{pk2(o[dt][4 * g] * inv, o[dt][4 * g + 1] * inv), pk2(o[dt][4 * g + 2] * inv, o[dt][4 * g + 3] * inv)};
    }
}

DI float wave_scan_sum(float v, int lane) {
#pragma unroll
  for (int o = 1; o < 64; o <<= 1) { float t = shfl_up_(v, o, lane); if (lane >= o) v += t; }
  return v;
}
DI float wave_scan_max(float v, int lane) {
#pragma unroll
  for (int o = 1; o < 64; o <<= 1) { float t = shfl_up_(v, o, lane); if (lane >= o) v = fmaxf(v, t); }
  return v;
}

#define RLX_AGENT __ATOMIC_RELAXED, __HIP_MEMORY_SCOPE_AGENT
DI void mlstm_item(const Params& p, char* smem, int l, int b, int h, int eh, int dir, bool latent, int* prog_self, int* prog_partner) {
  bf16_t* sQ = (bf16_t*)smem;
  bf16_t* sK = sQ + 64 * 136;
  bf16_t* sKw = sK + 64 * 136;
  bf16_t* sVt = sKw + 128 * 72;
  float* sN = (float*)(sVt + 64 * 72);
  float* sA = sN + 128;
  const int tid = get_tid();
  const int S = latent ? 4096 : 256, nc = S >> 6, half = nc >> 1;
  const int rowbase = latent ? TC + b * 4096 : b * 256;
  bf16_t* Z = (bf16_t*)(p.ws + WS_Z);
  bf16_t* HB = (bf16_t*)(p.ws + WS_HB);
  const float* IF = (const float*)(p.ws + WS_IF);
  f32x16 C[4];
  float m_state = 0.f;
  __syncthreads();
  {
    const int lane = tid & 63, w = tid >> 6, l31 = lane & 31, hh = lane >> 5, et = w & 1;
    if (latent) {
      const size_t sidx = (size_t)((b * 2 + l) * 2 + dir) * 4 + h;
      const float* C0 = p.st_C + sidx * 128 * 128;
      int cidx0 = 4 * hh * 128 + 64 * eh + 32 * et + l31; asm volatile("" : "+v"(cidx0));
#pragma unroll
      for (int dt = 0; dt < 4; ++dt) {
#pragma unroll
        for (int r = 0; r < 16; ++r) C[dt][r] = C0[(unsigned)(cidx0 + (32 * dt + 8 * (r >> 2) + (r & 3)) * 128)];
        __builtin_amdgcn_sched_barrier(0);
      }
      if (tid < 128) sN[tid] = p.st_n[sidx * 128 + tid];
      m_state = p.st_m[sidx];
    } else {
#pragma unroll
      for (int dt = 0; dt < 4; ++dt)
#pragma unroll
        for (int r = 0; r < 16; ++r) C[dt][r] = 0.f;
      if (tid < 128) sN[tid] = 0.f;
    }
  }
  float ip_n, lf_n;
  u32x4 rq[4], rkk[4], rvv[2];
  auto prefetch = [&](int c) {
    const int cbase = rowbase + (dir ? (nc - 1 - c) * 64 : c * 64);
    int tidc = tid; asm volatile("" : "+v"(tidc));
    const int lane = tidc & 63;
    const int tokp = cbase + (dir ? 63 - lane : lane);
    ip_n = IF[(size_t)tokp * 16 + dir * 4 + h];
    lf_n = IF[(size_t)tokp * 16 + 8 + dir * 4 + h];
#pragma unroll
    for (int i = 0; i < 4; ++i) {
      int id = tidc + 256 * i, pr = id >> 4, seg = (id & 15) * 8;
      int tok = cbase + (dir ? 63 - pr : pr);
      rq[i] = *(const u32x4*)(Z + (size_t)tok * ZW + MQ + h * 128 + seg);
    }
    const int dgp = (tidc & 15) * 8;
#pragma unroll
    for (int i = 0; i < 2; ++i) {
      const int s0 = 2 * ((tidc >> 4) + 16 * i), s1 = s0 + 1;
      const int t0 = cbase + (dir ? 63 - s0 : s0), t1 = cbase + (dir ? 63 - s1 : s1);
      rkk[2 * i] = *(const u32x4*)(Z + (size_t)t0 * ZW + MK + h * 128 + dgp);
      rkk[2 * i + 1] = *(const u32x4*)(Z + (size_t)t1 * ZW + MK + h * 128 + dgp);
    }
    {
      const int dgv = (tidc & 7) * 8, s0 = 2 * (tidc >> 3), s1 = s0 + 1;
      const int t0 = cbase + (dir ? 63 - s0 : s0), t1 = cbase + (dir ? 63 - s1 : s1);
      rvv[0] = *(const u32x4*)(Z + (size_t)t0 * ZW + MV + h * 128 + 64 * eh + dgv);
      rvv[1] = *(const u32x4*)(Z + (size_t)t1 * ZW + MV + h * 128 + 64 * eh + dgv);
    }
  };
  prefetch(0);
#pragma unroll 1
  for (int c = 0; c < nc; ++c) {
    const int cbase = rowbase + (dir ? (nc - 1 - c) * 64 : c * 64);
    int tidc = tid; asm volatile("" : "+v"(tidc));
    const int lane = tidc & 63, w = tidc >> 6, l31 = lane & 31, hh = lane >> 5, et = w & 1, tt = w >> 1;
    const float ip = ip_n, lf = lf_n;
    const float bcum = wave_scan_sum(lf, lane);
    const float av = ip - bcum;
    const float pm = wave_scan_max(av, lane);
    const float Mv = fmaxf(m_state, pm);
    const float Mlast = shfl_(Mv, 63), blast = shfl_(bcum, 63);
    const float wsv = __expf(av - Mlast);
    const float decay = __expf(m_state - Mlast);
    __syncthreads();
#pragma unroll
    for (int i = 0; i < 4; ++i) {
      int id = tidc + 256 * i, pr = id >> 4, seg = (id & 15) * 8;
      *(u32x4*)(sQ + pr * 136 + seg) = rq[i];
    }
    {
      const int dgp = (tidc & 15) * 8;
#pragma unroll
      for (int i = 0; i < 2; ++i) {
        const int s0 = 2 * ((tidc >> 4) + 16 * i), s1 = s0 + 1;
        const u32x4 k0 = rkk[2 * i], k1 = rkk[2 * i + 1];
        *(u32x4*)(sK + s0 * 136 + dgp) = k0;
        *(u32x4*)(sK + s1 * 136 + dgp) = k1;
        const float w0 = shfl_(wsv, s0), w1 = shfl_(wsv, s1);
#pragma unroll
        for (int e = 0; e < 4; ++e) {
          const int sw = 2 * ((s0 >> 1) ^ (4 * ((tidc & 15) & 7)));
          *(unsigned*)(sKw + (dgp + 2 * e) * 72 + sw) = pk2(bflo(k0[e]) * w0, bflo(k1[e]) * w1);
          *(unsigned*)(sKw + (dgp + 2 * e + 1) * 72 + sw) = pk2(bfhi(k0[e]) * w0, bfhi(k1[e]) * w1);
        }
      }
      const int dgv = (tidc & 7) * 8, sv0 = 2 * (tidc >> 3);
#pragma unroll
      for (int e = 0; e < 4; ++e) {
        const int svw = 2 * ((sv0 >> 1) ^ (4 * (tidc & 7)));
        *(unsigned*)(sVt + (dgv + 2 * e) * 72 + svw) = (rvv[0][e] & 0xffffu) | (rvv[1][e] << 16);
        *(unsigned*)(sVt + (dgv + 2 * e + 1) * 72 + svw) = (rvv[0][e] >> 16) | (rvv[1][e] & 0xffff0000u);
      }
    }
    if (w == 0) sA[lane] = av;
    __syncthreads();
    if (c + 1 < nc) prefetch(c + 1);
    __builtin_amdgcn_sched_barrier(0);
    const int t = 32 * tt + l31;
    const int tok = cbase + (dir ? 63 - t : t);
    const bool finisher = c >= half;
    u32x2 og[4];
    if (finisher) {
#pragma unroll
      for (int g = 0; g < 4; ++g) og[g] = *(const u32x2*)(Z + (size_t)tok * ZW + MO + h * 128 + 64 * eh + 32 * et + 8 * g + 4 * hh);
    }
    float inv;
    f32x16 acc;
    {
      const float Mt = shfl_(Mv, t), bt = shfl_(bcum, t);
      const float winter = __expf(m_state - Mt);
#pragma unroll
      for (int r = 0; r < 16; ++r) acc[r] = 0.f;
#pragma unroll
      for (int dt = 0; dt < 4; ++dt)
#pragma unroll
        for (int s2 = 0; s2 < 2; ++s2) {
          u32x4 ca = {pk2(C[dt][8 * s2 + 0], C[dt][8 * s2 + 1]), pk2(C[dt][8 * s2 + 2], C[dt][8 * s2 + 3]),
                      pk2(C[dt][8 * s2 + 4], C[dt][8 * s2 + 5]), pk2(C[dt][8 * s2 + 6], C[dt][8 * s2 + 7])};
          const bf16_t* qp = sQ + t * 136 + 32 * dt + 16 * s2 + 4 * hh;
          u32x2 lo = *(const u32x2*)qp, hi = *(const u32x2*)(qp + 8);
          acc = MFMA(as_bf8(ca), as_bf8(u32x4{lo[0], lo[1], hi[0], hi[1]}), acc);
        }
#pragma unroll
      for (int r = 0; r < 16; ++r) acc[r] *= winter;
      float qv = 0.f;
#pragma unroll
      for (int j = 0; j < 8; ++j) {
        u32x4 q8 = *(const u32x4*)(sQ + t * 136 + 64 * hh + 8 * j);
        f32x4 n0 = *(const f32x4*)(sN + 64 * hh + 8 * j), n1 = *(const f32x4*)(sN + 64 * hh + 8 * j + 4);
        qv += bflo(q8[0]) * n0[0] + bfhi(q8[0]) * n0[1] + bflo(q8[1]) * n0[2] + bfhi(q8[1]) * n0[3] +
              bflo(q8[2]) * n1[0] + bfhi(q8[2]) * n1[1] + bflo(q8[3]) * n1[2] + bfhi(q8[3]) * n1[3];
      }
      qv += shfl_xor_(qv, 32, lane);
      float rsv = 0.f;
#pragma unroll
      for (int st = 0; st < 2; ++st) {
        f32x16 sm;
#pragma unroll
        for (int r = 0; r < 16; ++r) sm[r] = 0.f;
#pragma unroll
        for (int ks = 0; ks < 8; ++ks) {
          bf16x8 ka = *(const bf16x8*)(sK + (32 * st + l31) * 136 + 16 * ks + 8 * hh);
          bf16x8 qb = *(const bf16x8*)(sQ + t * 136 + 16 * ks + 8 * hh);
          sm = MFMA(ka, qb, sm);
        }
#pragma unroll
        for (int g = 0; g < 4; ++g) {
          f32x4 a4 = *(const f32x4*)(sA + 32 * st + 8 * g + 4 * hh);
#pragma unroll
          for (int e = 0; e < 4; ++e) {
            const int s = 32 * st + 8 * g + 4 * hh + e;
            float wgt = s <= t ? __expf(a4[e] - Mt) : 0.f;
            float v = sm[4 * g + e] * wgt;
            sm[4 * g + e] = v;
            rsv += v;
          }
        }
#pragma unroll
        for (int s2 = 0; s2 < 2; ++s2) {
          const int rgv = (4 * et + (l31 >> 3)) & 7;
          const bf16_t* vrow = sVt + (32 * et + l31) * 72 + 4 * hh;
          u32x2 lo = *(const u32x2*)(vrow + 8 * ((4 * st + 2 * s2) ^ rgv)), hi = *(const u32x2*)(vrow + 8 * ((4 * st + 2 * s2 + 1) ^ rgv));
          u32x4 pb = {pk2(sm[8 * s2 + 0], sm[8 * s2 + 1]), pk2(sm[8 * s2 + 2], sm[8 * s2 + 3]),
                      pk2(sm[8 * s2 + 4], sm[8 * s2 + 5]), pk2(sm[8 * s2 + 6], sm[8 * s2 + 7])};
          acc = MFMA(as_bf8(u32x4{lo[0], lo[1], hi[0], hi[1]}), as_bf8(pb), acc);
        }
      }
      rsv += shfl_xor_(rsv, 32, lane);
      const float den = winter * qv + rsv;
      inv = 1.f / fmaxf(fabsf(den), __expf(-(bt + Mt)));
    }
#pragma unroll
    for (int dt = 0; dt < 4; ++dt) {
#pragma unroll
      for (int r = 0; r < 16; ++r) C[dt][r] *= decay;
#pragma unroll
      for (int ks = 0; ks < 4; ++ks) {
        bf16x8 ka = *(const bf16x8*)(sKw + (32 * dt + l31) * 72 + 8 * ((2 * ks + hh) ^ ((4 * dt + (l31 >> 3)) & 7)));
        bf16x8 vb = *(const bf16x8*)(sVt + (32 * et + l31) * 72 + 8 * ((2 * ks + hh) ^ ((4 * et + (l31 >> 3)) & 7)));
        C[dt] = MFMA(ka, vb, C[dt]);
      }
    }
    {
      unsigned long long* hbp = (unsigned long long*)(HB + (size_t)tok * 512 + h * 128 + 64 * eh + 32 * et + 4 * hh);
      if (!finisher) {
#pragma unroll
        for (int g = 0; g < 4; ++g) {
          const unsigned lo = pk2(acc[4 * g] * inv, acc[4 * g + 1] * inv), hi = pk2(acc[4 * g + 2] * inv, acc[4 * g + 3] * inv);
          __hip_atomic_store(hbp + 2 * g, ((unsigned long long)hi << 32) | lo, RLX_AGENT);
        }
        asm volatile("s_waitcnt vmcnt(0)" ::: "memory");
      } else {
        const int need = nc - c;
        unsigned spins = 0;
        while (__builtin_amdgcn_readfirstlane(__hip_atomic_load(prog_partner, RLX_AGENT)) < need) {
          __builtin_amdgcn_s_sleep(1);
          if (++spins > (1u << 24)) break;
        }
        __builtin_amdgcn_fence(__ATOMIC_ACQUIRE, "agent");
#pragma unroll
        for (int g = 0; g < 4; ++g) {
          const unsigned long long hb = hbp[2 * g];
          const unsigned hlo = (unsigned)hb, hhi = (unsigned)(hb >> 32);
          const float y0 = (acc[4 * g] * inv + bflo(hlo)) * sigmoidf_(bflo(og[g][0]));
          const float y1 = (acc[4 * g + 1] * inv + bfhi(hlo)) * sigmoidf_(bfhi(og[g][0]));
          const float y2 = (acc[4 * g + 2] * inv + bflo(hhi)) * sigmoidf_(bflo(og[g][1]));
          const float y3 = (acc[4 * g + 3] * inv + bfhi(hhi)) * sigmoidf_(bfhi(og[g][1]));
          hbp[2 * g] = ((unsigned long long)pk2(y2, y3) << 32) | pk2(y0, y1);
        }
      }
    }
    __syncthreads();
    if (!finisher && tidc == 0) __hip_atomic_store(prog_self, c + 1, RLX_AGENT);
    if (tidc < 128) {
      float sum = 0.f;
#pragma unroll
      for (int j = 0; j < 8; ++j) {
        u32x4 k8 = *(const u32x4*)(sKw + tidc * 72 + 8 * j);
        sum += bflo(k8[0]) + bfhi(k8[0]) + bflo(k8[1]) + bfhi(k8[1]) + bflo(k8[2]) + bfhi(k8[2]) + bflo(k8[3]) + bfhi(k8[3]);
      }
      sN[tidc] = decay * sN[tidc] + sum;
    }
    m_state = blast + Mlast;
  }
  if (!latent) {
    const int lane = tid & 63, w = tid >> 6, l31 = lane & 31, hh = lane >> 5, et = w & 1, tt = w >> 1;
    const size_t sidx = (size_t)((b * 2 + l) * 2 + dir) * 4 + h;
    float* Co = p.out + OUT_C + sidx * 128 * 128;
    if (tt == 0) {
      int cidx1 = 4 * hh * 128 + 64 * eh + 32 * et + l31; asm volatile("" : "+v"(cidx1));
#pragma unroll
      for (int dt = 0; dt < 4; ++dt) {
#pragma unroll
        for (int r = 0; r < 16; ++r) Co[(unsigned)(cidx1 + (32 * dt + 8 * (r >> 2) + (r & 3)) * 128)] = C[dt][r];
        __builtin_amdgcn_sched_barrier(0);
      }
    }
    __syncthreads();
    if (eh == 0) {
      if (tid < 128) p.out[OUT_N + sidx * 128 + tid] = sN[tid];
      if (tid == 0) p.out[OUT_M + sidx] = m_state;
    }
  }
}

DI void mlstm_norm_phase(const Params& p, int l) {
  const int tid = get_tid(), lane = tid & 63, w = tid >> 6;
  const bf16_t* HB = (const bf16_t*)(p.ws + WS_HB);
  bf16_t* Z = (bf16_t*)(p.ws + WS_Z);
  const float* g = p.ml_g + l * 512 + lane * 8;
  const f32x4 g0 = *(const f32x4*)g, g1 = *(const f32x4*)(g + 4);
  for (int row = blockIdx.x * 4 + w; row < TT; row += gridDim.x * 4) {
    u32x4 y = *(const u32x4*)(HB + (size_t)row * 512 + lane * 8);
    float v[8] = {bflo(y[0]), bfhi(y[0]), bflo(y[1]), bfhi(y[1]), bflo(y[2]), bfhi(y[2]), bflo(y[3]), bfhi(y[3])};
    float ss = 0.f;
#pragma unroll
    for (int e = 0; e < 8; ++e) ss += v[e] * v[e];
#pragma unroll
    for (int o = 8; o >= 1; o >>= 1) ss += shfl_xor_(ss, o, lane);
    const float rstd = rsqrtf(ss * (1.f / 128.f) + 1e-6f);
    *(u32x4*)(Z + (size_t)row * ZW + MQ + lane * 8) =
        u32x4{pk2(v[0] * rstd * g0[0], v[1] * rstd * g0[1]), pk2(v[2] * rstd * g0[2], v[3] * rstd * g0[3]),
              pk2(v[4] * rstd * g1[0], v[5] * rstd * g1[1]), pk2(v[6] * rstd * g1[2], v[7] * rstd * g1[3])};
  }
}

constexpr int MIX_ITEMS = 7296;
DI void phase_mixers(const Params& p, int l, char* smem) {
  __shared__ int s_item;
  const int tid = get_tid();
  int* cnt = (int*)(p.ws + WS_CNT) + l;
  auto draw = [&]() -> int {
    __syncthreads();
    if (tid == 0) s_item = atomicAdd(cnt, 1);
    __syncthreads();
    return __builtin_amdgcn_readfirstlane(s_item);
  };
  int item = draw();
  while (item < 384) {
    const bool lat = item < 128;
    const int j = lat ? item : item - 128;
    int* prog = (int*)(p.ws + WS_CNT) + 16 + l * 384;
    mlstm_item(p, smem, l, j >> 4, (j >> 2) & 3, (j >> 1) & 1, j & 1, lat, prog + item, prog + (item ^ 1));
    item = draw();
  }
#ifndef NO_ATTN
  const int w = __builtin_amdgcn_readfirstlane(get_tid() >> 6);
  bf16_t* Z = (bf16_t*)(p.ws + WS_Z);
  for (; item < MIX_ITEMS; item = draw()) {
    AttnArgs a;
    a.k2 = nullptr; a.v2 = nullptr; a.blk0_2 = 0; a.nblk2 = 0; a.mode = 0; a.m0 = -INFINITY; a.l0 = 0.f; a.rpb = nullptr; a.qpos0 = 0;
    a.nblk1 = 4;
    if (item < 2432) {
      int j = item - 384, qt = j & 127, kv = (j >> 7) & 1, b = j >> 8;
      const float* cb = p.cache_gqa + (size_t)((b * 2 + l) * 2) * 256 * 128 + kv * 64;
      a.k1 = cb; a.v1 = cb + 256 * 128; a.stride1 = 128; a.f32_1 = 1;
      bf16_t* zb = Z + (size_t)(TC + b * 4096) * ZW;
      a.k2 = zb + GK + kv * 64; a.v2 = zb + GV + kv * 64; a.blk0_2 = 0; a.nblk2 = 64;
      a.qo = zb + (size_t)(qt * 32) * ZW + GQ + (kv * 4 + w) * 64;
    } else if (item < 4480) {
      int j = item - 2432, qt = j & 127, kv = (j >> 7) & 1, b = j >> 8;
      const float* cb = p.cache_swa + (size_t)((b * 2 + l) * 2) * 256 * 128 + kv * 64;
      a.k1 = cb; a.v1 = cb + 256 * 128; a.stride1 = 128; a.f32_1 = 1;
      bf16_t* zb = Z + (size_t)(TC + b * 4096) * ZW;
      a.k2 = zb + SK + kv * 64; a.v2 = zb + SV + kv * 64;
      const int q0 = qt * 32;
      int lo = q0 - 128; lo = lo < 0 ? 0 : lo;
      int hi = q0 + 31 + 128; hi = hi > 4095 ? 4095 : hi;
      a.blk0_2 = lo >> 6; a.nblk2 = (hi >> 6) - (lo >> 6) + 1;
      a.qo = zb + (size_t)q0 * ZW + SQ + (kv * 4 + w) * 64;
      a.qpos0 = q0; a.mode = 1;
      a.m0 = p.swa_sink[l * 8 + kv * 4 + w] * LOG2E; a.l0 = 1.f;
    } else if (item < 6528) {
      int j = item - 4480, rp = j & 31, h = (j >> 5) & 7, b = j >> 8;
      const float* cb = p.cache_na + (size_t)((b * 2 + l) * 2) * 256 * 512 + h * 64;
      a.k1 = cb; a.v1 = cb + 256 * 512; a.stride1 = 512; a.f32_1 = 1;
      bf16_t* zb = Z + (size_t)(TC + b * 4096) * ZW;
      a.k2 = zb + NAK + h * 64; a.v2 = zb + NAV + h * 64;
      int r0 = 2 * rp, r1 = r0 + 1;
      int rs0 = r0 - 4; rs0 = rs0 < 0 ? 0 : (rs0 > 56 ? 56 : rs0);
      int rs1 = r1 - 4; rs1 = rs1 < 0 ? 0 : (rs1 > 56 ? 56 : rs1);
      a.blk0_2 = rs0; a.nblk2 = rs1 + 8 - rs0;
      const int q0 = (r0 + (w >> 1)) * 64 + 32 * (w & 1);
      a.qo = zb + (size_t)q0 * ZW + NAQ + h * 64;
      a.qpos0 = q0; a.mode = 2; a.rpb = p.na_rpb + (size_t)(l * 8 + h) * 465;
    } else if (item < 6784) {
      int j = item - 6528, qtile = j & 1, h = (j >> 1) & 7, b = j >> 4;
      bf16_t* zb = Z + (size_t)(b * 256) * ZW;
      a.k1 = zb + NAK + h * 64; a.v1 = zb + NAV + h * 64; a.stride1 = ZW; a.f32_1 = 0;
      a.qo = zb + (size_t)(qtile * 128 + 32 * w) * ZW + NAQ + h * 64;
    } else if (item < 7040) {
      int j = item - 6784, qt = j & 7, kv = (j >> 3) & 1, b = j >> 4;
      bf16_t* zb = Z + (size_t)(b * 256) * ZW;
      a.k1 = zb + GK + kv * 64; a.v1 = zb + GV + kv * 64; a.stride1 = ZW; a.f32_1 = 0;
      a.qo = zb + (size_t)(qt * 32) * ZW + GQ + (kv * 4 + w) * 64;
    } else {
      int j = item - 7040, qt = j & 7, kv = (j >> 3) & 1, b = j >> 4;
      bf16_t* zb = Z + (size_t)(b * 256) * ZW;
      a.k1 = zb + SK + kv * 64; a.v1 = zb + SV + kv * 64; a.stride1 = ZW; a.f32_1 = 0;
      a.qo = zb + (size_t)(qt * 32) * ZW + SQ + (kv * 4 + w) * 64;
      a.m0 = p.swa_sink[l * 8 + kv * 4 + w] * LOG2E; a.l0 = 1.f;
    }
    attn_item(a, smem);
  }
#endif
}

#define XB_TMO      128
#define XB_XCNT(j)  (256  + 64 * (j))
#define XB_XSUB(j)  (1280 + 64 * (j))
#define XB_XGEN(j)  (2304 + 64 * (j))
#define XB_TOP      3328
#define XB_TOPGEN   3392
#define XCD_BAR_WORDS 3456
#define XB_SPIN_CAP (1u << 18)
#define LAS __attribute__((address_space(3)))
DI unsigned xb_ld(unsigned* p) { return __hip_atomic_load(p, __ATOMIC_RELAXED, __HIP_MEMORY_SCOPE_AGENT); }
DI unsigned xb_add(unsigned* p, unsigned v) { return __hip_atomic_fetch_add(p, v, __ATOMIC_RELAXED, __HIP_MEMORY_SCOPE_AGENT); }
DI unsigned xb_xcc_id() { return (unsigned)__builtin_amdgcn_s_getreg((3 << 11) | 20) & 0xFu; }
#define XB_SPIN(cond, bar) do { unsigned _sp = 0; while (cond) { __builtin_amdgcn_s_sleep(1); \
    if ((++_sp & 255u) == 0u) { if (xb_ld(&(bar)[XB_TMO])) break; if (_sp > XB_SPIN_CAP) { atomicAdd(&(bar)[XB_TMO], 1u); break; } } } } while (0)
struct XcdBarrier { unsigned* bar; unsigned x; volatile LAS unsigned* st; };
DI XcdBarrier xcd_barrier_post(unsigned* bar, volatile LAS unsigned* st) {
  XcdBarrier b; b.bar = bar; b.x = xb_xcc_id(); b.st = st;
  if (threadIdx.x == 0) (void)xb_add(&bar[XB_XCNT(b.x)], 1u);
  return b;
}
DI void xcd_barrier_complete(unsigned* bar, unsigned x, unsigned& nloc, unsigned& nx) {
  const unsigned G = gridDim.x * gridDim.y * gridDim.z;
  unsigned sum, cnt, mine, sp = 0u;
  for (;;) {
    sum = 0u; cnt = 0u; mine = 0u;
#pragma unroll
    for (unsigned j = 0; j < 16; ++j) { const unsigned c = xb_ld(&bar[XB_XCNT(j)]); sum += c; cnt += (c > 0u) ? 1u : 0u; mine = (j == x) ? c : mine; }
    if (sum == G) break;
    __builtin_amdgcn_s_sleep(1);
    if ((++sp & 255u) == 0u) { if (xb_ld(&bar[XB_TMO])) break; if (sp > XB_SPIN_CAP) { atomicAdd(&bar[XB_TMO], 1u); break; } }
  }
  nloc = mine > 0u ? mine : 1u; nx = cnt > 0u ? cnt : 1u;
}
DI void xcd_barrier(const XcdBarrier& b) {
  asm volatile("s_waitcnt vmcnt(0)" ::: "memory");
  __syncthreads();
  if (threadIdx.x == 0) {
    unsigned* bar = b.bar;
    __builtin_amdgcn_s_waitcnt(0);
    unsigned nloc = b.st[0], nx = b.st[1];
    if (nloc == 0u) { xcd_barrier_complete(bar, b.x, nloc, nx); b.st[0] = nloc; b.st[1] = nx; }
    const unsigned old = xb_add(&bar[XB_XSUB(b.x)], 1u);
    const unsigned gen = old / nloc;
    if (old + 1u == (gen + 1u) * nloc) {
      __builtin_amdgcn_fence(__ATOMIC_RELEASE, "agent");
      asm volatile("s_waitcnt vmcnt(0)" ::: "memory");
      const unsigned og = xb_add(&bar[XB_TOP], 1u);
      const unsigned tg = og / nx;
      if (og + 1u == (tg + 1u) * nx) xb_add(&bar[XB_TOPGEN], 1u);
      else XB_SPIN(xb_ld(&bar[XB_TOPGEN]) == tg, bar);
      __builtin_amdgcn_fence(__ATOMIC_ACQUIRE, "agent");
      xb_add(&bar[XB_XGEN(b.x)], 1u);
      asm volatile("s_waitcnt vmcnt(0)" ::: "memory");
    } else {
      XB_SPIN(xb_ld(&bar[XB_XGEN(b.x)]) == gen, bar);
      __builtin_amdgcn_fence(__ATOMIC_ACQUIRE, "agent");
      asm volatile("s_waitcnt vmcnt(0)" ::: "memory");
    }
  }
  __syncthreads();
}

constexpr int N_PHASES = 20;
DI void run_phase(const Params& p, int ph, char* smem) {
  if (ph == 0) { phase0(p, smem); return; }
  if (ph == 19) { norm_phase(p, 0, 2); return; }
  const int l = (ph - 1) / 9, s = (ph - 1) % 9;
  switch (s) {
    case 0: convert_weights(p, l, smem); norm_phase(p, l, 0); break;
    case 1: phase_inproj(p, l, smem); break;
    case 2: phase_mixers(p, l, smem); break;
    case 3: mlstm_norm_phase(p, l); break;
    case 4: phase_merge(p, l, smem); break;
    case 5: phase_resid(p, l, 0, smem); break;
    case 6: norm_phase(p, l, 1); break;
    case 7: phase_ffn1(p, l, smem); break;
    default: phase_resid(p, l, 1, smem); break;
  }
}

#ifndef MK_TEST
template <bool COOP>
__global__ void __launch_bounds__(256, 2) hybrid_fwd(Params p, int ph_lo, int ph_hi) {
  extern __shared__ __attribute__((aligned(16))) char smem[];
  __shared__ uint4 xb_words;
  if (COOP) {
    if (threadIdx.x == 0) xb_words = make_uint4(0u, 0u, 0u, 0u);
    __syncthreads();
    run_phase(p, 0, smem);
    cg::this_grid().sync();
    XcdBarrier xb = xcd_barrier_post((unsigned*)(p.ws + WS_BAR), (volatile LAS unsigned*)&xb_words);
    for (int ph = 1; ph < ph_hi; ++ph) {
      run_phase(p, ph, smem);
#ifdef PROBE_DUP
      if (ph >= 1 && ph <= 18 && ((PROBE_DUP >> ((ph - 1) % 9)) & 1)) run_phase(p, ph, smem);
#endif
      if (ph + 1 < ph_hi) xcd_barrier(xb);
    }
  } else {
    for (int ph = ph_lo; ph < ph_hi; ++ph) run_phase(p, ph, smem);
  }
}

extern "C" void kernel_launch(void* const* d_in, const int* in_sizes, int n_in, void* d_out, int out_size, void* d_ws, size_t ws_size, hipStream_t stream) {
  static int grid = 0;
  if (grid == 0) {
    if (n_in != 26 || ws_size < WS_END) { fprintf(stderr, "kernel_launch: bad n_in %d or ws_size %zu (need %zu)\n", n_in, ws_size, (size_t)WS_END); grid = -1; return; }
    int dev = 0, cus = 0, per_cu = 0;
    hipGetDevice(&dev);
    hipDeviceGetAttribute(&cus, hipDeviceAttributeMultiprocessorCount, dev);
    hipFuncSetAttribute((const void*)hybrid_fwd<true>, hipFuncAttributeMaxDynamicSharedMemorySize, SMEM_BYTES);
    hipFuncSetAttribute((const void*)hybrid_fwd<false>, hipFuncAttributeMaxDynamicSharedMemorySize, SMEM_BYTES);
    hipOccupancyMaxActiveBlocksPerMultiprocessor(&per_cu, (const void*)hybrid_fwd<true>, 256, SMEM_BYTES);
    if (per_cu < 1) per_cu = 1;
    if (per_cu > 2) per_cu = 2;
    grid = cus * per_cu;
  }
  if (grid < 0) return;
  Params p{};
  const float** pp = (const float**)&p;
  for (int i = 0; i < 26; ++i) pp[i] = (const float*)d_in[i];
  p.out = (float*)d_out;
  p.ws = (char*)d_ws;
#if MK_COOP
  int lo = 0, hi = N_PHASES;
  void* args[] = {&p, &lo, &hi};
  hipError_t e = hipLaunchCooperativeKernel((const void*)hybrid_fwd<true>, dim3(grid), dim3(256), args, SMEM_BYTES, stream);
  if (e != hipSuccess) fprintf(stderr, "cooperative launch failed: %s (grid %d)\n", hipGetErrorString(e), grid);
#else
  for (int ph = 0; ph < N_PHASES; ++ph) hybrid_fwd<false><<<grid, 256, SMEM_BYTES, stream>>>(p, ph, ph + 1);
#endif
}
#endif
```

```cpp
#include <hip/hip_runtime.h>
#include <hip/hip_cooperative_groups.h>
#include <stdint.h>
#include <stdio.h>
namespace cg = cooperative_groups;

#ifndef MK_COOP
#define MK_COOP 1
#endif

typedef unsigned short bf16_t;
typedef __attribute__((ext_vector_type(8))) short bf16x8;
typedef __attribute__((ext_vector_type(16))) float f32x16;
typedef __attribute__((ext_vector_type(4))) float f32x4;
typedef __attribute__((ext_vector_type(4))) unsigned u32x4;
typedef __attribute__((ext_vector_type(2))) unsigned u32x2;

#define DI __device__ __forceinline__
#define MFMA(a, b, c) __builtin_amdgcn_mfma_f32_32x32x16_bf16((a), (b), (c), 0, 0, 0)

typedef __attribute__((ext_vector_type(2))) __bf16 bf16x2_t;
typedef __attribute__((ext_vector_type(2))) float f32x2;
DI unsigned pk2(float lo, float hi) { f32x2 v = {lo, hi}; bf16x2_t b = __builtin_convertvector(v, bf16x2_t); return __builtin_bit_cast(unsigned, b); }
DI float bflo(unsigned u) { return __uint_as_float(u << 16); }
DI float bfhi(unsigned u) { return __uint_as_float(u & 0xffff0000u); }
DI bf16x8 as_bf8(u32x4 v) { return __builtin_bit_cast(bf16x8, v); }
DI int get_tid() { int t = (int)__builtin_amdgcn_workitem_id_x(); asm volatile("" : "+v"(t)); return t; }
DI float shfl_(float v, int src) { return __int_as_float(__builtin_amdgcn_ds_bpermute(src << 2, __float_as_int(v))); }
DI float shfl_xor_(float v, int o, int lane) { return shfl_(v, lane ^ o); }
DI float shfl_up_(float v, int o, int lane) { int s = lane - o; return shfl_(v, s < 0 ? lane : s); }
DI float sigmoidf_(float x) { return 1.f / (1.f + __expf(-x)); }

constexpr int TC = 4096;
constexpr int TL = 32768;
constexpr int TT = TC + TL;
constexpr int DM = 1024;
constexpr int NIN = 9232;
constexpr int NZ = 5136;
constexpr int ZW = 5120;
constexpr int DFF = 2816;
constexpr int NAQ = 0, NAK = 512, NAV = 1024, GQ = 1536, GK = 2048, GV = 2176, SQ = 2304, SK = 2816, SV = 2944,
              MQ = 3072, MK = 3584, MV = 4096, MO = 4608;
constexpr int MGC = 512;
constexpr size_t WS_WIN = 0;
constexpr size_t WS_WBR = WS_WIN + (size_t)NIN * DM * 2;
constexpr size_t WS_WOUT = WS_WBR + (size_t)4 * 1024 * 512 * 2;
constexpr size_t WS_WF1 = WS_WOUT + (size_t)1024 * 1024 * 2;
constexpr size_t WS_WF2 = WS_WF1 + (size_t)5632 * 1024 * 2;
constexpr size_t WS_Z = WS_WF2 + (size_t)1024 * DFF * 2;
constexpr size_t WS_H = WS_Z + (size_t)TT * ZW * 2;
constexpr size_t WS_HB = WS_H + (size_t)TT * DM * 2;
constexpr size_t WS_IF = WS_HB + (size_t)TT * 512 * 2;
constexpr size_t WS_MODS = WS_IF + (size_t)TT * 16 * 4;
constexpr size_t WS_ROPE = WS_MODS + (size_t)2 * 9 * 6144 * 4;
constexpr size_t WS_CNT = WS_ROPE + 2 * 1024 * 4;
constexpr size_t WS_BAR = WS_CNT + 4096;
constexpr size_t WS_END = WS_BAR + 16384;
constexpr size_t OUT_YP = 0, OUT_YS = 4194304, OUT_NA = 37748736, OUT_GQA = 46137344, OUT_SWA = 48234496,
                 OUT_C = 50331648, OUT_N = 54525952, OUT_M = 54558720;

constexpr int SMEM_BYTES = 74752;
constexpr float LOG2E = 1.4426950408889634f;

struct Params {
  const float *x_prompt, *x_sample, *cache_na, *cache_gqa, *cache_swa, *st_C, *st_n, *st_m, *c, *c_ctx,
      *w_mod, *b_mod, *norm1_g, *norm2_g, *w_in, *b_in, *na_rpb, *gqa_q_g, *gqa_k_g, *swa_sink, *ml_g,
      *w_branch, *w_out, *w_f1, *w_f2, *final_g;
  float* out;
  char* ws;
};

DI int cond_of_row(int grow) { return grow < TC ? 0 : 1 + ((grow - TC) >> 12); }

DI void phase0(const Params& p, char* smem) {
  const int tid = get_tid();
  if (blockIdx.x == 0) {
    int* cnt = (int*)(p.ws + WS_CNT);
    for (int i = tid; i < 1024 + 4096; i += 256) cnt[i] = 0;
    float* rc = (float*)(p.ws + WS_ROPE);
    for (int idx = tid; idx < 1024; idx += 256) {
      int pos = idx >> 4, j = idx & 15;
      float freq = exp2f(-(float)j * (13.287712379549449f / 16.f));
      float ang = (float)pos * freq;
      float k = rintf(ang * 0.15915494309189535f);
      float r = fmaf(-k, 6.2831854820251465f, ang);
      r = fmaf(k, 1.7484555e-7f, r);
      rc[idx] = __cosf(r);
      rc[1024 + idx] = __sinf(r);
    }
  }
  float* sS = (float*)smem;
  float* sR = (float*)(smem + 36864);
  for (int idx = tid; idx < 9 * 1024; idx += 256) {
    int cv = idx >> 10, k = idx & 1023;
    float v = cv == 0 ? p.c_ctx[k] : p.c[(cv - 1) * 1024 + k];
    sS[idx] = v / (1.f + __expf(-v));
  }
  __syncthreads();
  for (int item = blockIdx.x; item < 192; item += gridDim.x) {
    int l = item / 96, n0 = (item % 96) * 64, n = n0 + (tid & 63), kg = tid >> 6;
    const float* w = p.w_mod + (size_t)l * 1024 * 6144 + n;
    float acc[9];
#pragma unroll
    for (int cv = 0; cv < 9; ++cv) acc[cv] = 0.f;
#pragma unroll 4
    for (int k = kg * 256; k < kg * 256 + 256; ++k) {
      float wv = w[(size_t)k * 6144];
#pragma unroll
      for (int cv = 0; cv < 9; ++cv) acc[cv] = fmaf(sS[cv * 1024 + k], wv, acc[cv]);
    }
#pragma unroll
    for (int cv = 0; cv < 9; ++cv) sR[(kg * 9 + cv) * 64 + (tid & 63)] = acc[cv];
    __syncthreads();
    if (tid < 64) {
      float* mods = (float*)(p.ws + WS_MODS);
      float bm = p.b_mod[l * 6144 + n];
#pragma unroll
      for (int cv = 0; cv < 9; ++cv) {
        float s = sR[(0 * 9 + cv) * 64 + tid] + sR[(1 * 9 + cv) * 64 + tid] + sR[(2 * 9 + cv) * 64 + tid] + sR[(3 * 9 + cv) * 64 + tid];
        mods[(size_t)(l * 9 + cv) * 6144 + n] = s + bm;
      }
    }
    __syncthreads();
  }
}

DI void convert_tile(const float* __restrict__ src, int K, int N, bf16_t* __restrict__ dst, int kt, int nt, int f1perm, char* smem) {
  float* sT = (float*)smem;
  const int tid = get_tid();
  __syncthreads();
  {
    int n4 = (tid & 15) * 4, kr = tid >> 4;
#pragma unroll
    for (int i = 0; i < 4; ++i) {
      int k = kr + 16 * i;
      int n = nt * 64 + n4;
      f32x4 v = {0.f, 0.f, 0.f, 0.f};
      if (n < N) v = *(const f32x4*)(src + (size_t)(kt * 64 + k) * N + n);
      sT[k * 65 + n4 + 0] = v[0]; sT[k * 65 + n4 + 1] = v[1]; sT[k * 65 + n4 + 2] = v[2]; sT[k * 65 + n4 + 3] = v[3];
    }
  }
  __syncthreads();
  {
    int nl = tid >> 2, seg = (tid & 3) * 16;
    int n = nt * 64 + nl;
    if (n < N) {
      int drow = n;
      if (f1perm) { int j = n < DFF ? n : n - DFF; drow = (j >> 6) * 128 + (n < DFF ? 0 : 64) + (j & 63); }
      unsigned o[8];
#pragma unroll
      for (int q = 0; q < 8; ++q) o[q] = pk2(sT[(seg + 2 * q) * 65 + nl], sT[(seg + 2 * q + 1) * 65 + nl]);
      u32x4* d = (u32x4*)(dst + (size_t)drow * K + kt * 64 + seg);
      d[0] = u32x4{o[0], o[1], o[2], o[3]};
      d[1] = u32x4{o[4], o[5], o[6], o[7]};
    }
  }
}

DI void convert_weights(const Params& p, int l, char* smem) {
  for (int item = blockIdx.x; item < 5200; item += gridDim.x) {
    const float* src; bf16_t* dst; int K, N, kt, nt, perm = 0;
    int j = item;
    if (j < 2320) { src = p.w_in + (size_t)l * 1024 * NIN; K = 1024; N = NIN; dst = (bf16_t*)(p.ws + WS_WIN); kt = j / 145; nt = j % 145; }
    else if (j < 2832) { j -= 2320; int i = j >> 7; j &= 127; src = p.w_branch + (size_t)(l * 4 + i) * 512 * 1024; K = 512; N = 1024; dst = (bf16_t*)(p.ws + WS_WBR) + (size_t)i * 1024 * 512; kt = j >> 4; nt = j & 15; }
    else if (j < 3088) { j -= 2832; src = p.w_out + (size_t)l * 1024 * 1024; K = 1024; N = 1024; dst = (bf16_t*)(p.ws + WS_WOUT); kt = j >> 4; nt = j & 15; }
    else if (j < 4496) { j -= 3088; src = p.w_f1 + (size_t)l * 1024 * 5632; K = 1024; N = 5632; dst = (bf16_t*)(p.ws + WS_WF1); kt = j / 88; nt = j % 88; perm = 1; }
    else { j -= 4496; src = p.w_f2 + (size_t)l * DFF * 1024; K = DFF; N = 1024; dst = (bf16_t*)(p.ws + WS_WF2); kt = j >> 4; nt = j & 15; }
    convert_tile(src, K, N, dst, kt, nt, perm, smem);
  }
}

DI void norm_phase(const Params& p, int l, int which) {
  const int tid = get_tid(), lane = tid & 63, w = tid >> 6;
  const float* g = which == 0 ? p.norm1_g + l * 1024 : (which == 1 ? p.norm2_g + l * 1024 : p.final_g);
  const float* mods = (const float*)(p.ws + WS_MODS);
  bf16_t* H = (bf16_t*)(p.ws + WS_H);
  for (int row = blockIdx.x * 4 + w; row < TT; row += gridDim.x * 4) {
    const float* xr;
    if (which == 0 && l == 0) xr = row < TC ? p.x_prompt + (size_t)row * 1024 : p.x_sample + (size_t)(row - TC) * 1024;
    else xr = p.out + (size_t)row * 1024;
    f32x4 v[4];
    float ss = 0.f;
#pragma unroll
    for (int i = 0; i < 4; ++i) {
      v[i] = *(const f32x4*)(xr + 4 * lane + 256 * i);
      ss += v[i][0] * v[i][0] + v[i][1] * v[i][1] + v[i][2] * v[i][2] + v[i][3] * v[i][3];
    }
#pragma unroll
    for (int o = 32; o >= 1; o >>= 1) ss += shfl_xor_(ss, o, lane);
    float rstd = rsqrtf(ss * (1.f / 1024.f) + 1e-6f);
    if (which == 2) {
      float* yo = p.out + (size_t)row * 1024;
#pragma unroll
      for (int i = 0; i < 4; ++i) {
        int k = 4 * lane + 256 * i;
        f32x4 g4 = *(const f32x4*)(g + k);
        f32x4 y;
#pragma unroll
        for (int e = 0; e < 4; ++e) y[e] = v[i][e] * rstd * g4[e];
        *(f32x4*)(yo + k) = y;
      }
    } else {
      const float* mr = mods + (size_t)(l * 9 + cond_of_row(row)) * 6144 + (which == 0 ? 0 : 3072);
#pragma unroll
      for (int i = 0; i < 4; ++i) {
        int k = 4 * lane + 256 * i;
        f32x4 g4 = *(const f32x4*)(g + k);
        f32x4 sh = *(const f32x4*)(mr + k);
        f32x4 sc = *(const f32x4*)(mr + 1024 + k);
        float y[4];
#pragma unroll
        for (int e = 0; e < 4; ++e) y[e] = (v[i][e] * rstd * g4[e]) * (1.f + sc[e]) + sh[e];
        *(u32x2*)(H + (size_t)row * 1024 + k) = u32x2{pk2(y[0], y[1]), pk2(y[2], y[3])};
      }
    }
  }
}

template <bool DB = true>
DI void gemm_core(const bf16_t* __restrict__ A, int lda, const bf16_t* __restrict__ B, int ldb, int K, f32x16 (&acc)[2][2], char* smem) {
  bf16_t* sA = (bf16_t*)smem;
  bf16_t* sB = sA + (DB ? 2 : 1) * 128 * 72;
  const int tid = get_tid(), lane = tid & 63, w = tid >> 6, wm = w >> 1, wn = w & 1, l31 = lane & 31, hh = lane >> 5;
  const int lrow = tid >> 3, lseg = (tid & 7) * 8;
  const char* Ab = (const char*)A;
  const char* Bb = (const char*)B;
  const unsigned offA = (unsigned)(lrow * lda + lseg) * 2u, offB = (unsigned)(lrow * ldb + lseg) * 2u;
  const unsigned stepA = (unsigned)lda * 64u, stepB = (unsigned)ldb * 64u;
  u32x4 ra[4], rb[4];
#pragma unroll
  for (int i = 0; i < 4; ++i) { ra[i] = *(const u32x4*)(Ab + (offA + i * stepA)); rb[i] = *(const u32x4*)(Bb + (offB + i * stepB)); }
  __syncthreads();
#pragma unroll
  for (int i = 0; i < 4; ++i) { *(u32x4*)(sA + (lrow + 32 * i) * 72 + lseg) = ra[i]; *(u32x4*)(sB + (lrow + 32 * i) * 72 + lseg) = rb[i]; }
  __syncthreads();
  const int nk = K >> 6;
  for (int kt = 0; kt < nk; ++kt) {
    const int buf = DB ? (kt & 1) : 0;
    if (kt + 1 < nk) {
#pragma unroll
      for (int i = 0; i < 4; ++i) { ra[i] = *(const u32x4*)(Ab + (offA + i * stepA + (unsigned)(kt + 1) * 128u)); rb[i] = *(const u32x4*)(Bb + (offB + i * stepB + (unsigned)(kt + 1) * 128u)); }
    }
    __builtin_amdgcn_sched_barrier(0);
    const bf16_t* pa = sA + (buf * 128 + 64 * wm + l31) * 72 + 8 * hh;
    const bf16_t* pb = sB + (buf * 128 + 64 * wn + l31) * 72 + 8 * hh;
    bf16x8 a0 = *(const bf16x8*)(pa), a1 = *(const bf16x8*)(pa + 32 * 72);
    bf16x8 b0 = *(const bf16x8*)(pb), b1 = *(const bf16x8*)(pb + 32 * 72);
#pragma unroll
    for (int ks = 0; ks < 4; ++ks) {
      bf16x8 na0 = a0, na1 = a1, nb0 = b0, nb1 = b1;
      if (ks < 3) {
        na0 = *(const bf16x8*)(pa + (ks + 1) * 16); na1 = *(const bf16x8*)(pa + 32 * 72 + (ks + 1) * 16);
        nb0 = *(const bf16x8*)(pb + (ks + 1) * 16); nb1 = *(const bf16x8*)(pb + 32 * 72 + (ks + 1) * 16);
      }
      __builtin_amdgcn_sched_barrier(0);
      acc[0][0] = MFMA(a0, b0, acc[0][0]);
      acc[0][1] = MFMA(a0, b1, acc[0][1]);
      acc[1][0] = MFMA(a1, b0, acc[1][0]);
      acc[1][1] = MFMA(a1, b1, acc[1][1]);
      __builtin_amdgcn_sched_barrier(0);
      a0 = na0; a1 = na1; b0 = nb0; b1 = nb1;
    }
    if (kt + 1 < nk) {
      const int nb = DB ? (buf ^ 1) : 0;
      if (!DB) __syncthreads();
#pragma unroll
      for (int i = 0; i < 4; ++i) { *(u32x4*)(sA + (nb * 128 + lrow + 32 * i) * 72 + lseg) = ra[i]; *(u32x4*)(sB + (nb * 128 + lrow + 32 * i) * 72 + lseg) = rb[i]; }
    }
    __syncthreads();
  }
}

DI void zero_acc(f32x16 (&acc)[2][2]) {
#pragma unroll
  for (int i = 0; i < 2; ++i)
#pragma unroll
    for (int j = 0; j < 2; ++j)
#pragma unroll
      for (int r = 0; r < 16; ++r) acc[i][j][r] = 0.f;
}

DI void acc_to_lds(const f32x16 (&acc)[2][2], float* sC) {
  const int tid = get_tid(), lane = tid & 63, w = tid >> 6, wm = w >> 1, wn = w & 1, l31 = lane & 31, hh = lane >> 5;
#pragma unroll
  for (int i = 0; i < 2; ++i)
#pragma unroll
    for (int j = 0; j < 2; ++j)
#pragma unroll
      for (int r = 0; r < 16; ++r) {
        int row = 64 * wm + 32 * i + 8 * (r >> 2) + 4 * hh + (r & 3), col = 64 * wn + 32 * j + l31;
        sC[row * 132 + col] = acc[i][j][r];
      }
  __syncthreads();
}

struct TileIter {
  int local, step, total, nN, xcd; bool swz;
  DI void init(int nN_) {
    nN = nN_;
    swz = (gridDim.x & 7) == 0;
    if (swz) { xcd = blockIdx.x & 7; local = blockIdx.x >> 3; step = gridDim.x >> 3; total = 36 * nN; }
    else { xcd = 0; local = blockIdx.x; step = gridDim.x; total = 288 * nN; }
  }
  DI bool next(int& mt, int& nt) {
    if (local >= total) return false;
    if (swz) {
      const int per_sr = 8 * nN;
      const int sr = local / per_sr, r = local - sr * per_sr;
      const int rows = (36 - 8 * sr) < 8 ? (36 - 8 * sr) : 8;
      nt = r / rows; mt = 36 * xcd + 8 * sr + (r - nt * rows);
    } else { mt = local / nN; nt = local - mt * nN; }
    local += step;
    return true;
  }
};

DI void epi_inproj(const Params& p, int l, int mt, int nt, const float* sC) {
  const int tid = get_tid();
  const int chunk = tid & 15, lane = tid & 63;
  const int half = chunk >> 3, d0 = (chunk & 7) * 8;
  const int c0 = nt * 128 + half * 64;
  if (c0 >= NZ && c0 != 5120) return;
  bf16_t* Z = (bf16_t*)(p.ws + WS_Z);
  const float* bias = p.b_in + (size_t)l * NIN + c0;
  if (c0 == 5120) {
    if (chunk >= 2) return;
    const f32x4 b0 = *(const f32x4*)(bias + d0), b1 = *(const f32x4*)(bias + d0 + 4);
#pragma unroll
    for (int it = 0; it < 8; ++it) {
      const int rt = (tid >> 4) + 16 * it, grow = mt * 128 + rt;
      const float* crow = sC + rt * 132 + d0;
      f32x4 v0 = *(const f32x4*)crow + b0, v1 = *(const f32x4*)(crow + 4) + b1;
      if (chunk == 1) {
#pragma unroll
        for (int e = 0; e < 4; ++e) {
          v0[e] = fminf(v0[e], 0.f) - log1pf(__expf(-fabsf(v0[e])));
          v1[e] = fminf(v1[e], 0.f) - log1pf(__expf(-fabsf(v1[e])));
        }
      }
      float* IF = (float*)(p.ws + WS_IF) + (size_t)grow * 16 + d0;
      *(f32x4*)IF = v0; *(f32x4*)(IF + 4) = v1;
    }
    return;
  }
  bool hn = false, rope = false;
  const float* hg = nullptr;
  float scale = 1.f;
  int kvsel = -1, kvh = 0, kvH = 0; size_t kvbase = 0;
  if (c0 < NAK) {}
  else if (c0 < NAV) { kvbase = OUT_NA; kvsel = 0; kvh = (c0 - NAK) >> 6; kvH = 8; }
  else if (c0 < GQ) { kvbase = OUT_NA; kvsel = 1; kvh = (c0 - NAV) >> 6; kvH = 8; }
  else if (c0 < GK) { hn = true; hg = p.gqa_q_g + l * 64; rope = true; }
  else if (c0 < GV) { hn = true; hg = p.gqa_k_g + l * 64; rope = true; kvbase = OUT_GQA; kvsel = 0; kvh = (c0 - GK) >> 6; kvH = 2; }
  else if (c0 < SQ) { kvbase = OUT_GQA; kvsel = 1; kvh = (c0 - GV) >> 6; kvH = 2; }
  else if (c0 < SK) { rope = true; }
  else if (c0 < SV) { rope = true; kvbase = OUT_SWA; kvsel = 0; kvh = (c0 - SK) >> 6; kvH = 2; }
  else if (c0 < MQ) { kvbase = OUT_SWA; kvsel = 1; kvh = (c0 - SV) >> 6; kvH = 2; }
  else if (c0 >= MK && c0 < MV) { scale = 0.08838834764831845f; }
  if (c0 < NAK || (c0 >= GQ && c0 < GK) || (c0 >= SQ && c0 < SK)) scale = 0.125f * LOG2E;
  const bool latent_tile = mt >= 32;
  if (latent_tile) kvsel = -1; else rope = false;
  const int dp = d0 ^ 16;
  const bool second = (d0 & 16) != 0;
  const f32x4 b0 = *(const f32x4*)(bias + d0), b1 = *(const f32x4*)(bias + d0 + 4);
  f32x4 pb0 = b0, pb1 = b1, g0 = {1.f, 1.f, 1.f, 1.f}, g1 = g0, pg0 = g0, pg1 = g0;
  if (rope) { pb0 = *(const f32x4*)(bias + dp); pb1 = *(const f32x4*)(bias + dp + 4); }
  if (hn) {
    g0 = *(const f32x4*)(hg + d0); g1 = *(const f32x4*)(hg + d0 + 4);
    pg0 = *(const f32x4*)(hg + dp); pg1 = *(const f32x4*)(hg + dp + 4);
  }
  const float* rcos = (const float*)(p.ws + WS_ROPE);
  const float* rsin = rcos + 1024;
#pragma unroll 4
  for (int it = 0; it < 8; ++it) {
    const int rt = (tid >> 4) + 16 * it, grow = mt * 128 + rt;
    const float* crow = sC + rt * 132 + half * 64;
    f32x4 x0 = *(const f32x4*)(crow + d0) + b0, x1 = *(const f32x4*)(crow + d0 + 4) + b1;
    float rs = 1.f;
    if (hn) {
      float ss = x0[0] * x0[0] + x0[1] * x0[1] + x0[2] * x0[2] + x0[3] * x0[3] + x1[0] * x1[0] + x1[1] * x1[1] + x1[2] * x1[2] + x1[3] * x1[3];
      ss += shfl_xor_(ss, 1, lane); ss += shfl_xor_(ss, 2, lane); ss += shfl_xor_(ss, 4, lane);
      rs = rsqrtf(ss * (1.f / 64.f) + 1e-6f);
    }
    const float sc = rs * scale;
    x0 = x0 * sc * g0; x1 = x1 * sc * g1;
    if (rope) {
      f32x4 y0 = (*(const f32x4*)(crow + dp) + pb0) * sc * pg0, y1 = (*(const f32x4*)(crow + dp + 4) + pb1) * sc * pg1;
      const int t = (grow - TC) & 4095;
      const int pos = (d0 & 32) ? (t & 63) : (t >> 6);
      const int fj = d0 & 15;
      const f32x4 c0v = *(const f32x4*)(rcos + pos * 16 + fj), c1v = *(const f32x4*)(rcos + pos * 16 + fj + 4);
      const f32x4 s0v = *(const f32x4*)(rsin + pos * 16 + fj), s1v = *(const f32x4*)(rsin + pos * 16 + fj + 4);
      if (second) { x0 = x0 * c0v + y0 * s0v; x1 = x1 * c1v + y1 * s1v; }
      else { x0 = x0 * c0v - y0 * s0v; x1 = x1 * c1v - y1 * s1v; }
    }
    __builtin_nontemporal_store(u32x4{pk2(x0[0], x0[1]), pk2(x0[2], x0[3]), pk2(x1[0], x1[1]), pk2(x1[2], x1[3])}, (u32x4*)(Z + (size_t)grow * ZW + c0 + d0));
    if (kvsel >= 0) {
      const int cb = grow >> 8, cs = grow & 255;
      float* kv = p.out + kvbase + ((((size_t)(cb * 2 + l) * 2 + kvsel) * 256 + cs) * kvH + kvh) * 64 + d0;
      *(f32x4*)kv = x0; *(f32x4*)(kv + 4) = x1;
    }
  }
}

DI void phase_inproj(const Params& p, int l, char* smem) {
  const bf16_t* H = (const bf16_t*)(p.ws + WS_H);
  const bf16_t* W = (const bf16_t*)(p.ws + WS_WIN);
  TileIter ti; ti.init(41);
  for (int mt, nt; ti.next(mt, nt);) {
    f32x16 acc[2][2];
    zero_acc(acc);
    gemm_core(H + (size_t)mt * 128 * DM, DM, W + (size_t)nt * 128 * DM, DM, DM, acc, smem);
    acc_to_lds(acc, (float*)smem);
    epi_inproj(p, l, mt, nt, (const float*)smem);
  }
}

DI void phase_merge(const Params& p, int l, char* smem) {
  const int tid = get_tid(), lane = tid & 63, w = tid >> 6, wn = w & 1, l31 = lane & 31;
  const bf16_t* H = (const bf16_t*)(p.ws + WS_H);
  const bf16_t* W = (const bf16_t*)(p.ws + WS_WIN);
  const bf16_t* WB = (const bf16_t*)(p.ws + WS_WBR);
  bf16_t* Z = (bf16_t*)(p.ws + WS_Z);
  TileIter ti; ti.init(8);
  for (int mt, nt; ti.next(mt, nt);) {
    f32x16 mg[2][2];
    zero_acc(mg);
#pragma unroll 1
    for (int i = 0; i < 4; ++i) {
      f32x16 acc[2][2];
      zero_acc(acc);
      gemm_core<false>(H + (size_t)mt * 128 * DM, DM, W + (size_t)(NZ + i * 1024 + nt * 128) * DM, DM, DM, acc, smem);
      unsigned* sG = (unsigned*)(smem + 36864) + tid;
#pragma unroll
      for (int j = 0; j < 2; ++j) {
        float bj = p.b_in[(size_t)l * NIN + NZ + i * 1024 + nt * 128 + 64 * wn + 32 * j + l31];
#pragma unroll
        for (int ii = 0; ii < 2; ++ii)
#pragma unroll
          for (int r = 0; r < 8; ++r) sG[((ii * 2 + j) * 8 + r) * 256] = pk2(sigmoidf_(acc[ii][j][2 * r] + bj), sigmoidf_(acc[ii][j][2 * r + 1] + bj));
      }
      zero_acc(acc);
      const int colA = i == 0 ? NAQ : (i == 1 ? GQ : (i == 2 ? SQ : MQ));
      gemm_core<false>(Z + (size_t)mt * 128 * ZW + colA, ZW, WB + (size_t)(i * 1024 + nt * 128) * 512, 512, 512, acc, smem);
#pragma unroll
      for (int ii = 0; ii < 2; ++ii)
#pragma unroll
        for (int j = 0; j < 2; ++j)
#pragma unroll
          for (int r = 0; r < 8; ++r) {
            const unsigned gpv = sG[((ii * 2 + j) * 8 + r) * 256];
            mg[ii][j][2 * r] += bflo(gpv) * acc[ii][j][2 * r];
            mg[ii][j][2 * r + 1] += bfhi(gpv) * acc[ii][j][2 * r + 1];
          }
    }
    float* sC = (float*)smem;
    __syncthreads();
    acc_to_lds(mg, sC);
#pragma unroll
    for (int it = 0; it < 8; ++it) {
      const int rt = (tid >> 4) + 16 * it, ch = (tid & 15) * 8;
      const float* crow = sC + rt * 132 + ch;
      f32x4 a = *(const f32x4*)crow, b = *(const f32x4*)(crow + 4);
      __builtin_nontemporal_store(u32x4{pk2(a[0], a[1]), pk2(a[2], a[3]), pk2(b[0], b[1]), pk2(b[2], b[3])}, (u32x4*)(Z + (size_t)(mt * 128 + rt) * ZW + MGC + nt * 128 + ch));
    }
  }
}

DI void phase_resid(const Params& p, int l, int which, char* smem) {
  const int tid = get_tid();
  const bf16_t* Z = (const bf16_t*)(p.ws + WS_Z);
  const bf16_t* W = (const bf16_t*)(p.ws + (which == 0 ? WS_WOUT : WS_WF2));
  const int K = which == 0 ? 1024 : DFF;
  const int acol = which == 0 ? MGC : 0;
  const int goff = which == 0 ? 2048 : 5120;
  const float* mods = (const float*)(p.ws + WS_MODS);
  TileIter ti; ti.init(8);
  for (int mt, nt; ti.next(mt, nt);) {
    f32x16 acc[2][2];
    zero_acc(acc);
    gemm_core(Z + (size_t)mt * 128 * ZW + acol, ZW, W + (size_t)nt * 128 * K, K, K, acc, smem);
    float* sC = (float*)smem;
    acc_to_lds(acc, sC);
    const int n = nt * 128 + (tid & 31) * 4;
    const f32x4 g4 = *(const f32x4*)(mods + (size_t)(l * 9 + cond_of_row(mt * 128)) * 6144 + goff + n);
    const float* xbase = (which == 0 && l == 0) ? (mt < 32 ? p.x_prompt + (size_t)mt * 128 * 1024 : p.x_sample + (size_t)(mt * 128 - TC) * 1024)
                                                : p.out + (size_t)mt * 128 * 1024;
#pragma unroll 4
    for (int it = 0; it < 16; ++it) {
      const int rt = (tid >> 5) + 8 * it, grow = mt * 128 + rt;
      const f32x4 x4 = *(const f32x4*)(xbase + (size_t)rt * 1024 + n);
      const f32x4 c4 = *(const f32x4*)(sC + rt * 132 + (tid & 31) * 4);
      __builtin_nontemporal_store(x4 + g4 * c4, (f32x4*)(p.out + (size_t)grow * 1024 + n));
    }
  }
}

DI void phase_ffn1(const Params& p, int l, char* smem) {
  const int tid = get_tid();
  const bf16_t* H = (const bf16_t*)(p.ws + WS_H);
  const bf16_t* W = (const bf16_t*)(p.ws + WS_WF1);
  bf16_t* Z = (bf16_t*)(p.ws + WS_Z);
  TileIter ti; ti.init(44);
  for (int mt, nt; ti.next(mt, nt);) {
    f32x16 acc[2][2];
    zero_acc(acc);
    gemm_core(H + (size_t)mt * 128 * DM, DM, W + (size_t)nt * 128 * DM, DM, DM, acc, smem);
    float* sC = (float*)smem;
    acc_to_lds(acc, sC);
#pragma unroll
    for (int it = 0; it < 4; ++it) {
      const int rt = (tid >> 3) + 32 * it, ch = (tid & 7) * 8;
      const float* crow = sC + rt * 132 + ch;
      float o[8];
#pragma unroll
      for (int hq = 0; hq < 2; ++hq) {
        f32x4 gt = *(const f32x4*)(crow + 4 * hq), up = *(const f32x4*)(crow + 64 + 4 * hq);
#pragma unroll
        for (int e = 0; e < 4; ++e) o[4 * hq + e] = gt[e] / (1.f + __expf(-gt[e])) * up[e];
      }
      __builtin_nontemporal_store(u32x4{pk2(o[0], o[1]), pk2(o[2], o[3]), pk2(o[4], o[5]), pk2(o[6], o[7])}, (u32x4*)(Z + (size_t)(mt * 128 + rt) * ZW + nt * 64 + ch));
    }
  }
}

struct AttnArgs {
  const void* k1; const void* v1; int stride1; int f32_1; int nblk1;
  const bf16_t* k2; const bf16_t* v2; int blk0_2; int nblk2;
  bf16_t* qo;
  int qpos0;
  int mode;
  float m0, l0;
  const float* rpb;
};

template <int QT>
DI void attn_item(const AttnArgs& a, char* smem) {
  bf16_t* sK = (bf16_t*)smem;
  bf16_t* sVt = sK + 2 * 64 * 72;
  float* sRpb = (float*)(smem + 4 * 64 * 72 * 2);
  const int tid = get_tid(), lane = tid & 63, l31 = lane & 31, hh = lane >> 5;
  const int dg = tid & 7, kp = tid >> 3;
  __syncthreads();
  if (a.mode == 2) for (int i = tid; i < 465; i += 256) sRpb[i] = a.rpb[i] * LOG2E;
  bf16x8 qf[QT][4];
#pragma unroll
  for (int qt = 0; qt < QT; ++qt)
#pragma unroll
    for (int st = 0; st < 4; ++st) qf[qt][st] = *(const bf16x8*)(a.qo + (size_t)(32 * qt + l31) * ZW + 16 * st + 8 * hh);
  f32x16 o[QT][2];
  float m_run[QT], l_run[QT];
#pragma unroll
  for (int qt = 0; qt < QT; ++qt) {
    m_run[qt] = a.m0; l_run[qt] = a.l0;
#pragma unroll
    for (int dt = 0; dt < 2; ++dt)
#pragma unroll
      for (int r = 0; r < 16; ++r) o[qt][dt][r] = 0.f;
  }
  const int nblk = a.nblk1 + a.nblk2;
  u32x4 rk[2], rv[2];
  auto load_blk = [&](int b) {
    if (b < a.nblk1) {
      if (a.f32_1) {
        const float* kb = (const float*)a.k1 + (size_t)(b * 64 + 2 * kp) * a.stride1 + 8 * dg;
        const float* vb = (const float*)a.v1 + (size_t)(b * 64 + 2 * kp) * a.stride1 + 8 * dg;
#pragma unroll
        for (int i = 0; i < 2; ++i) {
          f32x4 k0 = *(const f32x4*)(kb + (size_t)i * a.stride1), k1 = *(const f32x4*)(kb + (size_t)i * a.stride1 + 4);
          f32x4 v0 = *(const f32x4*)(vb + (size_t)i * a.stride1), v1 = *(const f32x4*)(vb + (size_t)i * a.stride1 + 4);
          rk[i] = u32x4{pk2(k0[0], k0[1]), pk2(k0[2], k0[3]), pk2(k1[0], k1[1]), pk2(k1[2], k1[3])};
          rv[i] = u32x4{pk2(v0[0], v0[1]), pk2(v0[2], v0[3]), pk2(v1[0], v1[1]), pk2(v1[2], v1[3])};
        }
      } else {
        const bf16_t* kb = (const bf16_t*)a.k1 + (size_t)(b * 64 + 2 * kp) * a.stride1 + 8 * dg;
        const bf16_t* vb = (const bf16_t*)a.v1 + (size_t)(b * 64 + 2 * kp) * a.stride1 + 8 * dg;
#pragma unroll
        for (int i = 0; i < 2; ++i) { rk[i] = *(const u32x4*)(kb + (size_t)i * a.stride1); rv[i] = *(const u32x4*)(vb + (size_t)i * a.stride1); }
      }
    } else {
      const int kb0 = (a.blk0_2 + (b - a.nblk1)) * 64 + 2 * kp;
      const bf16_t* kb = a.k2 + (size_t)kb0 * ZW + 8 * dg;
      const bf16_t* vb = a.v2 + (size_t)kb0 * ZW + 8 * dg;
#pragma unroll
      for (int i = 0; i < 2; ++i) { rk[i] = *(const u32x4*)(kb + (size_t)i * ZW); rv[i] = *(const u32x4*)(vb + (size_t)i * ZW); }
    }
  };
  auto store_blk = [&](int buf) {
    bf16_t* k = sK + buf * 64 * 72; bf16_t* v = sVt + buf * 64 * 72;
    *(u32x4*)(k + (2 * kp) * 72 + 8 * dg) = rk[0];
    *(u32x4*)(k + (2 * kp + 1) * 72 + 8 * dg) = rk[1];
#pragma unroll
    for (int e = 0; e < 4; ++e) {
      unsigned a0 = rv[0][e], a1 = rv[1][e];
      *(unsigned*)(v + (8 * dg + 2 * e) * 72 + 2 * (kp ^ (4 * dg))) = (a0 & 0xffffu) | (a1 << 16);
      *(unsigned*)(v + (8 * dg + 2 * e + 1) * 72 + 2 * (kp ^ (4 * dg))) = (a0 >> 16) | (a1 & 0xffff0000u);
    }
  };
  load_blk(0);
  store_blk(0);
  if (nblk > 1) load_blk(1);
  __syncthreads();
  for (int b = 0; b < nblk; ++b) {
    const bf16_t* cK = sK + (b & 1) * 64 * 72;
    const bf16_t* cV = sVt + (b & 1) * 64 * 72;
    f32x16 s[QT][2];
#pragma unroll
    for (int qt = 0; qt < QT; ++qt)
#pragma unroll
      for (int kt = 0; kt < 2; ++kt)
#pragma unroll
        for (int r = 0; r < 16; ++r) s[qt][kt][r] = 0.f;
#pragma unroll
    for (int st = 0; st < 4; ++st) {
      bf16x8 k0 = *(const bf16x8*)(cK + l31 * 72 + 16 * st + 8 * hh);
      bf16x8 k1 = *(const bf16x8*)(cK + (32 + l31) * 72 + 16 * st + 8 * hh);
#pragma unroll
      for (int qt = 0; qt < QT; ++qt) {
        s[qt][0] = MFMA(k0, qf[qt][st], s[qt][0]);
        s[qt][1] = MFMA(k1, qf[qt][st], s[qt][1]);
      }
    }
    const bool seg2 = b >= a.nblk1;
#pragma unroll
    for (int qt = 0; qt < QT; ++qt) {
      if (seg2 && a.mode == 1) {
        const int kbase = (a.blk0_2 + (b - a.nblk1)) * 64;
        const int qpos = a.qpos0 + 32 * qt + l31;
#pragma unroll
        for (int kt = 0; kt < 2; ++kt)
#pragma unroll
          for (int r = 0; r < 16; ++r) {
            int kpos = kbase + 32 * kt + 8 * (r >> 2) + 4 * hh + (r & 3);
            int dd = qpos - kpos; dd = dd < 0 ? -dd : dd;
            s[qt][kt][r] = dd <= 128 ? s[qt][kt][r] : -INFINITY;
          }
      } else if (seg2 && a.mode == 2) {
        const int kr = a.blk0_2 + (b - a.nblk1);
        const int qpos = a.qpos0 + 32 * qt + l31;
        const int qr = qpos >> 6, qc = qpos & 63;
        int rs = qr - 4; rs = rs < 0 ? 0 : (rs > 56 ? 56 : rs);
        int cs = qc - 8; cs = cs < 0 ? 0 : (cs > 48 ? 48 : cs);
        const bool rowok = kr >= rs && kr <= rs + 7;
        const int bbase = (kr - qr + 7) * 31 - qc + 15;
#pragma unroll
        for (int kt = 0; kt < 2; ++kt)
#pragma unroll
          for (int r = 0; r < 16; ++r) {
            int kc = 32 * kt + 8 * (r >> 2) + 4 * hh + (r & 3);
            bool ok = rowok && (unsigned)(kc - cs) < 16u;
            const float bias = sRpb[ok ? bbase + kc : 0];
            s[qt][kt][r] = ok ? s[qt][kt][r] + bias : -INFINITY;
          }
      }
      float mx = -INFINITY;
#pragma unroll
      for (int kt = 0; kt < 2; ++kt)
#pragma unroll
        for (int r = 0; r < 16; ++r) mx = fmaxf(mx, s[qt][kt][r]);
      mx = fmaxf(mx, shfl_xor_(mx, 32, lane));
      const float m_new = fmaxf(m_run[qt], mx);
      if (__builtin_amdgcn_ballot_w64(m_new > m_run[qt]) != 0ull) {
        const float alpha = __builtin_amdgcn_exp2f(m_run[qt] - m_new);
        l_run[qt] *= alpha;
#pragma unroll
        for (int dt = 0; dt < 2; ++dt)
#pragma unroll
          for (int r = 0; r < 16; ++r) o[qt][dt][r] *= alpha;
        m_run[qt] = m_new;
      }
      float ps = 0.f;
#pragma unroll
      for (int kt = 0; kt < 2; ++kt)
#pragma unroll
        for (int r = 0; r < 16; ++r) { float e = __builtin_amdgcn_exp2f(s[qt][kt][r] - m_run[qt]); s[qt][kt][r] = e; ps += e; }
      ps += shfl_xor_(ps, 32, lane);
      l_run[qt] += ps;
    }
#pragma unroll
    for (int kt = 0; kt < 2; ++kt)
#pragma unroll
      for (int s2 = 0; s2 < 2; ++s2) {
        u32x4 pb[QT];
#pragma unroll
        for (int qt = 0; qt < QT; ++qt)
          pb[qt] = u32x4{pk2(s[qt][kt][8 * s2 + 0], s[qt][kt][8 * s2 + 1]), pk2(s[qt][kt][8 * s2 + 2], s[qt][kt][8 * s2 + 3]),
                         pk2(s[qt][kt][8 * s2 + 4], s[qt][kt][8 * s2 + 5]), pk2(s[qt][kt][8 * s2 + 6], s[qt][kt][8 * s2 + 7])};
#pragma unroll
        for (int dt = 0; dt < 2; ++dt) {
          const int rg = (4 * dt + (l31 >> 3)) & 7;
          const bf16_t* vrow = cV + (32 * dt + l31) * 72 + 4 * hh;
          u32x2 lo = *(const u32x2*)(vrow + 8 * ((4 * kt + 2 * s2) ^ rg)), hi = *(const u32x2*)(vrow + 8 * ((4 * kt + 2 * s2 + 1) ^ rg));
          const bf16x8 vfr = as_bf8(u32x4{lo[0], lo[1], hi[0], hi[1]});
#pragma unroll
          for (int qt = 0; qt < QT; ++qt) o[qt][dt] = MFMA(vfr, as_bf8(pb[qt]), o[qt][dt]);
        }
      }
    if (b + 1 < nblk) store_blk((b + 1) & 1);
    if (b + 2 < nblk) load_blk(b + 2);
    __builtin_amdgcn_sched_barrier(0);
    __syncthreads();
  }
#pragma unroll
  for (int qt = 0; qt < QT; ++qt) {
    const float inv = 1.f / l_run[qt];
#pragma unroll
    for (int dt = 0; dt < 2; ++dt)
#pragma unroll
      for (int g = 0; g < 4; ++g) {
        *(u32x2*)(a.qo + (size_t)(32 * qt + l31) * ZW + 32 * dt + 8 * g + 4 * hh) =
            u32x2{pk2(o[qt][dt][4 * g] * inv, o[qt][dt][4 * g + 1] * inv), pk2(o[qt][dt][4 * g + 2] * inv, o[qt][dt][4 * g + 3] * inv)};
      }
  }
}

DI float wave_scan_sum(float v, int lane) {
#pragma unroll
  for (int o = 1; o < 64; o <<= 1) { float t = shfl_up_(v, o, lane); if (lane >= o) v += t; }
  return v;
}
DI float wave_scan_max(float v, int lane) {
#pragma unroll
  for (int o = 1; o < 64; o <<= 1) { float t = shfl_up_(v, o, lane); if (lane >= o) v = fmaxf(v, t); }
  return v;
}

#define RLX_AGENT __ATOMIC_RELAXED, __HIP_MEMORY_SCOPE_AGENT
DI void mlstm_item(const Params& p, char* smem, int l, int b, int h, int eh, int dir, bool latent, int* prog_self, int* prog_partner) {
  bf16_t* sQ = (bf16_t*)smem;
  bf16_t* sK = sQ + 64 * 136;
  bf16_t* sKw = sK + 64 * 136;
  bf16_t* sVt = sKw + 128 * 72;
  float* sN = (float*)(sVt + 64 * 72);
  float* sA = sN + 128;
  const int tid = get_tid();
  const int S = latent ? 4096 : 256, nc = S >> 6, half = nc >> 1;
  const int rowbase = latent ? TC + b * 4096 : b * 256;
  bf16_t* Z = (bf16_t*)(p.ws + WS_Z);
  bf16_t* HB = (bf16_t*)(p.ws + WS_HB);
  const float* IF = (const float*)(p.ws + WS_IF);
  f32x16 C[4];
  float m_state = 0.f;
  __syncthreads();
  {
    const int lane = tid & 63, w = tid >> 6, l31 = lane & 31, hh = lane >> 5, et = w & 1;
    if (latent) {
      const size_t sidx = (size_t)((b * 2 + l) * 2 + dir) * 4 + h;
      const float* C0 = p.st_C + sidx * 128 * 128;
      int cidx0 = 4 * hh * 128 + 64 * eh + 32 * et + l31; asm volatile("" : "+v"(cidx0));
#pragma unroll
      for (int dt = 0; dt < 4; ++dt) {
#pragma unroll
        for (int r = 0; r < 16; ++r) C[dt][r] = C0[(unsigned)(cidx0 + (32 * dt + 8 * (r >> 2) + (r & 3)) * 128)];
        __builtin_amdgcn_sched_barrier(0);
      }
      if (tid < 128) sN[tid] = p.st_n[sidx * 128 + tid];
      m_state = p.st_m[sidx];
    } else {
#pragma unroll
      for (int dt = 0; dt < 4; ++dt)
#pragma unroll
        for (int r = 0; r < 16; ++r) C[dt][r] = 0.f;
      if (tid < 128) sN[tid] = 0.f;
    }
  }
  float ip_n, lf_n;
  u32x4 rq[4], rkk[4], rvv[2];
  auto prefetch = [&](int c) {
    const int cbase = rowbase + (dir ? (nc - 1 - c) * 64 : c * 64);
    int tidc = tid; asm volatile("" : "+v"(tidc));
    const int lane = tidc & 63;
    const int tokp = cbase + (dir ? 63 - lane : lane);
    ip_n = IF[(size_t)tokp * 16 + dir * 4 + h];
    lf_n = IF[(size_t)tokp * 16 + 8 + dir * 4 + h];
#pragma unroll
    for (int i = 0; i < 4; ++i) {
      int id = tidc + 256 * i, pr = id >> 4, seg = (id & 15) * 8;
      int tok = cbase + (dir ? 63 - pr : pr);
      rq[i] = *(const u32x4*)(Z + (size_t)tok * ZW + MQ + h * 128 + seg);
    }
    const int dgp = (tidc & 15) * 8;
#pragma unroll
    for (int i = 0; i < 2; ++i) {
      const int s0 = 2 * ((tidc >> 4) + 16 * i), s1 = s0 + 1;
      const int t0 = cbase + (dir ? 63 - s0 : s0), t1 = cbase + (dir ? 63 - s1 : s1);
      rkk[2 * i] = *(const u32x4*)(Z + (size_t)t0 * ZW + MK + h * 128 + dgp);
      rkk[2 * i + 1] = *(const u32x4*)(Z + (size_t)t1 * ZW + MK + h * 128 + dgp);
    }
    {
      const int dgv = (tidc & 7) * 8, s0 = 2 * (tidc >> 3), s1 = s0 + 1;
      const int t0 = cbase + (dir ? 63 - s0 : s0), t1 = cbase + (dir ? 63 - s1 : s1);
      rvv[0] = *(const u32x4*)(Z + (size_t)t0 * ZW + MV + h * 128 + 64 * eh + dgv);
      rvv[1] = *(const u32x4*)(Z + (size_t)t1 * ZW + MV + h * 128 + 64 * eh + dgv);
    }
  };
  prefetch(0);
#pragma unroll 1
  for (int c = 0; c < nc; ++c) {
    const int cbase = rowbase + (dir ? (nc - 1 - c) * 64 : c * 64);
    int tidc = tid; asm volatile("" : "+v"(tidc));
    const int lane = tidc & 63, w = tidc >> 6, l31 = lane & 31, hh = lane >> 5, et = w & 1, tt = w >> 1;
    const float ip = ip_n, lf = lf_n;
    const float bcum = wave_scan_sum(lf, lane);
    const float av = ip - bcum;
    const float pm = wave_scan_max(av, lane);
    const float Mv = fmaxf(m_state, pm);
    const float Mlast = shfl_(Mv, 63), blast = shfl_(bcum, 63);
    const float wsv = __expf(av - Mlast);
    const float decay = __expf(m_state - Mlast);
    __syncthreads();
#pragma unroll
    for (int i = 0; i < 4; ++i) {
      int id = tidc + 256 * i, pr = id >> 4, seg = (id & 15) * 8;
      *(u32x4*)(sQ + pr * 136 + seg) = rq[i];
    }
    {
      const int dgp = (tidc & 15) * 8;
#pragma unroll
      for (int i = 0; i < 2; ++i) {
        const int s0 = 2 * ((tidc >> 4) + 16 * i), s1 = s0 + 1;
        const u32x4 k0 = rkk[2 * i], k1 = rkk[2 * i + 1];
        *(u32x4*)(sK + s0 * 136 + dgp) = k0;
        *(u32x4*)(sK + s1 * 136 + dgp) = k1;
        const float w0 = shfl_(wsv, s0), w1 = shfl_(wsv, s1);
#pragma unroll
        for (int e = 0; e < 4; ++e) {
          const int sw = 2 * ((s0 >> 1) ^ (4 * ((tidc & 15) & 7)));
          *(unsigned*)(sKw + (dgp + 2 * e) * 72 + sw) = pk2(bflo(k0[e]) * w0, bflo(k1[e]) * w1);
          *(unsigned*)(sKw + (dgp + 2 * e + 1) * 72 + sw) = pk2(bfhi(k0[e]) * w0, bfhi(k1[e]) * w1);
        }
      }
      const int dgv = (tidc & 7) * 8, sv0 = 2 * (tidc >> 3);
#pragma unroll
      for (int e = 0; e < 4; ++e) {
        const int svw = 2 * ((sv0 >> 1) ^ (4 * (tidc & 7)));
        *(unsigned*)(sVt + (dgv + 2 * e) * 72 + svw) = (rvv[0][e] & 0xffffu) | (rvv[1][e] << 16);
        *(unsigned*)(sVt + (dgv + 2 * e + 1) * 72 + svw) = (rvv[0][e] >> 16) | (rvv[1][e] & 0xffff0000u);
      }
    }
    if (w == 0) sA[lane] = av;
    __syncthreads();
    if (c + 1 < nc) prefetch(c + 1);
    __builtin_amdgcn_sched_barrier(0);
    const int t = 32 * tt + l31;
    const int tok = cbase + (dir ? 63 - t : t);
    const bool finisher = c >= half;
    u32x2 og[4];
    if (finisher) {
#pragma unroll
      for (int g = 0; g < 4; ++g) og[g] = *(const u32x2*)(Z + (size_t)tok * ZW + MO + h * 128 + 64 * eh + 32 * et + 8 * g + 4 * hh);
    }
    float inv;
    f32x16 acc;
    {
      const float Mt = shfl_(Mv, t), bt = shfl_(bcum, t);
      const float winter = __expf(m_state - Mt);
#pragma unroll
      for (int r = 0; r < 16; ++r) acc[r] = 0.f;
#pragma unroll
      for (int dt = 0; dt < 4; ++dt)
#pragma unroll
        for (int s2 = 0; s2 < 2; ++s2) {
          u32x4 ca = {pk2(C[dt][8 * s2 + 0], C[dt][8 * s2 + 1]), pk2(C[dt][8 * s2 + 2], C[dt][8 * s2 + 3]),
                      pk2(C[dt][8 * s2 + 4], C[dt][8 * s2 + 5]), pk2(C[dt][8 * s2 + 6], C[dt][8 * s2 + 7])};
          const bf16_t* qp = sQ + t * 136 + 32 * dt + 16 * s2 + 4 * hh;
          u32x2 lo = *(const u32x2*)qp, hi = *(const u32x2*)(qp + 8);
          acc = MFMA(as_bf8(ca), as_bf8(u32x4{lo[0], lo[1], hi[0], hi[1]}), acc);
        }
#pragma unroll
      for (int r = 0; r < 16; ++r) acc[r] *= winter;
      float qv = 0.f;
#pragma unroll
      for (int j = 0; j < 8; ++j) {
        u32x4 q8 = *(const u32x4*)(sQ + t * 136 + 64 * hh + 8 * j);
        f32x4 n0 = *(const f32x4*)(sN + 64 * hh + 8 * j), n1 = *(const f32x4*)(sN + 64 * hh + 8 * j + 4);
        qv += bflo(q8[0]) * n0[0] + bfhi(q8[0]) * n0[1] + bflo(q8[1]) * n0[2] + bfhi(q8[1]) * n0[3] +
              bflo(q8[2]) * n1[0] + bfhi(q8[2]) * n1[1] + bflo(q8[3]) * n1[2] + bfhi(q8[3]) * n1[3];
      }
      qv += shfl_xor_(qv, 32, lane);
      float rsv = 0.f;
#pragma unroll
      for (int st = 0; st < 2; ++st) {
        f32x16 sm;
#pragma unroll
        for (int r = 0; r < 16; ++r) sm[r] = 0.f;
#pragma unroll
        for (int ks = 0; ks < 8; ++ks) {
          bf16x8 ka = *(const bf16x8*)(sK + (32 * st + l31) * 136 + 16 * ks + 8 * hh);
          bf16x8 qb = *(const bf16x8*)(sQ + t * 136 + 16 * ks + 8 * hh);
          sm = MFMA(ka, qb, sm);
        }
#pragma unroll
        for (int g = 0; g < 4; ++g) {
          f32x4 a4 = *(const f32x4*)(sA + 32 * st + 8 * g + 4 * hh);
#pragma unroll
          for (int e = 0; e < 4; ++e) {
            const int s = 32 * st + 8 * g + 4 * hh + e;
            float wgt = s <= t ? __expf(a4[e] - Mt) : 0.f;
            float v = sm[4 * g + e] * wgt;
            sm[4 * g + e] = v;
            rsv += v;
          }
        }
#pragma unroll
        for (int s2 = 0; s2 < 2; ++s2) {
          const int rgv = (4 * et + (l31 >> 3)) & 7;
          const bf16_t* vrow = sVt + (32 * et + l31) * 72 + 4 * hh;
          u32x2 lo = *(const u32x2*)(vrow + 8 * ((4 * st + 2 * s2) ^ rgv)), hi = *(const u32x2*)(vrow + 8 * ((4 * st + 2 * s2 + 1) ^ rgv));
          u32x4 pb = {pk2(sm[8 * s2 + 0], sm[8 * s2 + 1]), pk2(sm[8 * s2 + 2], sm[8 * s2 + 3]),
                      pk2(sm[8 * s2 + 4], sm[8 * s2 + 5]), pk2(sm[8 * s2 + 6], sm[8 * s2 + 7])};
          acc = MFMA(as_bf8(u32x4{lo[0], lo[1], hi[0], hi[1]}), as_bf8(pb), acc);
        }
      }
      rsv += shfl_xor_(rsv, 32, lane);
      const float den = winter * qv + rsv;
      inv = 1.f / fmaxf(fabsf(den), __expf(-(bt + Mt)));
    }
#pragma unroll
    for (int dt = 0; dt < 4; ++dt) {
#pragma unroll
      for (int r = 0; r < 16; ++r) C[dt][r] *= decay;
#pragma unroll
      for (int ks = 0; ks < 4; ++ks) {
        bf16x8 ka = *(const bf16x8*)(sKw + (32 * dt + l31) * 72 + 8 * ((2 * ks + hh) ^ ((4 * dt + (l31 >> 3)) & 7)));
        bf16x8 vb = *(const bf16x8*)(sVt + (32 * et + l31) * 72 + 8 * ((2 * ks + hh) ^ ((4 * et + (l31 >> 3)) & 7)));
        C[dt] = MFMA(ka, vb, C[dt]);
      }
    }
    {
      unsigned long long* hbp = (unsigned long long*)(HB + (size_t)tok * 512 + h * 128 + 64 * eh + 32 * et + 4 * hh);
      if (!finisher) {
#pragma unroll
        for (int g = 0; g < 4; ++g) {
          const unsigned lo = pk2(acc[4 * g] * inv, acc[4 * g + 1] * inv), hi = pk2(acc[4 * g + 2] * inv, acc[4 * g + 3] * inv);
          __hip_atomic_store(hbp + 2 * g, ((unsigned long long)hi << 32) | lo, RLX_AGENT);
        }
        asm volatile("s_waitcnt vmcnt(0)" ::: "memory");
      } else {
        const int need = nc - c;
        unsigned spins = 0;
        while (__builtin_amdgcn_readfirstlane(__hip_atomic_load(prog_partner, RLX_AGENT)) < need) {
          __builtin_amdgcn_s_sleep(1);
          if (++spins > (1u << 24)) break;
        }
        __builtin_amdgcn_fence(__ATOMIC_ACQUIRE, "agent");
#pragma unroll
        for (int g = 0; g < 4; ++g) {
          const unsigned long long hb = hbp[2 * g];
          const unsigned hlo = (unsigned)hb, hhi = (unsigned)(hb >> 32);
          const float y0 = (acc[4 * g] * inv + bflo(hlo)) * sigmoidf_(bflo(og[g][0]));
          const float y1 = (acc[4 * g + 1] * inv + bfhi(hlo)) * sigmoidf_(bfhi(og[g][0]));
          const float y2 = (acc[4 * g + 2] * inv + bflo(hhi)) * sigmoidf_(bflo(og[g][1]));
          const float y3 = (acc[4 * g + 3] * inv + bfhi(hhi)) * sigmoidf_(bfhi(og[g][1]));
          hbp[2 * g] = ((unsigned long long)pk2(y2, y3) << 32) | pk2(y0, y1);
        }
      }
    }
    __syncthreads();
    if (!finisher && tidc == 0) __hip_atomic_store(prog_self, c + 1, RLX_AGENT);
    if (tidc < 128) {
      float sum = 0.f;
#pragma unroll
      for (int j = 0; j < 8; ++j) {
        u32x4 k8 = *(const u32x4*)(sKw + tidc * 72 + 8 * j);
        sum += bflo(k8[0]) + bfhi(k8[0]) + bflo(k8[1]) + bfhi(k8[1]) + bflo(k8[2]) + bfhi(k8[2]) + bflo(k8[3]) + bfhi(k8[3]);
      }
      sN[tidc] = decay * sN[tidc] + sum;
    }
    m_state = blast + Mlast;
  }
  if (!latent) {
    const int lane = tid & 63, w = tid >> 6, l31 = lane & 31, hh = lane >> 5, et = w & 1, tt = w >> 1;
    const size_t sidx = (size_t)((b * 2 + l) * 2 + dir) * 4 + h;
    float* Co = p.out + OUT_C + sidx * 128 * 128;
    if (tt == 0) {
      int cidx1 = 4 * hh * 128 + 64 * eh + 32 * et + l31; asm volatile("" : "+v"(cidx1));
#pragma unroll
      for (int dt = 0; dt < 4; ++dt) {
#pragma unroll
        for (int r = 0; r < 16; ++r) Co[(unsigned)(cidx1 + (32 * dt + 8 * (r >> 2) + (r & 3)) * 128)] = C[dt][r];
        __builtin_amdgcn_sched_barrier(0);
      }
    }
    __syncthreads();
    if (eh == 0) {
      if (tid < 128) p.out[OUT_N + sidx * 128 + tid] = sN[tid];
      if (tid == 0) p.out[OUT_M + sidx] = m_state;
    }
  }
}

DI void mlstm_norm_phase(const Params& p, int l) {
  const int tid = get_tid(), lane = tid & 63, w = tid >> 6;
  const bf16_t* HB = (const bf16_t*)(p.ws + WS_HB);
  bf16_t* Z = (bf16_t*)(p.ws + WS_Z);
  const float* g = p.ml_g + l * 512 + lane * 8;
  const f32x4 g0 = *(const f32x4*)g, g1 = *(const f32x4*)(g + 4);
  for (int row = blockIdx.x * 4 + w; row < TT; row += gridDim.x * 4) {
    u32x4 y = *(const u32x4*)(HB + (size_t)row * 512 + lane * 8);
    float v[8] = {bflo(y[0]), bfhi(y[0]), bflo(y[1]), bfhi(y[1]), bflo(y[2]), bfhi(y[2]), bflo(y[3]), bfhi(y[3])};
    float ss = 0.f;
#pragma unroll
    for (int e = 0; e < 8; ++e) ss += v[e] * v[e];
#pragma unroll
    for (int o = 8; o >= 1; o >>= 1) ss += shfl_xor_(ss, o, lane);
    const float rstd = rsqrtf(ss * (1.f / 128.f) + 1e-6f);
    *(u32x4*)(Z + (size_t)row * ZW + MQ + lane * 8) =
        u32x4{pk2(v[0] * rstd * g0[0], v[1] * rstd * g0[1]), pk2(v[2] * rstd * g0[2], v[3] * rstd * g0[3]),
              pk2(v[4] * rstd * g1[0], v[5] * rstd * g1[1]), pk2(v[6] * rstd * g1[2], v[7] * rstd * g1[3])};
  }
}

constexpr int MIX_ITEMS = 6272;
DI void phase_mixers(const Params& p, int l, char* smem) {
  __shared__ int s_item;
  const int tid = get_tid();
  int* cnt = (int*)(p.ws + WS_CNT) + l;
  auto draw = [&]() -> int {
    __syncthreads();
    if (tid == 0) s_item = atomicAdd(cnt, 1);
    __syncthreads();
    return __builtin_amdgcn_readfirstlane(s_item);
  };
  int item = draw();
  while (item < 384) {
    const bool lat = item < 128;
    const int j = lat ? item : item - 128;
    int* prog = (int*)(p.ws + WS_CNT) + 16 + l * 384;
    mlstm_item(p, smem, l, j >> 4, (j >> 2) & 3, (j >> 1) & 1, j & 1, lat, prog + item, prog + (item ^ 1));
    item = draw();
  }
#ifndef NO_ATTN
  const int w = __builtin_amdgcn_readfirstlane(get_tid() >> 6);
  bf16_t* Z = (bf16_t*)(p.ws + WS_Z);
  for (; item < MIX_ITEMS; item = draw()) {
    AttnArgs a;
    a.k2 = nullptr; a.v2 = nullptr; a.blk0_2 = 0; a.nblk2 = 0; a.mode = 0; a.m0 = -INFINITY; a.l0 = 0.f; a.rpb = nullptr; a.qpos0 = 0;
    a.nblk1 = 4;
    if (item < 1408) {
      int j = item - 384, qt = j & 63, kv = (j >> 6) & 1, b = j >> 7;
      const float* cb = p.cache_gqa + (size_t)((b * 2 + l) * 2) * 256 * 128 + kv * 64;
      a.k1 = cb; a.v1 = cb + 256 * 128; a.stride1 = 128; a.f32_1 = 1;
      bf16_t* zb = Z + (size_t)(TC + b * 4096) * ZW;
      a.k2 = zb + GK + kv * 64; a.v2 = zb + GV + kv * 64; a.blk0_2 = 0; a.nblk2 = 64;
      a.qo = zb + (size_t)(qt * 64) * ZW + GQ + (kv * 4 + w) * 64;
      attn_item<2>(a, smem);
      continue;
    } else if (item < 3456) {
      int j = item - 1408, qt = j & 127, kv = (j >> 7) & 1, b = j >> 8;
      const float* cb = p.cache_swa + (size_t)((b * 2 + l) * 2) * 256 * 128 + kv * 64;
      a.k1 = cb; a.v1 = cb + 256 * 128; a.stride1 = 128; a.f32_1 = 1;
      bf16_t* zb = Z + (size_t)(TC + b * 4096) * ZW;
      a.k2 = zb + SK + kv * 64; a.v2 = zb + SV + kv * 64;
      const int q0 = qt * 32;
      int lo = q0 - 128; lo = lo < 0 ? 0 : lo;
      int hi = q0 + 31 + 128; hi = hi > 4095 ? 4095 : hi;
      a.blk0_2 = lo >> 6; a.nblk2 = (hi >> 6) - (lo >> 6) + 1;
      a.qo = zb + (size_t)q0 * ZW + SQ + (kv * 4 + w) * 64;
      a.qpos0 = q0; a.mode = 1;
      a.m0 = p.swa_sink[l * 8 + kv * 4 + w] * LOG2E; a.l0 = 1.f;
    } else if (item < 5504) {
      int j = item - 3456, rp = j & 31, h = (j >> 5) & 7, b = j >> 8;
      const float* cb = p.cache_na + (size_t)((b * 2 + l) * 2) * 256 * 512 + h * 64;
      a.k1 = cb; a.v1 = cb + 256 * 512; a.stride1 = 512; a.f32_1 = 1;
      bf16_t* zb = Z + (size_t)(TC + b * 4096) * ZW;
      a.k2 = zb + NAK + h * 64; a.v2 = zb + NAV + h * 64;
      int r0 = 2 * rp, r1 = r0 + 1;
      int rs0 = r0 - 4; rs0 = rs0 < 0 ? 0 : (rs0 > 56 ? 56 : rs0);
      int rs1 = r1 - 4; rs1 = rs1 < 0 ? 0 : (rs1 > 56 ? 56 : rs1);
      a.blk0_2 = rs0; a.nblk2 = rs1 + 8 - rs0;
      const int q0 = (r0 + (w >> 1)) * 64 + 32 * (w & 1);
      a.qo = zb + (size_t)q0 * ZW + NAQ + h * 64;
      a.qpos0 = q0; a.mode = 2; a.rpb = p.na_rpb + (size_t)(l * 8 + h) * 465;
    } else if (item < 5760) {
      int j = item - 5504, qtile = j & 1, h = (j >> 1) & 7, b = j >> 4;
      bf16_t* zb = Z + (size_t)(b * 256) * ZW;
      a.k1 = zb + NAK + h * 64; a.v1 = zb + NAV + h * 64; a.stride1 = ZW; a.f32_1 = 0;
      a.qo = zb + (size_t)(qtile * 128 + 32 * w) * ZW + NAQ + h * 64;
    } else if (item < 6016) {
      int j = item - 5760, qt = j & 7, kv = (j >> 3) & 1, b = j >> 4;
      bf16_t* zb = Z + (size_t)(b * 256) * ZW;
      a.k1 = zb + GK + kv * 64; a.v1 = zb + GV + kv * 64; a.stride1 = ZW; a.f32_1 = 0;
      a.qo = zb + (size_t)(qt * 32) * ZW + GQ + (kv * 4 + w) * 64;
    } else {
      int j = item - 6016, qt = j & 7, kv = (j >> 3) & 1, b = j >> 4;
      bf16_t* zb = Z + (size_t)(b * 256) * ZW;
      a.k1 = zb + SK + kv * 64; a.v1 = zb + SV + kv * 64; a.stride1 = ZW; a.f32_1 = 0;
      a.qo = zb + (size_t)(qt * 32) * ZW + SQ + (kv * 4 + w) * 64;
      a.m0 = p.swa_sink[l * 8 + kv * 4 + w] * LOG2E; a.l0 = 1.f;
    }
    attn_item<1>(a, smem);
  }
#endif
}

#define XB_TMO      128
#define XB_XCNT(j)  (256  + 64 * (j))
#define XB_XSUB(j)  (1280 + 64 * (j))
#define XB_XGEN(j)  (2304 + 64 * (j))
#define XB_TOP      3328
#define XB_TOPGEN   3392
#define XCD_BAR_WORDS 3456
#define XB_SPIN_CAP (1u << 18)
#define LAS __attribute__((address_space(3)))
DI unsigned xb_ld(unsigned* p) { return __hip_atomic_load(p, __ATOMIC_RELAXED, __HIP_MEMORY_SCOPE_AGENT); }
DI unsigned xb_add(unsigned* p, unsigned v) { return __hip_atomic_fetch_add(p, v, __ATOMIC_RELAXED, __HIP_MEMORY_SCOPE_AGENT); }
DI unsigned xb_xcc_id() { return (unsigned)__builtin_amdgcn_s_getreg((3 << 11) | 20) & 0xFu; }
#define XB_SPIN(cond, bar) do { unsigned _sp = 0; while (cond) { __builtin_amdgcn_s_sleep(1); \
    if ((++_sp & 255u) == 0u) { if (xb_ld(&(bar)[XB_TMO])) break; if (_sp > XB_SPIN_CAP) { atomicAdd(&(bar)[XB_TMO], 1u); break; } } } } while (0)
struct XcdBarrier { unsigned* bar; unsigned x; volatile LAS unsigned* st; };
DI XcdBarrier xcd_barrier_post(unsigned* bar, volatile LAS unsigned* st) {
  XcdBarrier b; b.bar = bar; b.x = xb_xcc_id(); b.st = st;
  if (threadIdx.x == 0) (void)xb_add(&bar[XB_XCNT(b.x)], 1u);
  return b;
}
DI void xcd_barrier_complete(unsigned* bar, unsigned x, unsigned& nloc, unsigned& nx) {
  const unsigned G = gridDim.x * gridDim.y * gridDim.z;
  unsigned sum, cnt, mine, sp = 0u;
  for (;;) {
    sum = 0u; cnt = 0u; mine = 0u;
#pragma unroll
    for (unsigned j = 0; j < 16; ++j) { const unsigned c = xb_ld(&bar[XB_XCNT(j)]); sum += c; cnt += (c > 0u) ? 1u : 0u; mine = (j == x) ? c : mine; }
    if (sum == G) break;
    __builtin_amdgcn_s_sleep(1);
    if ((++sp & 255u) == 0u) { if (xb_ld(&bar[XB_TMO])) break; if (sp > XB_SPIN_CAP) { atomicAdd(&bar[XB_TMO], 1u); break; } }
  }
  nloc = mine > 0u ? mine : 1u; nx = cnt > 0u ? cnt : 1u;
}
DI void xcd_barrier(const XcdBarrier& b) {
  asm volatile("s_waitcnt vmcnt(0)" ::: "memory");
  __syncthreads();
  if (threadIdx.x == 0) {
    unsigned* bar = b.bar;
    __builtin_amdgcn_s_waitcnt(0);
    unsigned nloc = b.st[0], nx = b.st[1];
    if (nloc == 0u) { xcd_barrier_complete(bar, b.x, nloc, nx); b.st[0] = nloc; b.st[1] = nx; }
    const unsigned old = xb_add(&bar[XB_XSUB(b.x)], 1u);
    const unsigned gen = old / nloc;
    if (old + 1u == (gen + 1u) * nloc) {
      __builtin_amdgcn_fence(__ATOMIC_RELEASE, "agent");
      asm volatile("s_waitcnt vmcnt(0)" ::: "memory");
      const unsigned og = xb_add(&bar[XB_TOP], 1u);
      const unsigned tg = og / nx;
      if (og + 1u == (tg + 1u) * nx) xb_add(&bar[XB_TOPGEN], 1u);
      else XB_SPIN(xb_ld(&bar[XB_TOPGEN]) == tg, bar);
      __builtin_amdgcn_fence(__ATOMIC_ACQUIRE, "agent");
      xb_add(&bar[XB_XGEN(b.x)], 1u);
      asm volatile("s_waitcnt vmcnt(0)" ::: "memory");
    } else {
      XB_SPIN(xb_ld(&bar[XB_XGEN(b.x)]) == gen, bar);
      __builtin_amdgcn_fence(__ATOMIC_ACQUIRE, "agent");
      asm volatile("s_waitcnt vmcnt(0)" ::: "memory");
    }
  }
  __syncthreads();
}

constexpr int N_PHASES = 20;
DI void run_phase(const Params& p, int ph, char* smem) {
  if (ph == 0) { phase0(p, smem); return; }
  if (ph == 19) { norm_phase(p, 0, 2); return; }
  const int l = (ph - 1) / 9, s = (ph - 1) % 9;
  switch (s) {
    case 0: convert_weights(p, l, smem); norm_phase(p, l, 0); break;
    case 1: phase_inproj(p, l, smem); break;
    case 2: phase_mixers(p, l, smem); break;
    case 3: mlstm_norm_phase(p, l); break;
    case 4: phase_merge(p, l, smem); break;
    case 5: phase_resid(p, l, 0, smem); break;
    case 6: norm_phase(p, l, 1); break;
    case 7: phase_ffn1(p, l, smem); break;
    default: phase_resid(p, l, 1, smem); break;
  }
}

#ifndef MK_TEST
template <bool COOP>
__global__ void __launch_bounds__(256, 2) hybrid_fwd(Params p, int ph_lo, int ph_hi) {
  extern __shared__ __attribute__((aligned(16))) char smem[];
  __shared__ uint4 xb_words;
  if (COOP) {
    if (threadIdx.x == 0) xb_words = make_uint4(0u, 0u, 0u, 0u);
    __syncthreads();
    run_phase(p, 0, smem);
    cg::this_grid().sync();
    XcdBarrier xb = xcd_barrier_post((unsigned*)(p.ws + WS_BAR), (volatile LAS unsigned*)&xb_words);
    for (int ph = 1; ph < ph_hi; ++ph) {
      run_phase(p, ph, smem);
#ifdef PROBE_DUP
      if (ph >= 1 && ph <= 18 && ((PROBE_DUP >> ((ph - 1) % 9)) & 1)) run_phase(p, ph, smem);
#endif
      if (ph + 1 < ph_hi) xcd_barrier(xb);
    }
  } else {
    for (int ph = ph_lo; ph < ph_hi; ++ph) run_phase(p, ph, smem);
  }
}

extern "C" void kernel_launch(void* const* d_in, const int* in_sizes, int n_in, void* d_out, int out_size, void* d_ws, size_t ws_size, hipStream_t stream) {
  static int grid = 0;
  if (grid == 0) {
    if (n_in != 26 || ws_size < WS_END) { fprintf(stderr, "kernel_launch: bad n_in %d or ws_size %zu (need %zu)\n", n_in, ws_size, (size_t)WS_END); grid = -1; return; }
    int dev = 0, cus = 0, per_cu = 0;
    hipGetDevice(&dev);
    hipDeviceGetAttribute(&cus, hipDeviceAttributeMultiprocessorCount, dev);
    hipFuncSetAttribute((const void*)hybrid_fwd<true>, hipFuncAttributeMaxDynamicSharedMemorySize, SMEM_BYTES);
    hipFuncSetAttribute((const void*)hybrid_fwd<false>, hipFuncAttributeMaxDynamicSharedMemorySize, SMEM_BYTES);
    hipOccupancyMaxActiveBlocksPerMultiprocessor(&per_cu, (const void*)hybrid_fwd<true>, 256, SMEM_BYTES);
    if (per_cu < 1) per_cu = 1;
    if (per_cu > 2) per_cu = 2;
    grid = cus * per_cu;
  }
  if (grid < 0) return;
  Params p{};
  const float** pp = (const float**)&p;
  for (int i = 0; i < 26; ++i) pp[i] = (const float*)d_in[i];
  p.out = (float*)d_out;
  p.ws = (char*)d_ws;
#if MK_COOP
  int lo = 0, hi = N_PHASES;
  void* args[] = {&p, &lo, &hi};
  hipError_t e = hipLaunchCooperativeKernel((const void*)hybrid_fwd<true>, dim3(grid), dim3(256), args, SMEM_BYTES, stream);
  if (e != hipSuccess) fprintf(stderr, "cooperative launch failed: %s (grid %d)\n", hipGetErrorString(e), grid);
#else
  for (int ph = 0; ph < N_PHASES; ++ph) hybrid_fwd<false><<<grid, 256, SMEM_BYTES, stream>>>(p, ph, ph + 1);
#endif
}
#endif
```

```cpp
#include <hip/hip_runtime.h>
#include <hip/hip_cooperative_groups.h>
#include <stdint.h>
#include <stdio.h>
namespace cg = cooperative_groups;

#ifndef MK_COOP
#define MK_COOP 1
#endif

typedef unsigned short bf16_t;
typedef __attribute__((ext_vector_type(8))) short bf16x8;
typedef __attribute__((ext_vector_type(16))) float f32x16;
typedef __attribute__((ext_vector_type(4))) float f32x4;
typedef __attribute__((ext_vector_type(4))) unsigned u32x4;
typedef __attribute__((ext_vector_type(2))) unsigned u32x2;

#define DI __device__ __forceinline__
#define MFMA(a, b, c) __builtin_amdgcn_mfma_f32_32x32x16_bf16((a), (b), (c), 0, 0, 0)

typedef __attribute__((ext_vector_type(2))) __bf16 bf16x2_t;
typedef __attribute__((ext_vector_type(2))) float f32x2;
DI unsigned pk2(float lo, float hi) { f32x2 v = {lo, hi}; bf16x2_t b = __builtin_convertvector(v, bf16x2_t); return __builtin_bit_cast(unsigned, b); }
DI float bflo(unsigned u) { return __uint_as_float(u << 16); }
DI float bfhi(unsigned u) { return __uint_as_float(u & 0xffff0000u); }
DI bf16x8 as_bf8(u32x4 v) { return __builtin_bit_cast(bf16x8, v); }
DI int get_tid() { int t = (int)__builtin_amdgcn_workitem_id_x(); asm volatile("" : "+v"(t)); return t; }
DI float shfl_(float v, int src) { return __int_as_float(__builtin_amdgcn_ds_bpermute(src << 2, __float_as_int(v))); }
DI float shfl_xor_(float v, int o, int lane) { return shfl_(v, lane ^ o); }
DI float shfl_up_(float v, int o, int lane) { int s = lane - o; return shfl_(v, s < 0 ? lane : s); }
DI float sigmoidf_(float x) { return 1.f / (1.f + __expf(-x)); }

constexpr int TC = 4096;
constexpr int TL = 32768;
constexpr int TT = TC + TL;
constexpr int DM = 1024;
constexpr int NIN = 9232;
constexpr int NZ = 5136;
constexpr int ZW = 5120;
constexpr int DFF = 2816;
constexpr int NAQ = 0, NAK = 512, NAV = 1024, GQ = 1536, GK = 2048, GV = 2176, SQ = 2304, SK = 2816, SV = 2944,
              MQ = 3072, MK = 3584, MV = 4096, MO = 4608;
constexpr int MGC = 512;
constexpr size_t WS_WIN = 0;
constexpr size_t WS_WBR = WS_WIN + (size_t)NIN * DM * 2;
constexpr size_t WS_WOUT = WS_WBR + (size_t)4 * 1024 * 512 * 2;
constexpr size_t WS_WF1 = WS_WOUT + (size_t)1024 * 1024 * 2;
constexpr size_t WS_WF2 = WS_WF1 + (size_t)5632 * 1024 * 2;
constexpr size_t WS_Z = WS_WF2 + (size_t)1024 * DFF * 2;
constexpr size_t WS_H = WS_Z + (size_t)TT * ZW * 2;
constexpr size_t WS_HB = WS_H + (size_t)TT * DM * 2;
constexpr size_t WS_IF = WS_HB + (size_t)TT * 512 * 2;
constexpr size_t WS_MODS = WS_IF + (size_t)TT * 16 * 4;
constexpr size_t WS_ROPE = WS_MODS + (size_t)2 * 9 * 6144 * 4;
constexpr size_t WS_CNT = WS_ROPE + 2 * 1024 * 4;
constexpr size_t WS_BAR = WS_CNT + 4096;
constexpr size_t WS_END = WS_BAR + 16384;
constexpr size_t OUT_YP = 0, OUT_YS = 4194304, OUT_NA = 37748736, OUT_GQA = 46137344, OUT_SWA = 48234496,
                 OUT_C = 50331648, OUT_N = 54525952, OUT_M = 54558720;

constexpr int SMEM_BYTES = 74752;
constexpr float LOG2E = 1.4426950408889634f;

struct Params {
  const float *x_prompt, *x_sample, *cache_na, *cache_gqa, *cache_swa, *st_C, *st_n, *st_m, *c, *c_ctx,
      *w_mod, *b_mod, *norm1_g, *norm2_g, *w_in, *b_in, *na_rpb, *gqa_q_g, *gqa_k_g, *swa_sink, *ml_g,
      *w_branch, *w_out, *w_f1, *w_f2, *final_g;
  float* out;
  char* ws;
};

DI int cond_of_row(int grow) { return grow < TC ? 0 : 1 + ((grow - TC) >> 12); }

DI void phase0(const Params& p, char* smem) {
  const int tid = get_tid();
  if (blockIdx.x == 0) {
    int* cnt = (int*)(p.ws + WS_CNT);
    for (int i = tid; i < 1024 + 4096; i += 256) cnt[i] = 0;
    float* rc = (float*)(p.ws + WS_ROPE);
    for (int idx = tid; idx < 1024; idx += 256) {
      int pos = idx >> 4, j = idx & 15;
      float freq = exp2f(-(float)j * (13.287712379549449f / 16.f));
      float ang = (float)pos * freq;
      float k = rintf(ang * 0.15915494309189535f);
      float r = fmaf(-k, 6.2831854820251465f, ang);
      r = fmaf(k, 1.7484555e-7f, r);
      rc[idx] = __cosf(r);
      rc[1024 + idx] = __sinf(r);
    }
  }
  float* sS = (float*)smem;
  float* sR = (float*)(smem + 36864);
  for (int idx = tid; idx < 9 * 1024; idx += 256) {
    int cv = idx >> 10, k = idx & 1023;
    float v = cv == 0 ? p.c_ctx[k] : p.c[(cv - 1) * 1024 + k];
    sS[idx] = v / (1.f + __expf(-v));
  }
  __syncthreads();
  for (int item = blockIdx.x; item < 192; item += gridDim.x) {
    int l = item / 96, n0 = (item % 96) * 64, n = n0 + (tid & 63), kg = tid >> 6;
    const float* w = p.w_mod + (size_t)l * 1024 * 6144 + n;
    float acc[9];
#pragma unroll
    for (int cv = 0; cv < 9; ++cv) acc[cv] = 0.f;
#pragma unroll 4
    for (int k = kg * 256; k < kg * 256 + 256; ++k) {
      float wv = w[(size_t)k * 6144];
#pragma unroll
      for (int cv = 0; cv < 9; ++cv) acc[cv] = fmaf(sS[cv * 1024 + k], wv, acc[cv]);
    }
#pragma unroll
    for (int cv = 0; cv < 9; ++cv) sR[(kg * 9 + cv) * 64 + (tid & 63)] = acc[cv];
    __syncthreads();
    if (tid < 64) {
      float* mods = (float*)(p.ws + WS_MODS);
      float bm = p.b_mod[l * 6144 + n];
#pragma unroll
      for (int cv = 0; cv < 9; ++cv) {
        float s = sR[(0 * 9 + cv) * 64 + tid] + sR[(1 * 9 + cv) * 64 + tid] + sR[(2 * 9 + cv) * 64 + tid] + sR[(3 * 9 + cv) * 64 + tid];
        mods[(size_t)(l * 9 + cv) * 6144 + n] = s + bm;
      }
    }
    __syncthreads();
  }
}

DI void convert_tile(const float* __restrict__ src, int K, int N, bf16_t* __restrict__ dst, int kt, int nt, int f1perm, char* smem) {
  float* sT = (float*)smem;
  const int tid = get_tid();
  __syncthreads();
  {
    int n4 = (tid & 15) * 4, kr = tid >> 4;
#pragma unroll
    for (int i = 0; i < 4; ++i) {
      int k = kr + 16 * i;
      int n = nt * 64 + n4;
      f32x4 v = {0.f, 0.f, 0.f, 0.f};
      if (n < N) v = *(const f32x4*)(src + (size_t)(kt * 64 + k) * N + n);
      sT[k * 65 + n4 + 0] = v[0]; sT[k * 65 + n4 + 1] = v[1]; sT[k * 65 + n4 + 2] = v[2]; sT[k * 65 + n4 + 3] = v[3];
    }
  }
  __syncthreads();
  {
    int nl = tid >> 2, seg = (tid & 3) * 16;
    int n = nt * 64 + nl;
    if (n < N) {
      int drow = n;
      if (f1perm) { int j = n < DFF ? n : n - DFF; drow = (j >> 6) * 128 + (n < DFF ? 0 : 64) + (j & 63); }
      unsigned o[8];
#pragma unroll
      for (int q = 0; q < 8; ++q) o[q] = pk2(sT[(seg + 2 * q) * 65 + nl], sT[(seg + 2 * q + 1) * 65 + nl]);
      u32x4* d = (u32x4*)(dst + (size_t)drow * K + kt * 64 + seg);
      d[0] = u32x4{o[0], o[1], o[2], o[3]};
      d[1] = u32x4{o[4], o[5], o[6], o[7]};
    }
  }
}

DI void convert_weights(const Params& p, int l, char* smem) {
  for (int item = blockIdx.x; item < 5200; item += gridDim.x) {
    const float* src; bf16_t* dst; int K, N, kt, nt, perm = 0;
    int j = item;
    if (j < 2320) { src = p.w_in + (size_t)l * 1024 * NIN; K = 1024; N = NIN; dst = (bf16_t*)(p.ws + WS_WIN); kt = j / 145; nt = j % 145; }
    else if (j < 2832) { j -= 2320; int i = j >> 7; j &= 127; src = p.w_branch + (size_t)(l * 4 + i) * 512 * 1024; K = 512; N = 1024; dst = (bf16_t*)(p.ws + WS_WBR) + (size_t)i * 1024 * 512; kt = j >> 4; nt = j & 15; }
    else if (j < 3088) { j -= 2832; src = p.w_out + (size_t)l * 1024 * 1024; K = 1024; N = 1024; dst = (bf16_t*)(p.ws + WS_WOUT); kt = j >> 4; nt = j & 15; }
    else if (j < 4496) { j -= 3088; src = p.w_f1 + (size_t)l * 1024 * 5632; K = 1024; N = 5632; dst = (bf16_t*)(p.ws + WS_WF1); kt = j / 88; nt = j % 88; perm = 1; }
    else { j -= 4496; src = p.w_f2 + (size_t)l * DFF * 1024; K = DFF; N = 1024; dst = (bf16_t*)(p.ws + WS_WF2); kt = j >> 4; nt = j & 15; }
    convert_tile(src, K, N, dst, kt, nt, perm, smem);
  }
}

DI void norm_phase(const Params& p, int l, int which) {
  const int tid = get_tid(), lane = tid & 63, w = tid >> 6;
  const float* g = which == 0 ? p.norm1_g + l * 1024 : (which == 1 ? p.norm2_g + l * 1024 : p.final_g);
  const float* mods = (const float*)(p.ws + WS_MODS);
  bf16_t* H = (bf16_t*)(p.ws + WS_H);
  for (int row = blockIdx.x * 4 + w; row < TT; row += gridDim.x * 4) {
    const float* xr;
    if (which == 0 && l == 0) xr = row < TC ? p.x_prompt + (size_t)row * 1024 : p.x_sample + (size_t)(row - TC) * 1024;
    else xr = p.out + (size_t)row * 1024;
    f32x4 v[4];
    float ss = 0.f;
#pragma unroll
    for (int i = 0; i < 4; ++i) {
      v[i] = *(const f32x4*)(xr + 4 * lane + 256 * i);
      ss += v[i][0] * v[i][0] + v[i][1] * v[i][1] + v[i][2] * v[i][2] + v[i][3] * v[i][3];
    }
#pragma unroll
    for (int o = 32; o >= 1; o >>= 1) ss += shfl_xor_(ss, o, lane);
    float rstd = rsqrtf(ss * (1.f / 1024.f) + 1e-6f);
    if (which == 2) {
      float* yo = p.out + (size_t)row * 1024;
#pragma unroll
      for (int i = 0; i < 4; ++i) {
        int k = 4 * lane + 256 * i;
        f32x4 g4 = *(const f32x4*)(g + k);
        f32x4 y;
#pragma unroll
        for (int e = 0; e < 4; ++e) y[e] = v[i][e] * rstd * g4[e];
        *(f32x4*)(yo + k) = y;
      }
    } else {
      const float* mr = mods + (size_t)(l * 9 + cond_of_row(row)) * 6144 + (which == 0 ? 0 : 3072);
#pragma unroll
      for (int i = 0; i < 4; ++i) {
        int k = 4 * lane + 256 * i;
        f32x4 g4 = *(const f32x4*)(g + k);
        f32x4 sh = *(const f32x4*)(mr + k);
        f32x4 sc = *(const f32x4*)(mr + 1024 + k);
        float y[4];
#pragma unroll
        for (int e = 0; e < 4; ++e) y[e] = (v[i][e] * rstd * g4[e]) * (1.f + sc[e]) + sh[e];
        *(u32x2*)(H + (size_t)row * 1024 + k) = u32x2{pk2(y[0], y[1]), pk2(y[2], y[3])};
      }
    }
  }
}

template <bool DB = true>
DI void gemm_core(const bf16_t* __restrict__ A, int lda, const bf16_t* __restrict__ B, int ldb, int K, f32x16 (&acc)[2][2], char* smem) {
  bf16_t* sA = (bf16_t*)smem;
  bf16_t* sB = sA + (DB ? 2 : 1) * 128 * 72;
  const int tid = get_tid(), lane = tid & 63, w = tid >> 6, wm = w >> 1, wn = w & 1, l31 = lane & 31, hh = lane >> 5;
  const int lrow = tid >> 3, lseg = (tid & 7) * 8;
  const char* Ab = (const char*)A;
  const char* Bb = (const char*)B;
  const unsigned offA = (unsigned)(lrow * lda + lseg) * 2u, offB = (unsigned)(lrow * ldb + lseg) * 2u;
  const unsigned stepA = (unsigned)lda * 64u, stepB = (unsigned)ldb * 64u;
  u32x4 ra[4], rb[4];
#pragma unroll
  for (int i = 0; i < 4; ++i) { ra[i] = *(const u32x4*)(Ab + (offA + i * stepA)); rb[i] = *(const u32x4*)(Bb + (offB + i * stepB)); }
  __syncthreads();
#pragma unroll
  for (int i = 0; i < 4; ++i) { *(u32x4*)(sA + (lrow + 32 * i) * 72 + lseg) = ra[i]; *(u32x4*)(sB + (lrow + 32 * i) * 72 + lseg) = rb[i]; }
  __syncthreads();
  const int nk = K >> 6;
  for (int kt = 0; kt < nk; ++kt) {
    const int buf = DB ? (kt & 1) : 0;
    if (kt + 1 < nk) {
#pragma unroll
      for (int i = 0; i < 4; ++i) { ra[i] = *(const u32x4*)(Ab + (offA + i * stepA + (unsigned)(kt + 1) * 128u)); rb[i] = *(const u32x4*)(Bb + (offB + i * stepB + (unsigned)(kt + 1) * 128u)); }
    }
    __builtin_amdgcn_sched_barrier(0);
    const bf16_t* pa = sA + (buf * 128 + 64 * wm + l31) * 72 + 8 * hh;
    const bf16_t* pb = sB + (buf * 128 + 64 * wn + l31) * 72 + 8 * hh;
    bf16x8 a0 = *(const bf16x8*)(pa), a1 = *(const bf16x8*)(pa + 32 * 72);
    bf16x8 b0 = *(const bf16x8*)(pb), b1 = *(const bf16x8*)(pb + 32 * 72);
#pragma unroll
    for (int ks = 0; ks < 4; ++ks) {
      bf16x8 na0 = a0, na1 = a1, nb0 = b0, nb1 = b1;
      if (ks < 3) {
        na0 = *(const bf16x8*)(pa + (ks + 1) * 16); na1 = *(const bf16x8*)(pa + 32 * 72 + (ks + 1) * 16);
        nb0 = *(const bf16x8*)(pb + (ks + 1) * 16); nb1 = *(const bf16x8*)(pb + 32 * 72 + (ks + 1) * 16);
      }
      __builtin_amdgcn_sched_barrier(0);
      acc[0][0] = MFMA(a0, b0, acc[0][0]);
      acc[0][1] = MFMA(a0, b1, acc[0][1]);
      acc[1][0] = MFMA(a1, b0, acc[1][0]);
      acc[1][1] = MFMA(a1, b1, acc[1][1]);
      __builtin_amdgcn_sched_barrier(0);
      a0 = na0; a1 = na1; b0 = nb0; b1 = nb1;
    }
    if (kt + 1 < nk) {
      const int nb = DB ? (buf ^ 1) : 0;
      if (!DB) __syncthreads();
#pragma unroll
      for (int i = 0; i < 4; ++i) { *(u32x4*)(sA + (nb * 128 + lrow + 32 * i) * 72 + lseg) = ra[i]; *(u32x4*)(sB + (nb * 128 + lrow + 32 * i) * 72 + lseg) = rb[i]; }
    }
    __syncthreads();
  }
}

DI void zero_acc(f32x16 (&acc)[2][2]) {
#pragma unroll
  for (int i = 0; i < 2; ++i)
#pragma unroll
    for (int j = 0; j < 2; ++j)
#pragma unroll
      for (int r = 0; r < 16; ++r) acc[i][j][r] = 0.f;
}

DI void acc_to_lds(const f32x16 (&acc)[2][2], float* sC) {
  const int tid = get_tid(), lane = tid & 63, w = tid >> 6, wm = w >> 1, wn = w & 1, l31 = lane & 31, hh = lane >> 5;
#pragma unroll
  for (int i = 0; i < 2; ++i)
#pragma unroll
    for (int j = 0; j < 2; ++j)
#pragma unroll
      for (int r = 0; r < 16; ++r) {
        int row = 64 * wm + 32 * i + 8 * (r >> 2) + 4 * hh + (r & 3), col = 64 * wn + 32 * j + l31;
        sC[row * 132 + col] = acc[i][j][r];
      }
  __syncthreads();
}

struct TileIter {
  int local, step, total, nN, xcd; bool swz;
  DI void init(int nN_) {
    nN = nN_;
    swz = (gridDim.x & 7) == 0;
    if (swz) { xcd = blockIdx.x & 7; local = blockIdx.x >> 3; step = gridDim.x >> 3; total = 36 * nN; }
    else { xcd = 0; local = blockIdx.x; step = gridDim.x; total = 288 * nN; }
  }
  DI bool next(int& mt, int& nt) {
    if (local >= total) return false;
    if (swz) {
      const int per_sr = 8 * nN;
      const int sr = local / per_sr, r = local - sr * per_sr;
      const int rows = (36 - 8 * sr) < 8 ? (36 - 8 * sr) : 8;
      nt = r / rows; mt = 36 * xcd + 8 * sr + (r - nt * rows);
    } else { mt = local / nN; nt = local - mt * nN; }
    local += step;
    return true;
  }
};

DI void epi_inproj(const Params& p, int l, int mt, int nt, const float* sC) {
  const int tid = get_tid();
  const int chunk = tid & 15, lane = tid & 63;
  const int half = chunk >> 3, d0 = (chunk & 7) * 8;
  const int c0 = nt * 128 + half * 64;
  if (c0 >= NZ && c0 != 5120) return;
  bf16_t* Z = (bf16_t*)(p.ws + WS_Z);
  const float* bias = p.b_in + (size_t)l * NIN + c0;
  if (c0 == 5120) {
    if (chunk >= 2) return;
    const f32x4 b0 = *(const f32x4*)(bias + d0), b1 = *(const f32x4*)(bias + d0 + 4);
#pragma unroll
    for (int it = 0; it < 8; ++it) {
      const int rt = (tid >> 4) + 16 * it, grow = mt * 128 + rt;
      const float* crow = sC + rt * 132 + d0;
      f32x4 v0 = *(const f32x4*)crow + b0, v1 = *(const f32x4*)(crow + 4) + b1;
      if (chunk == 1) {
#pragma unroll
        for (int e = 0; e < 4; ++e) {
          v0[e] = fminf(v0[e], 0.f) - log1pf(__expf(-fabsf(v0[e])));
          v1[e] = fminf(v1[e], 0.f) - log1pf(__expf(-fabsf(v1[e])));
        }
      }
      float* IF = (float*)(p.ws + WS_IF) + (size_t)grow * 16 + d0;
      *(f32x4*)IF = v0; *(f32x4*)(IF + 4) = v1;
    }
    return;
  }
  bool hn = false, rope = false;
  const float* hg = nullptr;
  float scale = 1.f;
  int kvsel = -1, kvh = 0, kvH = 0; size_t kvbase = 0;
  if (c0 < NAK) {}
  else if (c0 < NAV) { kvbase = OUT_NA; kvsel = 0; kvh = (c0 - NAK) >> 6; kvH = 8; }
  else if (c0 < GQ) { kvbase = OUT_NA; kvsel = 1; kvh = (c0 - NAV) >> 6; kvH = 8; }
  else if (c0 < GK) { hn = true; hg = p.gqa_q_g + l * 64; rope = true; }
  else if (c0 < GV) { hn = true; hg = p.gqa_k_g + l * 64; rope = true; kvbase = OUT_GQA; kvsel = 0; kvh = (c0 - GK) >> 6; kvH = 2; }
  else if (c0 < SQ) { kvbase = OUT_GQA; kvsel = 1; kvh = (c0 - GV) >> 6; kvH = 2; }
  else if (c0 < SK) { rope = true; }
  else if (c0 < SV) { rope = true; kvbase = OUT_SWA; kvsel = 0; kvh = (c0 - SK) >> 6; kvH = 2; }
  else if (c0 < MQ) { kvbase = OUT_SWA; kvsel = 1; kvh = (c0 - SV) >> 6; kvH = 2; }
  else if (c0 >= MK && c0 < MV) { scale = 0.08838834764831845f; }
  if (c0 < NAK || (c0 >= GQ && c0 < GK) || (c0 >= SQ && c0 < SK)) scale = 0.125f * LOG2E;
  const bool latent_tile = mt >= 32;
  if (latent_tile) kvsel = -1; else rope = false;
  const int dp = d0 ^ 16;
  const bool second = (d0 & 16) != 0;
  const f32x4 b0 = *(const f32x4*)(bias + d0), b1 = *(const f32x4*)(bias + d0 + 4);
  f32x4 pb0 = b0, pb1 = b1, g0 = {1.f, 1.f, 1.f, 1.f}, g1 = g0, pg0 = g0, pg1 = g0;
  if (rope) { pb0 = *(const f32x4*)(bias + dp); pb1 = *(const f32x4*)(bias + dp + 4); }
  if (hn) {
    g0 = *(const f32x4*)(hg + d0); g1 = *(const f32x4*)(hg + d0 + 4);
    pg0 = *(const f32x4*)(hg + dp); pg1 = *(const f32x4*)(hg + dp + 4);
  }
  const float* rcos = (const float*)(p.ws + WS_ROPE);
  const float* rsin = rcos + 1024;
#pragma unroll 4
  for (int it = 0; it < 8; ++it) {
    const int rt = (tid >> 4) + 16 * it, grow = mt * 128 + rt;
    const float* crow = sC + rt * 132 + half * 64;
    f32x4 x0 = *(const f32x4*)(crow + d0) + b0, x1 = *(const f32x4*)(crow + d0 + 4) + b1;
    float rs = 1.f;
    if (hn) {
      float ss = x0[0] * x0[0] + x0[1] * x0[1] + x0[2] * x0[2] + x0[3] * x0[3] + x1[0] * x1[0] + x1[1] * x1[1] + x1[2] * x1[2] + x1[3] * x1[3];
      ss += shfl_xor_(ss, 1, lane); ss += shfl_xor_(ss, 2, lane); ss += shfl_xor_(ss, 4, lane);
      rs = rsqrtf(ss * (1.f / 64.f) + 1e-6f);
    }
    const float sc = rs * scale;
    x0 = x0 * sc * g0; x1 = x1 * sc * g1;
    if (rope) {
      f32x4 y0 = (*(const f32x4*)(crow + dp) + pb0) * sc * pg0, y1 = (*(const f32x4*)(crow + dp + 4) + pb1) * sc * pg1;
      const int t = (grow - TC) & 4095;
      const int pos = (d0 & 32) ? (t & 63) : (t >> 6);
      const int fj = d0 & 15;
      const f32x4 c0v = *(const f32x4*)(rcos + pos * 16 + fj), c1v = *(const f32x4*)(rcos + pos * 16 + fj + 4);
      const f32x4 s0v = *(const f32x4*)(rsin + pos * 16 + fj), s1v = *(const f32x4*)(rsin + pos * 16 + fj + 4);
      if (second) { x0 = x0 * c0v + y0 * s0v; x1 = x1 * c1v + y1 * s1v; }
      else { x0 = x0 * c0v - y0 * s0v; x1 = x1 * c1v - y1 * s1v; }
    }
    __builtin_nontemporal_store(u32x4{pk2(x0[0], x0[1]), pk2(x0[2], x0[3]), pk2(x1[0], x1[1]), pk2(x1[2], x1[3])}, (u32x4*)(Z + (size_t)grow * ZW + c0 + d0));
    if (kvsel >= 0) {
      const int cb = grow >> 8, cs = grow & 255;
      float* kv = p.out + kvbase + ((((size_t)(cb * 2 + l) * 2 + kvsel) * 256 + cs) * kvH + kvh) * 64 + d0;
      *(f32x4*)kv = x0; *(f32x4*)(kv + 4) = x1;
    }
  }
}

DI void phase_inproj(const Params& p, int l, char* smem) {
  const bf16_t* H = (const bf16_t*)(p.ws + WS_H);
  const bf16_t* W = (const bf16_t*)(p.ws + WS_WIN);
  TileIter ti; ti.init(41);
  for (int mt, nt; ti.next(mt, nt);) {
    f32x16 acc[2][2];
    zero_acc(acc);
    gemm_core(H + (size_t)mt * 128 * DM, DM, W + (size_t)nt * 128 * DM, DM, DM, acc, smem);
    acc_to_lds(acc, (float*)smem);
    epi_inproj(p, l, mt, nt, (const float*)smem);
  }
}

DI void phase_merge(const Params& p, int l, char* smem) {
  const int tid = get_tid(), lane = tid & 63, w = tid >> 6, wn = w & 1, l31 = lane & 31;
  const bf16_t* H = (const bf16_t*)(p.ws + WS_H);
  const bf16_t* W = (const bf16_t*)(p.ws + WS_WIN);
  const bf16_t* WB = (const bf16_t*)(p.ws + WS_WBR);
  bf16_t* Z = (bf16_t*)(p.ws + WS_Z);
  TileIter ti; ti.init(8);
  for (int mt, nt; ti.next(mt, nt);) {
    f32x16 mg[2][2];
    zero_acc(mg);
#pragma unroll 1
    for (int i = 0; i < 4; ++i) {
      f32x16 acc[2][2];
      zero_acc(acc);
      gemm_core<false>(H + (size_t)mt * 128 * DM, DM, W + (size_t)(NZ + i * 1024 + nt * 128) * DM, DM, DM, acc, smem);
      unsigned* sG = (unsigned*)(smem + 36864) + tid;
#pragma unroll
      for (int j = 0; j < 2; ++j) {
        float bj = p.b_in[(size_t)l * NIN + NZ + i * 1024 + nt * 128 + 64 * wn + 32 * j + l31];
#pragma unroll
        for (int ii = 0; ii < 2; ++ii)
#pragma unroll
          for (int r = 0; r < 8; ++r) sG[((ii * 2 + j) * 8 + r) * 256] = pk2(sigmoidf_(acc[ii][j][2 * r] + bj), sigmoidf_(acc[ii][j][2 * r + 1] + bj));
      }
      zero_acc(acc);
      const int colA = i == 0 ? NAQ : (i == 1 ? GQ : (i == 2 ? SQ : MQ));
      gemm_core<false>(Z + (size_t)mt * 128 * ZW + colA, ZW, WB + (size_t)(i * 1024 + nt * 128) * 512, 512, 512, acc, smem);
#pragma unroll
      for (int ii = 0; ii < 2; ++ii)
#pragma unroll
        for (int j = 0; j < 2; ++j)
#pragma unroll
          for (int r = 0; r < 8; ++r) {
            const unsigned gpv = sG[((ii * 2 + j) * 8 + r) * 256];
            mg[ii][j][2 * r] += bflo(gpv) * acc[ii][j][2 * r];
            mg[ii][j][2 * r + 1] += bfhi(gpv) * acc[ii][j][2 * r + 1];
          }
    }
    float* sC = (float*)smem;
    __syncthreads();
    acc_to_lds(mg, sC);
#pragma unroll
    for (int it = 0; it < 8; ++it) {
      const int rt = (tid >> 4) + 16 * it, ch = (tid & 15) * 8;
      const float* crow = sC + rt * 132 + ch;
      f32x4 a = *(const f32x4*)crow, b = *(const f32x4*)(crow + 4);
      __builtin_nontemporal_store(u32x4{pk2(a[0], a[1]), pk2(a[2], a[3]), pk2(b[0], b[1]), pk2(b[2], b[3])}, (u32x4*)(Z + (size_t)(mt * 128 + rt) * ZW + MGC + nt * 128 + ch));
    }
  }
}

DI void phase_resid(const Params& p, int l, int which, char* smem) {
  const int tid = get_tid();
  const bf16_t* Z = (const bf16_t*)(p.ws + WS_Z);
  const bf16_t* W = (const bf16_t*)(p.ws + (which == 0 ? WS_WOUT : WS_WF2));
  const int K = which == 0 ? 1024 : DFF;
  const int acol = which == 0 ? MGC : 0;
  const int goff = which == 0 ? 2048 : 5120;
  const float* mods = (const float*)(p.ws + WS_MODS);
  TileIter ti; ti.init(8);
  for (int mt, nt; ti.next(mt, nt);) {
    f32x16 acc[2][2];
    zero_acc(acc);
    gemm_core(Z + (size_t)mt * 128 * ZW + acol, ZW, W + (size_t)nt * 128 * K, K, K, acc, smem);
    float* sC = (float*)smem;
    acc_to_lds(acc, sC);
    const int n = nt * 128 + (tid & 31) * 4;
    const f32x4 g4 = *(const f32x4*)(mods + (size_t)(l * 9 + cond_of_row(mt * 128)) * 6144 + goff + n);
    const float* xbase = (which == 0 && l == 0) ? (mt < 32 ? p.x_prompt + (size_t)mt * 128 * 1024 : p.x_sample + (size_t)(mt * 128 - TC) * 1024)
                                                : p.out + (size_t)mt * 128 * 1024;
#pragma unroll 4
    for (int it = 0; it < 16; ++it) {
      const int rt = (tid >> 5) + 8 * it, grow = mt * 128 + rt;
      const f32x4 x4 = *(const f32x4*)(xbase + (size_t)rt * 1024 + n);
      const f32x4 c4 = *(const f32x4*)(sC + rt * 132 + (tid & 31) * 4);
      __builtin_nontemporal_store(x4 + g4 * c4, (f32x4*)(p.out + (size_t)grow * 1024 + n));
    }
  }
}

DI void phase_ffn1(const Params& p, int l, char* smem) {
  const int tid = get_tid();
  const bf16_t* H = (const bf16_t*)(p.ws + WS_H);
  const bf16_t* W = (const bf16_t*)(p.ws + WS_WF1);
  bf16_t* Z = (bf16_t*)(p.ws + WS_Z);
  TileIter ti; ti.init(44);
  for (int mt, nt; ti.next(mt, nt);) {
    f32x16 acc[2][2];
    zero_acc(acc);
    gemm_core(H + (size_t)mt * 128 * DM, DM, W + (size_t)nt * 128 * DM, DM, DM, acc, smem);
    float* sC = (float*)smem;
    acc_to_lds(acc, sC);
#pragma unroll
    for (int it = 0; it < 4; ++it) {
      const int rt = (tid >> 3) + 32 * it, ch = (tid & 7) * 8;
      const float* crow = sC + rt * 132 + ch;
      float o[8];
#pragma unroll
      for (int hq = 0; hq < 2; ++hq) {
        f32x4 gt = *(const f32x4*)(crow + 4 * hq), up = *(const f32x4*)(crow + 64 + 4 * hq);
#pragma unroll
        for (int e = 0; e < 4; ++e) o[4 * hq + e] = gt[e] / (1.f + __expf(-gt[e])) * up[e];
      }
      __builtin_nontemporal_store(u32x4{pk2(o[0], o[1]), pk2(o[2], o[3]), pk2(o[4], o[5]), pk2(o[6], o[7])}, (u32x4*)(Z + (size_t)(mt * 128 + rt) * ZW + nt * 64 + ch));
    }
  }
}

struct AttnArgs {
  const void* k1; const void* v1; int stride1; int f32_1; int nblk1;
  const bf16_t* k2; const bf16_t* v2; int blk0_2; int nblk2;
  bf16_t* qo;
  int qpos0;
  int mode;
  float m0, l0;
  const float* rpb;
};

template <int QT>
DI void attn_item(const AttnArgs& a, char* smem) {
  bf16_t* sK = (bf16_t*)smem;
  bf16_t* sVt = sK + 2 * 64 * 72;
  float* sRpb = (float*)(smem + 4 * 64 * 72 * 2);
  const int tid = get_tid(), lane = tid & 63, l31 = lane & 31, hh = lane >> 5;
  const int dg = tid & 7, kp = tid >> 3;
  __syncthreads();
  if (a.mode == 2) for (int i = tid; i < 465; i += 256) sRpb[i] = a.rpb[i] * LOG2E;
  bf16x8 qf[QT][4];
#pragma unroll
  for (int qt = 0; qt < QT; ++qt)
#pragma unroll
    for (int st = 0; st < 4; ++st) qf[qt][st] = *(const bf16x8*)(a.qo + (size_t)(32 * qt + l31) * ZW + 16 * st + 8 * hh);
  f32x16 o[QT][2];
  float m_run[QT], l_run[QT];
#pragma unroll
  for (int qt = 0; qt < QT; ++qt) {
    m_run[qt] = a.m0; l_run[qt] = a.l0;
#pragma unroll
    for (int dt = 0; dt < 2; ++dt)
#pragma unroll
      for (int r = 0; r < 16; ++r) o[qt][dt][r] = 0.f;
  }
  const int nblk = a.nblk1 + a.nblk2;
  u32x4 rk[2], rv[2];
  auto load_blk = [&](int b) {
    if (b < a.nblk1) {
      if (a.f32_1) {
        const float* kb = (const float*)a.k1 + (size_t)(b * 64 + 2 * kp) * a.stride1 + 8 * dg;
        const float* vb = (const float*)a.v1 + (size_t)(b * 64 + 2 * kp) * a.stride1 + 8 * dg;
#pragma unroll
        for (int i = 0; i < 2; ++i) {
          f32x4 k0 = *(const f32x4*)(kb + (size_t)i * a.stride1), k1 = *(const f32x4*)(kb + (size_t)i * a.stride1 + 4);
          f32x4 v0 = *(const f32x4*)(vb + (size_t)i * a.stride1), v1 = *(const f32x4*)(vb + (size_t)i * a.stride1 + 4);
          rk[i] = u32x4{pk2(k0[0], k0[1]), pk2(k0[2], k0[3]), pk2(k1[0], k1[1]), pk2(k1[2], k1[3])};
          rv[i] = u32x4{pk2(v0[0], v0[1]), pk2(v0[2], v0[3]), pk2(v1[0], v1[1]), pk2(v1[2], v1[3])};
        }
      } else {
        const bf16_t* kb = (const bf16_t*)a.k1 + (size_t)(b * 64 + 2 * kp) * a.stride1 + 8 * dg;
        const bf16_t* vb = (const bf16_t*)a.v1 + (size_t)(b * 64 + 2 * kp) * a.stride1 + 8 * dg;
#pragma unroll
        for (int i = 0; i < 2; ++i) { rk[i] = *(const u32x4*)(kb + (size_t)i * a.stride1); rv[i] = *(const u32x4*)(vb + (size_t)i * a.stride1); }
      }
    } else {
      const int kb0 = (a.blk0_2 + (b - a.nblk1)) * 64 + 2 * kp;
      const bf16_t* kb = a.k2 + (size_t)kb0 * ZW + 8 * dg;
      const bf16_t* vb = a.v2 + (size_t)kb0 * ZW + 8 * dg;
#pragma unroll
      for (int i = 0; i < 2; ++i) { rk[i] = *(const u32x4*)(kb + (size_t)i * ZW); rv[i] = *(const u32x4*)(vb + (size_t)i * ZW); }
    }
  };
  auto store_blk = [&](int buf) {
    bf16_t* k = sK + buf * 64 * 72; bf16_t* v = sVt + buf * 64 * 72;
    *(u32x4*)(k + (2 * kp) * 72 + 8 * dg) = rk[0];
    *(u32x4*)(k + (2 * kp + 1) * 72 + 8 * dg) = rk[1];
#pragma unroll
    for (int e = 0; e < 4; ++e) {
      unsigned a0 = rv[0][e], a1 = rv[1][e];
      *(unsigned*)(v + (8 * dg + 2 * e) * 72 + 2 * (kp ^ (4 * dg))) = (a0 & 0xffffu) | (a1 << 16);
      *(unsigned*)(v + (8 * dg + 2 * e + 1) * 72 + 2 * (kp ^ (4 * dg))) = (a0 >> 16) | (a1 & 0xffff0000u);
    }
  };
  load_blk(0);
  store_blk(0);
  if (nblk > 1) load_blk(1);
  __syncthreads();
  for (int b = 0; b < nblk; ++b) {
    const bf16_t* cK = sK + (b & 1) * 64 * 72;
    const bf16_t* cV = sVt + (b & 1) * 64 * 72;
    f32x16 s[QT][2];
#pragma unroll
    for (int qt = 0; qt < QT; ++qt)
#pragma unroll
      for (int kt = 0; kt < 2; ++kt)
#pragma unroll
        for (int r = 0; r < 16; ++r) s[qt][kt][r] = 0.f;
#pragma unroll
    for (int st = 0; st < 4; ++st) {
      bf16x8 k0 = *(const bf16x8*)(cK + l31 * 72 + 16 * st + 8 * hh);
      bf16x8 k1 = *(const bf16x8*)(cK + (32 + l31) * 72 + 16 * st + 8 * hh);
#pragma unroll
      for (int qt = 0; qt < QT; ++qt) {
        s[qt][0] = MFMA(k0, qf[qt][st], s[qt][0]);
        s[qt][1] = MFMA(k1, qf[qt][st], s[qt][1]);
      }
    }
    const bool seg2 = b >= a.nblk1;
#pragma unroll
    for (int qt = 0; qt < QT; ++qt) {
      if (seg2 && a.mode == 1) {
        const int kbase = (a.blk0_2 + (b - a.nblk1)) * 64;
        const int qpos = a.qpos0 + 32 * qt + l31;
#pragma unroll
        for (int kt = 0; kt < 2; ++kt)
#pragma unroll
          for (int r = 0; r < 16; ++r) {
            int kpos = kbase + 32 * kt + 8 * (r >> 2) + 4 * hh + (r & 3);
            int dd = qpos - kpos; dd = dd < 0 ? -dd : dd;
            s[qt][kt][r] = dd <= 128 ? s[qt][kt][r] : -INFINITY;
          }
      } else if (seg2 && a.mode == 2) {
        const int kr = a.blk0_2 + (b - a.nblk1);
        const int qpos = a.qpos0 + 32 * qt + l31;
        const int qr = qpos >> 6, qc = qpos & 63;
        int rs = qr - 4; rs = rs < 0 ? 0 : (rs > 56 ? 56 : rs);
        int cs = qc - 8; cs = cs < 0 ? 0 : (cs > 48 ? 48 : cs);
        const bool rowok = kr >= rs && kr <= rs + 7;
        const int bbase = (kr - qr + 7) * 31 - qc + 15;
#pragma unroll
        for (int kt = 0; kt < 2; ++kt)
#pragma unroll
          for (int r = 0; r < 16; ++r) {
            int kc = 32 * kt + 8 * (r >> 2) + 4 * hh + (r & 3);
            bool ok = rowok && (unsigned)(kc - cs) < 16u;
            const float bias = sRpb[ok ? bbase + kc : 0];
            s[qt][kt][r] = ok ? s[qt][kt][r] + bias : -INFINITY;
          }
      }
      float mx = -INFINITY;
#pragma unroll
      for (int kt = 0; kt < 2; ++kt)
#pragma unroll
        for (int r = 0; r < 16; ++r) mx = fmaxf(mx, s[qt][kt][r]);
      mx = fmaxf(mx, shfl_xor_(mx, 32, lane));
      const float m_new = fmaxf(m_run[qt], mx);
      if (__builtin_amdgcn_ballot_w64(m_new > m_run[qt]) != 0ull) {
        const float alpha = __builtin_amdgcn_exp2f(m_run[qt] - m_new);
        l_run[qt] *= alpha;
#pragma unroll
        for (int dt = 0; dt < 2; ++dt)
#pragma unroll
          for (int r = 0; r < 16; ++r) o[qt][dt][r] *= alpha;
        m_run[qt] = m_new;
      }
      float ps = 0.f;
#pragma unroll
      for (int kt = 0; kt < 2; ++kt)
#pragma unroll
        for (int r = 0; r < 16; ++r) { float e = __builtin_amdgcn_exp2f(s[qt][kt][r] - m_run[qt]); s[qt][kt][r] = e; ps += e; }
      ps += shfl_xor_(ps, 32, lane);
      l_run[qt] += ps;
    }
#pragma unroll
    for (int kt = 0; kt < 2; ++kt)
#pragma unroll
      for (int s2 = 0; s2 < 2; ++s2) {
        u32x4 pb[QT];
#pragma unroll
        for (int qt = 0; qt < QT; ++qt)
          pb[qt] = u32x4{pk2(s[qt][kt][8 * s2 + 0], s[qt][kt][8 * s2 + 1]), pk2(s[qt][kt][8 * s2 + 2], s[qt][kt][8 * s2 + 3]),
                         pk2(s[qt][kt][8 * s2 + 4], s[qt][kt][8 * s2 + 5]), pk2(s[qt][kt][8 * s2 + 6], s[qt][kt][8 * s2 + 7])};
#pragma unroll
        for (int dt = 0; dt < 2; ++dt) {
          const int rg = (4 * dt + (l31 >> 3)) & 7;
          const bf16_t* vrow = cV + (32 * dt + l31) * 72 + 4 * hh;
          u32x2 lo = *(const u32x2*)(vrow + 8 * ((4 * kt + 2 * s2) ^ rg)), hi = *(const u32x2*)(vrow + 8 * ((4 * kt + 2 * s2 + 1) ^ rg));
          const bf16x8 vfr = as_bf8(u32x4{lo[0], lo[1], hi[0], hi[1]});
#pragma unroll
          for (int qt = 0; qt < QT; ++qt) o[qt][dt] = MFMA(vfr, as_bf8(pb[qt]), o[qt][dt]);
        }
      }
    if (b + 1 < nblk) store_blk((b + 1) & 1);
    if (b + 2 < nblk) load_blk(b + 2);
    __builtin_amdgcn_sched_barrier(0);
    __syncthreads();
  }
#pragma unroll
  for (int qt = 0; qt < QT; ++qt) {
    const float inv = 1.f / l_run[qt];
#pragma unroll
    for (int dt = 0; dt < 2; ++dt)
#pragma unroll
      for (int g = 0; g < 4; ++g) {
        *(u32x2*)(a.qo + (size_t)(32 * qt + l31) * ZW + 32 * dt + 8 * g + 4 * hh) =
            u32x2{pk2(o[qt][dt][4 * g] * inv, o[qt][dt][4 * g + 1] * inv), pk2(o[qt][dt][4 * g + 2] * inv, o[qt][dt][4 * g + 3] * inv)};
      }
  }
}

DI float wave_scan_sum(float v, int lane) {
#pragma unroll
  for (int o = 1; o < 64; o <<= 1) { float t = shfl_up_(v, o, lane); if (lane >= o) v += t; }
  return v;
}
DI float wave_scan_max(float v, int lane) {
#pragma unroll
  for (int o = 1; o < 64; o <<= 1) { float t = shfl_up_(v, o, lane); if (lane >= o) v = fmaxf(v, t); }
  return v;
}

#define RLX_AGENT __ATOMIC_RELAXED, __HIP_MEMORY_SCOPE_AGENT
DI void mlstm_item(const Params& p, char* smem, int l, int b, int h, int eh, int dir, bool latent, int* prog_self, int* prog_partner) {
  bf16_t* sQ = (bf16_t*)smem;
  bf16_t* sK = sQ + 64 * 136;
  bf16_t* sKw = sK + 64 * 136;
  bf16_t* sVt = sKw + 128 * 72;
  float* sN = (float*)(sVt + 64 * 72);
  float* sA = sN + 128;
  const int tid = get_tid();
  const int S = latent ? 4096 : 256, nc = S >> 6, half = nc >> 1;
  const int rowbase = latent ? TC + b * 4096 : b * 256;
  bf16_t* Z = (bf16_t*)(p.ws + WS_Z);
  bf16_t* HB = (bf16_t*)(p.ws + WS_HB);
  const float* IF = (const float*)(p.ws + WS_IF);
  f32x16 C[4];
  float m_state = 0.f;
  __syncthreads();
  {
    const int lane = tid & 63, w = tid >> 6, l31 = lane & 31, hh = lane >> 5, et = w & 1;
    if (latent) {
      const size_t sidx = (size_t)((b * 2 + l) * 2 + dir) * 4 + h;
      const float* C0 = p.st_C + sidx * 128 * 128;
      int cidx0 = 4 * hh * 128 + 64 * eh + 32 * et + l31; asm volatile("" : "+v"(cidx0));
#pragma unroll
      for (int dt = 0; dt < 4; ++dt) {
#pragma unroll
        for (int r = 0; r < 16; ++r) C[dt][r] = C0[(unsigned)(cidx0 + (32 * dt + 8 * (r >> 2) + (r & 3)) * 128)];
        __builtin_amdgcn_sched_barrier(0);
      }
      if (tid < 128) sN[tid] = p.st_n[sidx * 128 + tid];
      m_state = p.st_m[sidx];
    } else {
#pragma unroll
      for (int dt = 0; dt < 4; ++dt)
#pragma unroll
        for (int r = 0; r < 16; ++r) C[dt][r] = 0.f;
      if (tid < 128) sN[tid] = 0.f;
    }
  }
  float ip_n, lf_n;
  u32x4 rq[4], rkk[4], rvv[2];
  auto prefetch = [&](int c) {
    const int cbase = rowbase + (dir ? (nc - 1 - c) * 64 : c * 64);
    int tidc = tid; asm volatile("" : "+v"(tidc));
    const int lane = tidc & 63;
    const int tokp = cbase + (dir ? 63 - lane : lane);
    ip_n = IF[(size_t)tokp * 16 + dir * 4 + h];
    lf_n = IF[(size_t)tokp * 16 + 8 + dir * 4 + h];
#pragma unroll
    for (int i = 0; i < 4; ++i) {
      int id = tidc + 256 * i, pr = id >> 4, seg = (id & 15) * 8;
      int tok = cbase + (dir ? 63 - pr : pr);
      rq[i] = *(const u32x4*)(Z + (size_t)tok * ZW + MQ + h * 128 + seg);
    }
    const int dgp = (tidc & 15) * 8;
#pragma unroll
    for (int i = 0; i < 2; ++i) {
      const int s0 = 2 * ((tidc >> 4) + 16 * i), s1 = s0 + 1;
      const int t0 = cbase + (dir ? 63 - s0 : s0), t1 = cbase + (dir ? 63 - s1 : s1);
      rkk[2 * i] = *(const u32x4*)(Z + (size_t)t0 * ZW + MK + h * 128 + dgp);
      rkk[2 * i + 1] = *(const u32x4*)(Z + (size_t)t1 * ZW + MK + h * 128 + dgp);
    }
    {
      const int dgv = (tidc & 7) * 8, s0 = 2 * (tidc >> 3), s1 = s0 + 1;
      const int t0 = cbase + (dir ? 63 - s0 : s0), t1 = cbase + (dir ? 63 - s1 : s1);
      rvv[0] = *(const u32x4*)(Z + (size_t)t0 * ZW + MV + h * 128 + 64 * eh + dgv);
      rvv[1] = *(const u32x4*)(Z + (size_t)t1 * ZW + MV + h * 128 + 64 * eh + dgv);
    }
  };
  prefetch(0);
#pragma unroll 1
  for (int c = 0; c < nc; ++c) {
    const int cbase = rowbase + (dir ? (nc - 1 - c) * 64 : c * 64);
    int tidc = tid; asm volatile("" : "+v"(tidc));
    const int lane = tidc & 63, w = tidc >> 6, l31 = lane & 31, hh = lane >> 5, et = w & 1, tt = w >> 1;
    const float ip = ip_n, lf = lf_n;
    const float bcum = wave_scan_sum(lf, lane);
    const float av = ip - bcum;
    const float pm = wave_scan_max(av, lane);
    const float Mv = fmaxf(m_state, pm);
    const float Mlast = shfl_(Mv, 63), blast = shfl_(bcum, 63);
    const float wsv = __expf(av - Mlast);
    const float decay = __expf(m_state - Mlast);
    __syncthreads();
#pragma unroll
    for (int i = 0; i < 4; ++i) {
      int id = tidc + 256 * i, pr = id >> 4, seg = (id & 15) * 8;
      *(u32x4*)(sQ + pr * 136 + seg) = rq[i];
    }
    {
      const int dgp = (tidc & 15) * 8;
#pragma unroll
      for (int i = 0; i < 2; ++i) {
        const int s0 = 2 * ((tidc >> 4) + 16 * i), s1 = s0 + 1;
        const u32x4 k0 = rkk[2 * i], k1 = rkk[2 * i + 1];
        *(u32x4*)(sK + s0 * 136 + dgp) = k0;
        *(u32x4*)(sK + s1 * 136 + dgp) = k1;
        const float w0 = shfl_(wsv, s0), w1 = shfl_(wsv, s1);
#pragma unroll
        for (int e = 0; e < 4; ++e) {
          const int sw = 2 * ((s0 >> 1) ^ (4 * ((tidc & 15) & 7)));
          *(unsigned*)(sKw + (dgp + 2 * e) * 72 + sw) = pk2(bflo(k0[e]) * w0, bflo(k1[e]) * w1);
          *(unsigned*)(sKw + (dgp + 2 * e + 1) * 72 + sw) = pk2(bfhi(k0[e]) * w0, bfhi(k1[e]) * w1);
        }
      }
      const int dgv = (tidc & 7) * 8, sv0 = 2 * (tidc >> 3);
#pragma unroll
      for (int e = 0; e < 4; ++e) {
        const int svw = 2 * ((sv0 >> 1) ^ (4 * (tidc & 7)));
        *(unsigned*)(sVt + (dgv + 2 * e) * 72 + svw) = (rvv[0][e] & 0xffffu) | (rvv[1][e] << 16);
        *(unsigned*)(sVt + (dgv + 2 * e + 1) * 72 + svw) = (rvv[0][e] >> 16) | (rvv[1][e] & 0xffff0000u);
      }
    }
    if (w == 0) sA[lane] = av;
    __syncthreads();
    if (c + 1 < nc) prefetch(c + 1);
    __builtin_amdgcn_sched_barrier(0);
    const int t = 32 * tt + l31;
    const int tok = cbase + (dir ? 63 - t : t);
    const bool finisher = c >= half;
    u32x2 og[4];
    if (finisher) {
#pragma unroll
      for (int g = 0; g < 4; ++g) og[g] = *(const u32x2*)(Z + (size_t)tok * ZW + MO + h * 128 + 64 * eh + 32 * et + 8 * g + 4 * hh);
    }
    float inv;
    f32x16 acc;
    {
      const float Mt = shfl_(Mv, t), bt = shfl_(bcum, t);
      const float winter = __expf(m_state - Mt);
#pragma unroll
      for (int r = 0; r < 16; ++r) acc[r] = 0.f;
#pragma unroll
      for (int dt = 0; dt < 4; ++dt)
#pragma unroll
        for (int s2 = 0; s2 < 2; ++s2) {
          u32x4 ca = {pk2(C[dt][8 * s2 + 0], C[dt][8 * s2 + 1]), pk2(C[dt][8 * s2 + 2], C[dt][8 * s2 + 3]),
                      pk2(C[dt][8 * s2 + 4], C[dt][8 * s2 + 5]), pk2(C[dt][8 * s2 + 6], C[dt][8 * s2 + 7])};
          const bf16_t* qp = sQ + t * 136 + 32 * dt + 16 * s2 + 4 * hh;
          u32x2 lo = *(const u32x2*)qp, hi = *(const u32x2*)(qp + 8);
          acc = MFMA(as_bf8(ca), as_bf8(u32x4{lo[0], lo[1], hi[0], hi[1]}), acc);
        }
#pragma unroll
      for (int r = 0; r < 16; ++r) acc[r] *= winter;
      float qv = 0.f;
#pragma unroll
      for (int j = 0; j < 8; ++j) {
        u32x4 q8 = *(const u32x4*)(sQ + t * 136 + 64 * hh + 8 * j);
        f32x4 n0 = *(const f32x4*)(sN + 64 * hh + 8 * j), n1 = *(const f32x4*)(sN + 64 * hh + 8 * j + 4);
        qv += bflo(q8[0]) * n0[0] + bfhi(q8[0]) * n0[1] + bflo(q8[1]) * n0[2] + bfhi(q8[1]) * n0[3] +
              bflo(q8[2]) * n1[0] + bfhi(q8[2]) * n1[1] + bflo(q8[3]) * n1[2] + bfhi(q8[3]) * n1[3];
      }
      qv += shfl_xor_(qv, 32, lane);
      float rsv = 0.f;
#pragma unroll
      for (int st = 0; st < 2; ++st) {
        f32x16 sm;
#pragma unroll
        for (int r = 0; r < 16; ++r) sm[r] = 0.f;
#pragma unroll
        for (int ks = 0; ks < 8; ++ks) {
          bf16x8 ka = *(const bf16x8*)(sK + (32 * st + l31) * 136 + 16 * ks + 8 * hh);
          bf16x8 qb = *(const bf16x8*)(sQ + t * 136 + 16 * ks + 8 * hh);
          sm = MFMA(ka, qb, sm);
        }
#pragma unroll
        for (int g = 0; g < 4; ++g) {
          f32x4 a4 = *(const f32x4*)(sA + 32 * st + 8 * g + 4 * hh);
#pragma unroll
          for (int e = 0; e < 4; ++e) {
            const int s = 32 * st + 8 * g + 4 * hh + e;
            float wgt = s <= t ? __expf(a4[e] - Mt) : 0.f;
            float v = sm[4 * g + e] * wgt;
            sm[4 * g + e] = v;
            rsv += v;
          }
        }
#pragma unroll
        for (int s2 = 0; s2 < 2; ++s2) {
          const int rgv = (4 * et + (l31 >> 3)) & 7;
          const bf16_t* vrow = sVt + (32 * et + l31) * 72 + 4 * hh;
          u32x2 lo = *(const u32x2*)(vrow + 8 * ((4 * st + 2 * s2) ^ rgv)), hi = *(const u32x2*)(vrow + 8 * ((4 * st + 2 * s2 + 1) ^ rgv));
          u32x4 pb = {pk2(sm[8 * s2 + 0], sm[8 * s2 + 1]), pk2(sm[8 * s2 + 2], sm[8 * s2 + 3]),
                      pk2(sm[8 * s2 + 4], sm[8 * s2 + 5]), pk2(sm[8 * s2 + 6], sm[8 * s2 + 7])};
          acc = MFMA(as_bf8(u32x4{lo[0], lo[1], hi[0], hi[1]}), as_bf8(pb), acc);
        }
      }
      rsv += shfl_xor_(rsv, 32, lane);
      const float den = winter * qv + rsv;
      inv = 1.f / fmaxf(fabsf(den), __expf(-(bt + Mt)));
    }
#pragma unroll
    for (int dt = 0; dt < 4; ++dt) {
#pragma unroll
      for (int r = 0; r < 16; ++r) C[dt][r] *= decay;
#pragma unroll
      for (int ks = 0; ks < 4; ++ks) {
        bf16x8 ka = *(const bf16x8*)(sKw + (32 * dt + l31) * 72 + 8 * ((2 * ks + hh) ^ ((4 * dt + (l31 >> 3)) & 7)));
        bf16x8 vb = *(const bf16x8*)(sVt + (32 * et + l31) * 72 + 8 * ((2 * ks + hh) ^ ((4 * et + (l31 >> 3)) & 7)));
        C[dt] = MFMA(ka, vb, C[dt]);
      }
    }
    {
      unsigned long long* hbp = (unsigned long long*)(HB + (size_t)tok * 512 + h * 128 + 64 * eh + 32 * et + 4 * hh);
      if (!finisher) {
#pragma unroll
        for (int g = 0; g < 4; ++g) {
          const unsigned lo = pk2(acc[4 * g] * inv, acc[4 * g + 1] * inv), hi = pk2(acc[4 * g + 2] * inv, acc[4 * g + 3] * inv);
          __hip_atomic_store(hbp + 2 * g, ((unsigned long long)hi << 32) | lo, RLX_AGENT);
        }
        asm volatile("s_waitcnt vmcnt(0)" ::: "memory");
      } else {
        const int need = nc - c;
        unsigned spins = 0;
        while (__builtin_amdgcn_readfirstlane(__hip_atomic_load(prog_partner, RLX_AGENT)) < need) {
          __builtin_amdgcn_s_sleep(1);
          if (++spins > (1u << 24)) break;
        }
        __builtin_amdgcn_fence(__ATOMIC_ACQUIRE, "agent");
#pragma unroll
        for (int g = 0; g < 4; ++g) {
          const unsigned long long hb = hbp[2 * g];
          const unsigned hlo = (unsigned)hb, hhi = (unsigned)(hb >> 32);
          const float y0 = (acc[4 * g] * inv + bflo(hlo)) * sigmoidf_(bflo(og[g][0]));
          const float y1 = (acc[4 * g + 1] * inv + bfhi(hlo)) * sigmoidf_(bfhi(og[g][0]));
          const float y2 = (acc[4 * g + 2] * inv + bflo(hhi)) * sigmoidf_(bflo(og[g][1]));
          const float y3 = (acc[4 * g + 3] * inv + bfhi(hhi)) * sigmoidf_(bfhi(og[g][1]));
          hbp[2 * g] = ((unsigned long long)pk2(y2, y3) << 32) | pk2(y0, y1);
        }
      }
    }
    __syncthreads();
    if (!finisher && tidc == 0) __hip_atomic_store(prog_self, c + 1, RLX_AGENT);
    if (tidc < 128) {
      float sum = 0.f;
#pragma unroll
      for (int j = 0; j < 8; ++j) {
        u32x4 k8 = *(const u32x4*)(sKw + tidc * 72 + 8 * j);
        sum += bflo(k8[0]) + bfhi(k8[0]) + bflo(k8[1]) + bfhi(k8[1]) + bflo(k8[2]) + bfhi(k8[2]) + bflo(k8[3]) + bfhi(k8[3]);
      }
      sN[tidc] = decay * sN[tidc] + sum;
    }
    m_state = blast + Mlast;
  }
  if (!latent) {
    const int lane = tid & 63, w = tid >> 6, l31 = lane & 31, hh = lane >> 5, et = w & 1, tt = w >> 1;
    const size_t sidx = (size_t)((b * 2 + l) * 2 + dir) * 4 + h;
    float* Co = p.out + OUT_C + sidx * 128 * 128;
    if (tt == 0) {
      int cidx1 = 4 * hh * 128 + 64 * eh + 32 * et + l31; asm volatile("" : "+v"(cidx1));
#pragma unroll
      for (int dt = 0; dt < 4; ++dt) {
#pragma unroll
        for (int r = 0; r < 16; ++r) Co[(unsigned)(cidx1 + (32 * dt + 8 * (r >> 2) + (r & 3)) * 128)] = C[dt][r];
        __builtin_amdgcn_sched_barrier(0);
      }
    }
    __syncthreads();
    if (eh == 0) {
      if (tid < 128) p.out[OUT_N + sidx * 128 + tid] = sN[tid];
      if (tid == 0) p.out[OUT_M + sidx] = m_state;
    }
  }
}

DI void mlstm_norm_phase(const Params& p, int l) {
  const int tid = get_tid(), lane = tid & 63, w = tid >> 6;
  const bf16_t* HB = (const bf16_t*)(p.ws + WS_HB);
  bf16_t* Z = (bf16_t*)(p.ws + WS_Z);
  const float* g = p.ml_g + l * 512 + lane * 8;
  const f32x4 g0 = *(const f32x4*)g, g1 = *(const f32x4*)(g + 4);
  for (int row = blockIdx.x * 4 + w; row < TT; row += gridDim.x * 4) {
    u32x4 y = *(const u32x4*)(HB + (size_t)row * 512 + lane * 8);
    float v[8] = {bflo(y[0]), bfhi(y[0]), bflo(y[1]), bfhi(y[1]), bflo(y[2]), bfhi(y[2]), bflo(y[3]), bfhi(y[3])};
    float ss = 0.f;
#pragma unroll
    for (int e = 0; e < 8; ++e) ss += v[e] * v[e];
#pragma unroll
    for (int o = 8; o >= 1; o >>= 1) ss += shfl_xor_(ss, o, lane);
    const float rstd = rsqrtf(ss * (1.f / 128.f) + 1e-6f);
    *(u32x4*)(Z + (size_t)row * ZW + MQ + lane * 8) =
        u32x4{pk2(v[0] * rstd * g0[0], v[1] * rstd * g0[1]), pk2(v[2] * rstd * g0[2], v[3] * rstd * g0[3]),
              pk2(v[4] * rstd * g1[0], v[5] * rstd * g1[1]), pk2(v[6] * rstd * g1[2], v[7] * rstd * g1[3])};
  }
}

constexpr int MIX_ITEMS = 5248;
DI void phase_mixers(const Params& p, int l, char* smem) {
  __shared__ int s_item;
  const int tid = get_tid();
  int* cnt = (int*)(p.ws + WS_CNT) + l;
  auto draw = [&]() -> int {
    __syncthreads();
    if (tid == 0) s_item = atomicAdd(cnt, 1);
    __syncthreads();
    return __builtin_amdgcn_readfirstlane(s_item);
  };
  int item = draw();
  while (item < 384) {
    const bool lat = item < 128;
    const int j = lat ? item : item - 128;
    int* prog = (int*)(p.ws + WS_CNT) + 16 + l * 384;
    mlstm_item(p, smem, l, j >> 4, (j >> 2) & 3, (j >> 1) & 1, j & 1, lat, prog + item, prog + (item ^ 1));
    item = draw();
  }
#ifndef NO_ATTN
  const int w = __builtin_amdgcn_readfirstlane(get_tid() >> 6);
  bf16_t* Z = (bf16_t*)(p.ws + WS_Z);
  for (; item < MIX_ITEMS; item = draw()) {
    AttnArgs a;
    a.k2 = nullptr; a.v2 = nullptr; a.blk0_2 = 0; a.nblk2 = 0; a.mode = 0; a.m0 = -INFINITY; a.l0 = 0.f; a.rpb = nullptr; a.qpos0 = 0;
    a.nblk1 = 4;
    if (item < 1408) {
      int j = item - 384, qt = j & 63, kv = (j >> 6) & 1, b = j >> 7;
      const float* cb = p.cache_gqa + (size_t)((b * 2 + l) * 2) * 256 * 128 + kv * 64;
      a.k1 = cb; a.v1 = cb + 256 * 128; a.stride1 = 128; a.f32_1 = 1;
      bf16_t* zb = Z + (size_t)(TC + b * 4096) * ZW;
      a.k2 = zb + GK + kv * 64; a.v2 = zb + GV + kv * 64; a.blk0_2 = 0; a.nblk2 = 64;
      a.qo = zb + (size_t)(qt * 64) * ZW + GQ + (kv * 4 + w) * 64;
      attn_item<2>(a, smem);
      continue;
    } else if (item < 2432) {
      int j = item - 1408, qt = j & 63, kv = (j >> 6) & 1, b = j >> 7;
      const float* cb = p.cache_swa + (size_t)((b * 2 + l) * 2) * 256 * 128 + kv * 64;
      a.k1 = cb; a.v1 = cb + 256 * 128; a.stride1 = 128; a.f32_1 = 1;
      bf16_t* zb = Z + (size_t)(TC + b * 4096) * ZW;
      a.k2 = zb + SK + kv * 64; a.v2 = zb + SV + kv * 64;
      const int q0 = qt * 64;
      int lo = q0 - 128; lo = lo < 0 ? 0 : lo;
      int hi = q0 + 63 + 128; hi = hi > 4095 ? 4095 : hi;
      a.blk0_2 = lo >> 6; a.nblk2 = (hi >> 6) - (lo >> 6) + 1;
      a.qo = zb + (size_t)q0 * ZW + SQ + (kv * 4 + w) * 64;
      a.qpos0 = q0; a.mode = 1;
      a.m0 = p.swa_sink[l * 8 + kv * 4 + w] * LOG2E; a.l0 = 1.f;
      attn_item<2>(a, smem);
      continue;
    } else if (item < 4480) {
      int j = item - 2432, rp = j & 31, h = (j >> 5) & 7, b = j >> 8;
      const float* cb = p.cache_na + (size_t)((b * 2 + l) * 2) * 256 * 512 + h * 64;
      a.k1 = cb; a.v1 = cb + 256 * 512; a.stride1 = 512; a.f32_1 = 1;
      bf16_t* zb = Z + (size_t)(TC + b * 4096) * ZW;
      a.k2 = zb + NAK + h * 64; a.v2 = zb + NAV + h * 64;
      int r0 = 2 * rp, r1 = r0 + 1;
      int rs0 = r0 - 4; rs0 = rs0 < 0 ? 0 : (rs0 > 56 ? 56 : rs0);
      int rs1 = r1 - 4; rs1 = rs1 < 0 ? 0 : (rs1 > 56 ? 56 : rs1);
      a.blk0_2 = rs0; a.nblk2 = rs1 + 8 - rs0;
      const int q0 = (r0 + (w >> 1)) * 64 + 32 * (w & 1);
      a.qo = zb + (size_t)q0 * ZW + NAQ + h * 64;
      a.qpos0 = q0; a.mode = 2; a.rpb = p.na_rpb + (size_t)(l * 8 + h) * 465;
    } else if (item < 4736) {
      int j = item - 4480, qtile = j & 1, h = (j >> 1) & 7, b = j >> 4;
      bf16_t* zb = Z + (size_t)(b * 256) * ZW;
      a.k1 = zb + NAK + h * 64; a.v1 = zb + NAV + h * 64; a.stride1 = ZW; a.f32_1 = 0;
      a.qo = zb + (size_t)(qtile * 128 + 32 * w) * ZW + NAQ + h * 64;
    } else if (item < 4992) {
      int j = item - 4736, qt = j & 7, kv = (j >> 3) & 1, b = j >> 4;
      bf16_t* zb = Z + (size_t)(b * 256) * ZW;
      a.k1 = zb + GK + kv * 64; a.v1 = zb + GV + kv * 64; a.stride1 = ZW; a.f32_1 = 0;
      a.qo = zb + (size_t)(qt * 32) * ZW + GQ + (kv * 4 + w) * 64;
    } else {
      int j = item - 4992, qt = j & 7, kv = (j >> 3) & 1, b = j >> 4;
      bf16_t* zb = Z + (size_t)(b * 256) * ZW;
      a.k1 = zb + SK + kv * 64; a.v1 = zb + SV + kv * 64; a.stride1 = ZW; a.f32_1 = 0;
      a.qo = zb + (size_t)(qt * 32) * ZW + SQ + (kv * 4 + w) * 64;
      a.m0 = p.swa_sink[l * 8 + kv * 4 + w] * LOG2E; a.l0 = 1.f;
    }
    attn_item<1>(a, smem);
  }
#endif
}

#define XB_TMO      128
#define XB_XCNT(j)  (256  + 64 * (j))
#define XB_XSUB(j)  (1280 + 64 * (j))
#define XB_XGEN(j)  (2304 + 64 * (j))
#define XB_TOP      3328
#define XB_TOPGEN   3392
#define XCD_BAR_WORDS 3456
#define XB_SPIN_CAP (1u << 18)
#define LAS __attribute__((address_space(3)))
DI unsigned xb_ld(unsigned* p) { return __hip_atomic_load(p, __ATOMIC_RELAXED, __HIP_MEMORY_SCOPE_AGENT); }
DI unsigned xb_add(unsigned* p, unsigned v) { return __hip_atomic_fetch_add(p, v, __ATOMIC_RELAXED, __HIP_MEMORY_SCOPE_AGENT); }
DI unsigned xb_xcc_id() { return (unsigned)__builtin_amdgcn_s_getreg((3 << 11) | 20) & 0xFu; }
#define XB_SPIN(cond, bar) do { unsigned _sp = 0; while (cond) { __builtin_amdgcn_s_sleep(1); \
    if ((++_sp & 255u) == 0u) { if (xb_ld(&(bar)[XB_TMO])) break; if (_sp > XB_SPIN_CAP) { atomicAdd(&(bar)[XB_TMO], 1u); break; } } } } while (0)
struct XcdBarrier { unsigned* bar; unsigned x; volatile LAS unsigned* st; };
DI XcdBarrier xcd_barrier_post(unsigned* bar, volatile LAS unsigned* st) {
  XcdBarrier b; b.bar = bar; b.x = xb_xcc_id(); b.st = st;
  if (threadIdx.x == 0) (void)xb_add(&bar[XB_XCNT(b.x)], 1u);
  return b;
}
DI void xcd_barrier_complete(unsigned* bar, unsigned x, unsigned& nloc, unsigned& nx) {
  const unsigned G = gridDim.x * gridDim.y * gridDim.z;
  unsigned sum, cnt, mine, sp = 0u;
  for (;;) {
    sum = 0u; cnt = 0u; mine = 0u;
#pragma unroll
    for (unsigned j = 0; j < 16; ++j) { const unsigned c = xb_ld(&bar[XB_XCNT(j)]); sum += c; cnt += (c > 0u) ? 1u : 0u; mine = (j == x) ? c : mine; }
    if (sum == G) break;
    __builtin_amdgcn_s_sleep(1);
    if ((++sp & 255u) == 0u) { if (xb_ld(&bar[XB_TMO])) break; if (sp > XB_SPIN_CAP) { atomicAdd(&bar[XB_TMO], 1u); break; } }
  }
  nloc = mine > 0u ? mine : 1u; nx = cnt > 0u ? cnt : 1u;
}
DI void xcd_barrier(const XcdBarrier& b) {
  asm volatile("s_waitcnt vmcnt(0)" ::: "memory");
  __syncthreads();
  if (threadIdx.x == 0) {
    unsigned* bar = b.bar;
    __builtin_amdgcn_s_waitcnt(0);
    unsigned nloc = b.st[0], nx = b.st[1];
    if (nloc == 0u) { xcd_barrier_complete(bar, b.x, nloc, nx); b.st[0] = nloc; b.st[1] = nx; }
    const unsigned old = xb_add(&bar[XB_XSUB(b.x)], 1u);
    const unsigned gen = old / nloc;
    if (old + 1u == (gen + 1u) * nloc) {
      __builtin_amdgcn_fence(__ATOMIC_RELEASE, "agent");
      asm volatile("s_waitcnt vmcnt(0)" ::: "memory");
      const unsigned og = xb_add(&bar[XB_TOP], 1u);
      const unsigned tg = og / nx;
      if (og + 1u == (tg + 1u) * nx) xb_add(&bar[XB_TOPGEN], 1u);
      else XB_SPIN(xb_ld(&bar[XB_TOPGEN]) == tg, bar);
      __builtin_amdgcn_fence(__ATOMIC_ACQUIRE, "agent");
      xb_add(&bar[XB_XGEN(b.x)], 1u);
      asm volatile("s_waitcnt vmcnt(0)" ::: "memory");
    } else {
      XB_SPIN(xb_ld(&bar[XB_XGEN(b.x)]) == gen, bar);
      __builtin_amdgcn_fence(__ATOMIC_ACQUIRE, "agent");
      asm volatile("s_waitcnt vmcnt(0)" ::: "memory");
    }
  }
  __syncthreads();
}

constexpr int N_PHASES = 20;
DI void run_phase(const Params& p, int ph, char* smem) {
  if (ph == 0) { phase0(p, smem); return; }
  if (ph == 19) { norm_phase(p, 0, 2); return; }
  const int l = (ph - 1) / 9, s = (ph - 1) % 9;
  switch (s) {
    case 0: convert_weights(p, l, smem); norm_phase(p, l, 0); break;
    case 1: phase_inproj(p, l, smem); break;
    case 2: phase_mixers(p, l, smem); break;
    case 3: mlstm_norm_phase(p, l); break;
    case 4: phase_merge(p, l, smem); break;
    case 5: phase_resid(p, l, 0, smem); break;
    case 6: norm_phase(p, l, 1); break;
    case 7: phase_ffn1(p, l, smem); break;
    default: phase_resid(p, l, 1, smem); break;
  }
}

#ifndef MK_TEST
template <bool COOP>
__global__ void __launch_bounds__(256, 2) hybrid_fwd(Params p, int ph_lo, int ph_hi) {
  extern __shared__ __attribute__((aligned(16))) char smem[];
  __shared__ uint4 xb_words;
  if (COOP) {
    if (threadIdx.x == 0) xb_words = make_uint4(0u, 0u, 0u, 0u);
    __syncthreads();
    run_phase(p, 0, smem);
    cg::this_grid().sync();
    XcdBarrier xb = xcd_barrier_post((unsigned*)(p.ws + WS_BAR), (volatile LAS unsigned*)&xb_words);
    for (int ph = 1; ph < ph_hi; ++ph) {
      run_phase(p, ph, smem);
#ifdef PROBE_DUP
      if (ph >= 1 && ph <= 18 && ((PROBE_DUP >> ((ph - 1) % 9)) & 1)) run_phase(p, ph, smem);
#endif
      if (ph + 1 < ph_hi) xcd_barrier(xb);
    }
  } else {
    for (int ph = ph_lo; ph < ph_hi; ++ph) run_phase(p, ph, smem);
  }
}

extern "C" void kernel_launch(void* const* d_in, const int* in_sizes, int n_in, void* d_out, int out_size, void* d_ws, size_t ws_size, hipStream_t stream) {
  static int grid = 0;
  if (grid == 0) {
    if (n_in != 26 || ws_size < WS_END) { fprintf(stderr, "kernel_launch: bad n_in %d or ws_size %zu (need %zu)\n", n_in, ws_size, (size_t)WS_END); grid = -1; return; }
    int dev = 0, cus = 0, per_cu = 0;
    hipGetDevice(&dev);
    hipDeviceGetAttribute(&cus, hipDeviceAttributeMultiprocessorCount, dev);
    hipFuncSetAttribute((const void*)hybrid_fwd<true>, hipFuncAttributeMaxDynamicSharedMemorySize, SMEM_BYTES);
    hipFuncSetAttribute((const void*)hybrid_fwd<false>, hipFuncAttributeMaxDynamicSharedMemorySize, SMEM_BYTES);
    hipOccupancyMaxActiveBlocksPerMultiprocessor(&per_cu, (const void*)hybrid_fwd<true>, 256, SMEM_BYTES);
    if (per_cu < 1) per_cu = 1;
    if (per_cu > 2) per_cu = 2;
    grid = cus * per_cu;
  }
  if (grid < 0) return;
  Params p{};
  const float** pp = (const float**)&p;
  for (int i = 0; i < 26; ++i) pp[i] = (const float*)d_in[i];
  p.out = (float*)d_out;
  p.ws = (char*)d_ws;
#if MK_COOP
  int lo = 0, hi = N_PHASES;
  void* args[] = {&p, &lo, &hi};
  hipError_t e = hipLaunchCooperativeKernel((const void*)hybrid_fwd<true>, dim3(grid), dim3(256), args, SMEM_BYTES, stream);
  if (e != hipSuccess) fprintf(stderr, "cooperative launch failed: %s (grid %d)\n", hipGetErrorString(e), grid);
#else
  for (int ph = 0; ph < N_PHASES; ++ph) hybrid_fwd<false><<<grid, 256, SMEM_BYTES, stream>>>(p, ph, ph + 1);
#endif
}
#endif
```

```cpp
#include <hip/hip_runtime.h>
#include <hip/hip_cooperative_groups.h>
#include <stdint.h>
#include <stdio.h>
namespace cg = cooperative_groups;

#ifndef MK_COOP
#define MK_COOP 1
#endif

typedef unsigned short bf16_t;
typedef __attribute__((ext_vector_type(8))) short bf16x8;
typedef __attribute__((ext_vector_type(16))) float f32x16;
typedef __attribute__((ext_vector_type(4))) float f32x4;
typedef __attribute__((ext_vector_type(4))) unsigned u32x4;
typedef __attribute__((ext_vector_type(2))) unsigned u32x2;

#define DI __device__ __forceinline__
#define MFMA(a, b, c) __builtin_amdgcn_mfma_f32_32x32x16_bf16((a), (b), (c), 0, 0, 0)

typedef __attribute__((ext_vector_type(2))) __bf16 bf16x2_t;
typedef __attribute__((ext_vector_type(2))) float f32x2;
DI unsigned pk2(float lo, float hi) { f32x2 v = {lo, hi}; bf16x2_t b = __builtin_convertvector(v, bf16x2_t); return __builtin_bit_cast(unsigned, b); }
DI float bflo(unsigned u) { return __uint_as_float(u << 16); }
DI float bfhi(unsigned u) { return __uint_as_float(u & 0xffff0000u); }
DI bf16x8 as_bf8(u32x4 v) { return __builtin_bit_cast(bf16x8, v); }
DI int get_tid() { int t = (int)__builtin_amdgcn_workitem_id_x(); asm volatile("" : "+v"(t)); return t; }
DI float shfl_(float v, int src) { return __int_as_float(__builtin_amdgcn_ds_bpermute(src << 2, __float_as_int(v))); }
DI float shfl_xor_(float v, int o, int lane) { return shfl_(v, lane ^ o); }
DI float shfl_up_(float v, int o, int lane) { int s = lane - o; return shfl_(v, s < 0 ? lane : s); }
DI float sigmoidf_(float x) { return 1.f / (1.f + __expf(-x)); }

constexpr int TC = 4096;
constexpr int TL = 32768;
constexpr int TT = TC + TL;
constexpr int DM = 1024;
constexpr int NIN = 9232;
constexpr int NZ = 5136;
constexpr int ZW = 5120;
constexpr int DFF = 2816;
constexpr int NAQ = 0, NAK = 512, NAV = 1024, GQ = 1536, GK = 2048, GV = 2176, SQ = 2304, SK = 2816, SV = 2944,
              MQ = 3072, MK = 3584, MV = 4096, MO = 4608;
constexpr int MGC = 512;
constexpr size_t WS_WIN = 0;
constexpr size_t WS_WBR = WS_WIN + (size_t)NIN * DM * 2;
constexpr size_t WS_WOUT = WS_WBR + (size_t)4 * 1024 * 512 * 2;
constexpr size_t WS_WF1 = WS_WOUT + (size_t)1024 * 1024 * 2;
constexpr size_t WS_WF2 = WS_WF1 + (size_t)5632 * 1024 * 2;
constexpr size_t WS_Z = WS_WF2 + (size_t)1024 * DFF * 2;
constexpr size_t WS_H = WS_Z + (size_t)TT * ZW * 2;
constexpr size_t WS_HB = WS_H + (size_t)TT * DM * 2;
constexpr size_t WS_IF = WS_HB + (size_t)TT * 512 * 2;
constexpr size_t WS_MODS = WS_IF + (size_t)TT * 16 * 4;
constexpr size_t WS_ROPE = WS_MODS + (size_t)2 * 9 * 6144 * 4;
constexpr size_t WS_CNT = WS_ROPE + 2 * 1024 * 4;
constexpr size_t WS_BAR = WS_CNT + 4096;
constexpr size_t WS_END = WS_BAR + 16384;
constexpr size_t OUT_YP = 0, OUT_YS = 4194304, OUT_NA = 37748736, OUT_GQA = 46137344, OUT_SWA = 48234496,
                 OUT_C = 50331648, OUT_N = 54525952, OUT_M = 54558720;

constexpr int SMEM_BYTES = 74752;
constexpr float LOG2E = 1.4426950408889634f;

struct Params {
  const float *x_prompt, *x_sample, *cache_na, *cache_gqa, *cache_swa, *st_C, *st_n, *st_m, *c, *c_ctx,
      *w_mod, *b_mod, *norm1_g, *norm2_g, *w_in, *b_in, *na_rpb, *gqa_q_g, *gqa_k_g, *swa_sink, *ml_g,
      *w_branch, *w_out, *w_f1, *w_f2, *final_g;
  float* out;
  char* ws;
};

DI int cond_of_row(int grow) { return grow < TC ? 0 : 1 + ((grow - TC) >> 12); }

DI void phase0(const Params& p, char* smem) {
  const int tid = get_tid();
  if (blockIdx.x == 0) {
    int* cnt = (int*)(p.ws + WS_CNT);
    for (int i = tid; i < 1024 + 4096; i += 256) cnt[i] = 0;
    float* rc = (float*)(p.ws + WS_ROPE);
    for (int idx = tid; idx < 1024; idx += 256) {
      int pos = idx >> 4, j = idx & 15;
      float freq = exp2f(-(float)j * (13.287712379549449f / 16.f));
      float ang = (float)pos * freq;
      float k = rintf(ang * 0.15915494309189535f);
      float r = fmaf(-k, 6.2831854820251465f, ang);
      r = fmaf(k, 1.7484555e-7f, r);
      rc[idx] = __cosf(r);
      rc[1024 + idx] = __sinf(r);
    }
  }
  float* sS = (float*)smem;
  float* sR = (float*)(smem + 36864);
  for (int idx = tid; idx < 9 * 1024; idx += 256) {
    int cv = idx >> 10, k = idx & 1023;
    float v = cv == 0 ? p.c_ctx[k] : p.c[(cv - 1) * 1024 + k];
    sS[idx] = v / (1.f + __expf(-v));
  }
  __syncthreads();
  for (int item = blockIdx.x; item < 192; item += gridDim.x) {
    int l = item / 96, n0 = (item % 96) * 64, n = n0 + (tid & 63), kg = tid >> 6;
    const float* w = p.w_mod + (size_t)l * 1024 * 6144 + n;
    float acc[9];
#pragma unroll
    for (int cv = 0; cv < 9; ++cv) acc[cv] = 0.f;
#pragma unroll 4
    for (int k = kg * 256; k < kg * 256 + 256; ++k) {
      float wv = w[(size_t)k * 6144];
#pragma unroll
      for (int cv = 0; cv < 9; ++cv) acc[cv] = fmaf(sS[cv * 1024 + k], wv, acc[cv]);
    }
#pragma unroll
    for (int cv = 0; cv < 9; ++cv) sR[(kg * 9 + cv) * 64 + (tid & 63)] = acc[cv];
    __syncthreads();
    if (tid < 64) {
      float* mods = (float*)(p.ws + WS_MODS);
      float bm = p.b_mod[l * 6144 + n];
#pragma unroll
      for (int cv = 0; cv < 9; ++cv) {
        float s = sR[(0 * 9 + cv) * 64 + tid] + sR[(1 * 9 + cv) * 64 + tid] + sR[(2 * 9 + cv) * 64 + tid] + sR[(3 * 9 + cv) * 64 + tid];
        mods[(size_t)(l * 9 + cv) * 6144 + n] = s + bm;
      }
    }
    __syncthreads();
  }
}

DI void convert_tile(const float* __restrict__ src, int K, int N, bf16_t* __restrict__ dst, int kt, int nt, int f1perm, char* smem) {
  float* sT = (float*)smem;
  const int tid = get_tid();
  __syncthreads();
  {
    int n4 = (tid & 15) * 4, kr = tid >> 4;
#pragma unroll
    for (int i = 0; i < 4; ++i) {
      int k = kr + 16 * i;
      int n = nt * 64 + n4;
      f32x4 v = {0.f, 0.f, 0.f, 0.f};
      if (n < N) v = *(const f32x4*)(src + (size_t)(kt * 64 + k) * N + n);
      sT[k * 65 + n4 + 0] = v[0]; sT[k * 65 + n4 + 1] = v[1]; sT[k * 65 + n4 + 2] = v[2]; sT[k * 65 + n4 + 3] = v[3];
    }
  }
  __syncthreads();
  {
    int nl = tid >> 2, seg = (tid & 3) * 16;
    int n = nt * 64 + nl;
    if (n < N) {
      int drow = n;
      if (f1perm) { int j = n < DFF ? n : n - DFF; drow = (j >> 6) * 128 + (n < DFF ? 0 : 64) + (j & 63); }
      unsigned o[8];
#pragma unroll
      for (int q = 0; q < 8; ++q) o[q] = pk2(sT[(seg + 2 * q) * 65 + nl], sT[(seg + 2 * q + 1) * 65 + nl]);
      u32x4* d = (u32x4*)(dst + (size_t)drow * K + kt * 64 + seg);
      d[0] = u32x4{o[0], o[1], o[2], o[3]};
      d[1] = u32x4{o[4], o[5], o[6], o[7]};
    }
  }
}

DI void convert_weights(const Params& p, int l, char* smem) {
  for (int item = blockIdx.x; item < 5200; item += gridDim.x) {
    const float* src; bf16_t* dst; int K, N, kt, nt, perm = 0;
    int j = item;
    if (j < 2320) { src = p.w_in + (size_t)l * 1024 * NIN; K = 1024; N = NIN; dst = (bf16_t*)(p.ws + WS_WIN); kt = j / 145; nt = j % 145; }
    else if (j < 2832) { j -= 2320; int i = j >> 7; j &= 127; src = p.w_branch + (size_t)(l * 4 + i) * 512 * 1024; K = 512; N = 1024; dst = (bf16_t*)(p.ws + WS_WBR) + (size_t)i * 1024 * 512; kt = j >> 4; nt = j & 15; }
    else if (j < 3088) { j -= 2832; src = p.w_out + (size_t)l * 1024 * 1024; K = 1024; N = 1024; dst = (bf16_t*)(p.ws + WS_WOUT); kt = j >> 4; nt = j & 15; }
    else if (j < 4496) { j -= 3088; src = p.w_f1 + (size_t)l * 1024 * 5632; K = 1024; N = 5632; dst = (bf16_t*)(p.ws + WS_WF1); kt = j / 88; nt = j % 88; perm = 1; }
    else { j -= 4496; src = p.w_f2 + (size_t)l * DFF * 1024; K = DFF; N = 1024; dst = (bf16_t*)(p.ws + WS_WF2); kt = j >> 4; nt = j & 15; }
    convert_tile(src, K, N, dst, kt, nt, perm, smem);
  }
}

DI void norm_phase(const Params& p, int l, int which) {
  const int tid = get_tid(), lane = tid & 63, w = tid >> 6;
  const float* g = which == 0 ? p.norm1_g + l * 1024 : (which == 1 ? p.norm2_g + l * 1024 : p.final_g);
  const float* mods = (const float*)(p.ws + WS_MODS);
  bf16_t* H = (bf16_t*)(p.ws + WS_H);
  for (int row = blockIdx.x * 4 + w; row < TT; row += gridDim.x * 4) {
    const float* xr;
    if (which == 0 && l == 0) xr = row < TC ? p.x_prompt + (size_t)row * 1024 : p.x_sample + (size_t)(row - TC) * 1024;
    else xr = p.out + (size_t)row * 1024;
    f32x4 v[4];
    float ss = 0.f;
#pragma unroll
    for (int i = 0; i < 4; ++i) {
      v[i] = *(const f32x4*)(xr + 4 * lane + 256 * i);
      ss += v[i][0] * v[i][0] + v[i][1] * v[i][1] + v[i][2] * v[i][2] + v[i][3] * v[i][3];
    }
#pragma unroll
    for (int o = 32; o >= 1; o >>= 1) ss += shfl_xor_(ss, o, lane);
    float rstd = rsqrtf(ss * (1.f / 1024.f) + 1e-6f);
    if (which == 2) {
      float* yo = p.out + (size_t)row * 1024;
#pragma unroll
      for (int i = 0; i < 4; ++i) {
        int k = 4 * lane + 256 * i;
        f32x4 g4 = *(const f32x4*)(g + k);
        f32x4 y;
#pragma unroll
        for (int e = 0; e < 4; ++e) y[e] = v[i][e] * rstd * g4[e];
        *(f32x4*)(yo + k) = y;
      }
    } else {
      const float* mr = mods + (size_t)(l * 9 + cond_of_row(row)) * 6144 + (which == 0 ? 0 : 3072);
#pragma unroll
      for (int i = 0; i < 4; ++i) {
        int k = 4 * lane + 256 * i;
        f32x4 g4 = *(const f32x4*)(g + k);
        f32x4 sh = *(const f32x4*)(mr + k);
        f32x4 sc = *(const f32x4*)(mr + 1024 + k);
        float y[4];
#pragma unroll
        for (int e = 0; e < 4; ++e) y[e] = (v[i][e] * rstd * g4[e]) * (1.f + sc[e]) + sh[e];
        *(u32x2*)(H + (size_t)row * 1024 + k) = u32x2{pk2(y[0], y[1]), pk2(y[2], y[3])};
      }
    }
  }
}

template <bool DB = true>
DI void gemm_core(const bf16_t* __restrict__ A, int lda, const bf16_t* __restrict__ B, int ldb, int K, f32x16 (&acc)[2][2], char* smem) {
  bf16_t* sA = (bf16_t*)smem;
  bf16_t* sB = sA + (DB ? 2 : 1) * 128 * 72;
  const int tid = get_tid(), lane = tid & 63, w = tid >> 6, wm = w >> 1, wn = w & 1, l31 = lane & 31, hh = lane >> 5;
  const int lrow = tid >> 3, lseg = (tid & 7) * 8;
  const char* Ab = (const char*)A;
  const char* Bb = (const char*)B;
  const unsigned offA = (unsigned)(lrow * lda + lseg) * 2u, offB = (unsigned)(lrow * ldb + lseg) * 2u;
  const unsigned stepA = (unsigned)lda * 64u, stepB = (unsigned)ldb * 64u;
  u32x4 ra[4], rb[4];
#pragma unroll
  for (int i = 0; i < 4; ++i) { ra[i] = *(const u32x4*)(Ab + (offA + i * stepA)); rb[i] = *(const u32x4*)(Bb + (offB + i * stepB)); }
  __syncthreads();
#pragma unroll
  for (int i = 0; i < 4; ++i) { *(u32x4*)(sA + (lrow + 32 * i) * 72 + lseg) = ra[i]; *(u32x4*)(sB + (lrow + 32 * i) * 72 + lseg) = rb[i]; }
  __syncthreads();
  const int nk = K >> 6;
  for (int kt = 0; kt < nk; ++kt) {
    const int buf = DB ? (kt & 1) : 0;
    if (kt + 1 < nk) {
#pragma unroll
      for (int i = 0; i < 4; ++i) { ra[i] = *(const u32x4*)(Ab + (offA + i * stepA + (unsigned)(kt + 1) * 128u)); rb[i] = *(const u32x4*)(Bb + (offB + i * stepB + (unsigned)(kt + 1) * 128u)); }
    }
    __builtin_amdgcn_sched_barrier(0);
    const bf16_t* pa = sA + (buf * 128 + 64 * wm + l31) * 72 + 8 * hh;
    const bf16_t* pb = sB + (buf * 128 + 64 * wn + l31) * 72 + 8 * hh;
    bf16x8 a0 = *(const bf16x8*)(pa), a1 = *(const bf16x8*)(pa + 32 * 72);
    bf16x8 b0 = *(const bf16x8*)(pb), b1 = *(const bf16x8*)(pb + 32 * 72);
#pragma unroll
    for (int ks = 0; ks < 4; ++ks) {
      bf16x8 na0 = a0, na1 = a1, nb0 = b0, nb1 = b1;
      if (ks < 3) {
        na0 = *(const bf16x8*)(pa + (ks + 1) * 16); na1 = *(const bf16x8*)(pa + 32 * 72 + (ks + 1) * 16);
        nb0 = *(const bf16x8*)(pb + (ks + 1) * 16); nb1 = *(const bf16x8*)(pb + 32 * 72 + (ks + 1) * 16);
      }
      __builtin_amdgcn_sched_barrier(0);
      acc[0][0] = MFMA(a0, b0, acc[0][0]);
      acc[0][1] = MFMA(a0, b1, acc[0][1]);
      acc[1][0] = MFMA(a1, b0, acc[1][0]);
      acc[1][1] = MFMA(a1, b1, acc[1][1]);
      __builtin_amdgcn_sched_barrier(0);
      a0 = na0; a1 = na1; b0 = nb0; b1 = nb1;
    }
    if (kt + 1 < nk) {
      const int nb = DB ? (buf ^ 1) : 0;
      if (!DB) __syncthreads();
#pragma unroll
      for (int i = 0; i < 4; ++i) { *(u32x4*)(sA + (nb * 128 + lrow + 32 * i) * 72 + lseg) = ra[i]; *(u32x4*)(sB + (nb * 128 + lrow + 32 * i) * 72 + lseg) = rb[i]; }
    }
    __syncthreads();
  }
}

DI void zero_acc(f32x16 (&acc)[2][2]) {
#pragma unroll
  for (int i = 0; i < 2; ++i)
#pragma unroll
    for (int j = 0; j < 2; ++j)
#pragma unroll
      for (int r = 0; r < 16; ++r) acc[i][j][r] = 0.f;
}

DI void acc_to_lds(const f32x16 (&acc)[2][2], float* sC) {
  const int tid = get_tid(), lane = tid & 63, w = tid >> 6, wm = w >> 1, wn = w & 1, l31 = lane & 31, hh = lane >> 5;
#pragma unroll
  for (int i = 0; i < 2; ++i)
#pragma unroll
    for (int j = 0; j < 2; ++j)
#pragma unroll
      for (int r = 0; r < 16; ++r) {
        int row = 64 * wm + 32 * i + 8 * (r >> 2) + 4 * hh + (r & 3), col = 64 * wn + 32 * j + l31;
        sC[row * 132 + col] = acc[i][j][r];
      }
  __syncthreads();
}

struct TileIter {
  int local, step, total, nN, xcd; bool swz;
  DI void init(int nN_) {
    nN = nN_;
    swz = (gridDim.x & 7) == 0;
    if (swz) { xcd = blockIdx.x & 7; local = blockIdx.x >> 3; step = gridDim.x >> 3; total = 36 * nN; }
    else { xcd = 0; local = blockIdx.x; step = gridDim.x; total = 288 * nN; }
  }
  DI bool next(int& mt, int& nt) {
    if (local >= total) return false;
    if (swz) {
      const int per_sr = 8 * nN;
      const int sr = local / per_sr, r = local - sr * per_sr;
      const int rows = (36 - 8 * sr) < 8 ? (36 - 8 * sr) : 8;
      nt = r / rows; mt = 36 * xcd + 8 * sr + (r - nt * rows);
    } else { mt = local / nN; nt = local - mt * nN; }
    local += step;
    return true;
  }
};

DI void epi_inproj(const Params& p, int l, int mt, int nt, const float* sC) {
  const int tid = get_tid();
  const int chunk = tid & 15, lane = tid & 63;
  const int half = chunk >> 3, d0 = (chunk & 7) * 8;
  const int c0 = nt * 128 + half * 64;
  if (c0 >= NZ && c0 != 5120) return;
  bf16_t* Z = (bf16_t*)(p.ws + WS_Z);
  const float* bias = p.b_in + (size_t)l * NIN + c0;
  if (c0 == 5120) {
    if (chunk >= 2) return;
    const f32x4 b0 = *(const f32x4*)(bias + d0), b1 = *(const f32x4*)(bias + d0 + 4);
#pragma unroll
    for (int it = 0; it < 8; ++it) {
      const int rt = (tid >> 4) + 16 * it, grow = mt * 128 + rt;
      const float* crow = sC + rt * 132 + d0;
      f32x4 v0 = *(const f32x4*)crow + b0, v1 = *(const f32x4*)(crow + 4) + b1;
      if (chunk == 1) {
#pragma unroll
        for (int e = 0; e < 4; ++e) {
          v0[e] = fminf(v0[e], 0.f) - log1pf(__expf(-fabsf(v0[e])));
          v1[e] = fminf(v1[e], 0.f) - log1pf(__expf(-fabsf(v1[e])));
        }
      }
      float* IF = (float*)(p.ws + WS_IF) + (size_t)grow * 16 + d0;
      *(f32x4*)IF = v0; *(f32x4*)(IF + 4) = v1;
    }
    return;
  }
  bool hn = false, rope = false;
  const float* hg = nullptr;
  float scale = 1.f;
  int kvsel = -1, kvh = 0, kvH = 0; size_t kvbase = 0;
  if (c0 < NAK) {}
  else if (c0 < NAV) { kvbase = OUT_NA; kvsel = 0; kvh = (c0 - NAK) >> 6; kvH = 8; }
  else if (c0 < GQ) { kvbase = OUT_NA; kvsel = 1; kvh = (c0 - NAV) >> 6; kvH = 8; }
  else if (c0 < GK) { hn = true; hg = p.gqa_q_g + l * 64; rope = true; }
  else if (c0 < GV) { hn = true; hg = p.gqa_k_g + l * 64; rope = true; kvbase = OUT_GQA; kvsel = 0; kvh = (c0 - GK) >> 6; kvH = 2; }
  else if (c0 < SQ) { kvbase = OUT_GQA; kvsel = 1; kvh = (c0 - GV) >> 6; kvH = 2; }
  else if (c0 < SK) { rope = true; }
  else if (c0 < SV) { rope = true; kvbase = OUT_SWA; kvsel = 0; kvh = (c0 - SK) >> 6; kvH = 2; }
  else if (c0 < MQ) { kvbase = OUT_SWA; kvsel = 1; kvh = (c0 - SV) >> 6; kvH = 2; }
  else if (c0 >= MK && c0 < MV) { scale = 0.08838834764831845f; }
  if (c0 < NAK || (c0 >= GQ && c0 < GK) || (c0 >= SQ && c0 < SK)) scale = 0.125f * LOG2E;
  const bool latent_tile = mt >= 32;
  if (latent_tile) kvsel = -1; else rope = false;
  const int dp = d0 ^ 16;
  const bool second = (d0 & 16) != 0;
  const f32x4 b0 = *(const f32x4*)(bias + d0), b1 = *(const f32x4*)(bias + d0 + 4);
  f32x4 pb0 = b0, pb1 = b1, g0 = {1.f, 1.f, 1.f, 1.f}, g1 = g0, pg0 = g0, pg1 = g0;
  if (rope) { pb0 = *(const f32x4*)(bias + dp); pb1 = *(const f32x4*)(bias + dp + 4); }
  if (hn) {
    g0 = *(const f32x4*)(hg + d0); g1 = *(const f32x4*)(hg + d0 + 4);
    pg0 = *(const f32x4*)(hg + dp); pg1 = *(const f32x4*)(hg + dp + 4);
  }
  const float* rcos = (const float*)(p.ws + WS_ROPE);
  const float* rsin = rcos + 1024;
#pragma unroll 4
  for (int it = 0; it < 8; ++it) {
    const int rt = (tid >> 4) + 16 * it, grow = mt * 128 + rt;
    const float* crow = sC + rt * 132 + half * 64;
    f32x4 x0 = *(const f32x4*)(crow + d0) + b0, x1 = *(const f32x4*)(crow + d0 + 4) + b1;
    float rs = 1.f;
    if (hn) {
      float ss = x0[0] * x0[0] + x0[1] * x0[1] + x0[2] * x0[2] + x0[3] * x0[3] + x1[0] * x1[0] + x1[1] * x1[1] + x1[2] * x1[2] + x1[3] * x1[3];
      ss += shfl_xor_(ss, 1, lane); ss += shfl_xor_(ss, 2, lane); ss += shfl_xor_(ss, 4, lane);
      rs = rsqrtf(ss * (1.f / 64.f) + 1e-6f);
    }
    const float sc = rs * scale;
    x0 = x0 * sc * g0; x1 = x1 * sc * g1;
    if (rope) {
      f32x4 y0 = (*(const f32x4*)(crow + dp) + pb0) * sc * pg0, y1 = (*(const f32x4*)(crow + dp + 4) + pb1) * sc * pg1;
      const int t = (grow - TC) & 4095;
      const int pos = (d0 & 32) ? (t & 63) : (t >> 6);
      const int fj = d0 & 15;
      const f32x4 c0v = *(const f32x4*)(rcos + pos * 16 + fj), c1v = *(const f32x4*)(rcos + pos * 16 + fj + 4);
      const f32x4 s0v = *(const f32x4*)(rsin + pos * 16 + fj), s1v = *(const f32x4*)(rsin + pos * 16 + fj + 4);
      if (second) { x0 = x0 * c0v + y0 * s0v; x1 = x1 * c1v + y1 * s1v; }
      else { x0 = x0 * c0v - y0 * s0v; x1 = x1 * c1v - y1 * s1v; }
    }
    __builtin_nontemporal_store(u32x4{pk2(x0[0], x0[1]), pk2(x0[2], x0[3]), pk2(x1[0], x1[1]), pk2(x1[2], x1[3])}, (u32x4*)(Z + (size_t)grow * ZW + c0 + d0));
    if (kvsel >= 0) {
      const int cb = grow >> 8, cs = grow & 255;
      float* kv = p.out + kvbase + ((((size_t)(cb * 2 + l) * 2 + kvsel) * 256 + cs) * kvH + kvh) * 64 + d0;
      *(f32x4*)kv = x0; *(f32x4*)(kv + 4) = x1;
    }
  }
}

DI void phase_inproj(const Params& p, int l, char* smem) {
  const bf16_t* H = (const bf16_t*)(p.ws + WS_H);
  const bf16_t* W = (const bf16_t*)(p.ws + WS_WIN);
  TileIter ti; ti.init(41);
  for (int mt, nt; ti.next(mt, nt);) {
    f32x16 acc[2][2];
    zero_acc(acc);
    gemm_core(H + (size_t)mt * 128 * DM, DM, W + (size_t)nt * 128 * DM, DM, DM, acc, smem);
    acc_to_lds(acc, (float*)smem);
    epi_inproj(p, l, mt, nt, (const float*)smem);
  }
}

DI void phase_merge(const Params& p, int l, char* smem) {
  const int tid = get_tid(), lane = tid & 63, w = tid >> 6, wn = w & 1, l31 = lane & 31;
  const bf16_t* H = (const bf16_t*)(p.ws + WS_H);
  const bf16_t* W = (const bf16_t*)(p.ws + WS_WIN);
  const bf16_t* WB = (const bf16_t*)(p.ws + WS_WBR);
  bf16_t* Z = (bf16_t*)(p.ws + WS_Z);
  TileIter ti; ti.init(8);
  for (int mt, nt; ti.next(mt, nt);) {
    f32x16 mg[2][2];
    zero_acc(mg);
#pragma unroll 1
    for (int i = 0; i < 4; ++i) {
      f32x16 acc[2][2];
      zero_acc(acc);
      gemm_core<false>(H + (size_t)mt * 128 * DM, DM, W + (size_t)(NZ + i * 1024 + nt * 128) * DM, DM, DM, acc, smem);
      unsigned* sG = (unsigned*)(smem + 36864) + tid;
#pragma unroll
      for (int j = 0; j < 2; ++j) {
        float bj = p.b_in[(size_t)l * NIN + NZ + i * 1024 + nt * 128 + 64 * wn + 32 * j + l31];
#pragma unroll
        for (int ii = 0; ii < 2; ++ii)
#pragma unroll
          for (int r = 0; r < 8; ++r) sG[((ii * 2 + j) * 8 + r) * 256] = pk2(sigmoidf_(acc[ii][j][2 * r] + bj), sigmoidf_(acc[ii][j][2 * r + 1] + bj));
      }
      zero_acc(acc);
      const int colA = i == 0 ? NAQ : (i == 1 ? GQ : (i == 2 ? SQ : MQ));
      gemm_core<false>(Z + (size_t)mt * 128 * ZW + colA, ZW, WB + (size_t)(i * 1024 + nt * 128) * 512, 512, 512, acc, smem);
#pragma unroll
      for (int ii = 0; ii < 2; ++ii)
#pragma unroll
        for (int j = 0; j < 2; ++j)
#pragma unroll
          for (int r = 0; r < 8; ++r) {
            const unsigned gpv = sG[((ii * 2 + j) * 8 + r) * 256];
            mg[ii][j][2 * r] += bflo(gpv) * acc[ii][j][2 * r];
            mg[ii][j][2 * r + 1] += bfhi(gpv) * acc[ii][j][2 * r + 1];
          }
    }
    float* sC = (float*)smem;
    __syncthreads();
    acc_to_lds(mg, sC);
#pragma unroll
    for (int it = 0; it < 8; ++it) {
      const int rt = (tid >> 4) + 16 * it, ch = (tid & 15) * 8;
      const float* crow = sC + rt * 132 + ch;
      f32x4 a = *(const f32x4*)crow, b = *(const f32x4*)(crow + 4);
      __builtin_nontemporal_store(u32x4{pk2(a[0], a[1]), pk2(a[2], a[3]), pk2(b[0], b[1]), pk2(b[2], b[3])}, (u32x4*)(Z + (size_t)(mt * 128 + rt) * ZW + MGC + nt * 128 + ch));
    }
  }
}

DI void phase_resid(const Params& p, int l, int which, char* smem) {
  const int tid = get_tid();
  const bf16_t* Z = (const bf16_t*)(p.ws + WS_Z);
  const bf16_t* W = (const bf16_t*)(p.ws + (which == 0 ? WS_WOUT : WS_WF2));
  const int K = which == 0 ? 1024 : DFF;
  const int acol = which == 0 ? MGC : 0;
  const int goff = which == 0 ? 2048 : 5120;
  const float* mods = (const float*)(p.ws + WS_MODS);
  TileIter ti; ti.init(8);
  for (int mt, nt; ti.next(mt, nt);) {
    f32x16 acc[2][2];
    zero_acc(acc);
    gemm_core(Z + (size_t)mt * 128 * ZW + acol, ZW, W + (size_t)nt * 128 * K, K, K, acc, smem);
    float* sC = (float*)smem;
    acc_to_lds(acc, sC);
    const int n = nt * 128 + (tid & 31) * 4;
    const f32x4 g4 = *(const f32x4*)(mods + (size_t)(l * 9 + cond_of_row(mt * 128)) * 6144 + goff + n);
    const float* xbase = (which == 0 && l == 0) ? (mt < 32 ? p.x_prompt + (size_t)mt * 128 * 1024 : p.x_sample + (size_t)(mt * 128 - TC) * 1024)
                                                : p.out + (size_t)mt * 128 * 1024;
#pragma unroll 4
    for (int it = 0; it < 16; ++it) {
      const int rt = (tid >> 5) + 8 * it, grow = mt * 128 + rt;
      const f32x4 x4 = *(const f32x4*)(xbase + (size_t)rt * 1024 + n);
      const f32x4 c4 = *(const f32x4*)(sC + rt * 132 + (tid & 31) * 4);
      __builtin_nontemporal_store(x4 + g4 * c4, (f32x4*)(p.out + (size_t)grow * 1024 + n));
    }
  }
}

DI void phase_ffn1(const Params& p, int l, char* smem) {
  const int tid = get_tid();
  const bf16_t* H = (const bf16_t*)(p.ws + WS_H);
  const bf16_t* W = (const bf16_t*)(p.ws + WS_WF1);
  bf16_t* Z = (bf16_t*)(p.ws + WS_Z);
  TileIter ti; ti.init(44);
  for (int mt, nt; ti.next(mt, nt);) {
    f32x16 acc[2][2];
    zero_acc(acc);
    gemm_core(H + (size_t)mt * 128 * DM, DM, W + (size_t)nt * 128 * DM, DM, DM, acc, smem);
    float* sC = (float*)smem;
    acc_to_lds(acc, sC);
#pragma unroll
    for (int it = 0; it < 4; ++it) {
      const int rt = (tid >> 3) + 32 * it, ch = (tid & 7) * 8;
      const float* crow = sC + rt * 132 + ch;
      float o[8];
#pragma unroll
      for (int hq = 0; hq < 2; ++hq) {
        f32x4 gt = *(const f32x4*)(crow + 4 * hq), up = *(const f32x4*)(crow + 64 + 4 * hq);
#pragma unroll
        for (int e = 0; e < 4; ++e) o[4 * hq + e] = gt[e] / (1.f + __expf(-gt[e])) * up[e];
      }
      __builtin_nontemporal_store(u32x4{pk2(o[0], o[1]), pk2(o[2], o[3]), pk2(o[4], o[5]), pk2(o[6], o[7])}, (u32x4*)(Z + (size_t)(mt * 128 + rt) * ZW + nt * 64 + ch));
    }
  }
}

struct AttnArgs {
  const void* k1; const void* v1; int stride1; int f32_1; int nblk1;
  const bf16_t* k2; const bf16_t* v2; int blk0_2; int nblk2;
  bf16_t* qo;
  int qpos0;
  int mode;
  float m0, l0;
  const float* rpb;
};

template <int QT>
DI void attn_item(const AttnArgs& a, char* smem) {
  bf16_t* sK = (bf16_t*)smem;
  bf16_t* sVt = sK + 2 * 64 * 72;
  float* sRpb = (float*)(smem + 4 * 64 * 72 * 2);
  const int tid = get_tid(), lane = tid & 63, l31 = lane & 31, hh = lane >> 5;
  const int dg = tid & 7, kp = tid >> 3;
  __syncthreads();
  if (a.mode == 2) for (int i = tid; i < 465; i += 256) sRpb[i] = a.rpb[i] * LOG2E;
  bf16x8 qf[QT][4];
#pragma unroll
  for (int qt = 0; qt < QT; ++qt)
#pragma unroll
    for (int st = 0; st < 4; ++st) qf[qt][st] = *(const bf16x8*)(a.qo + (size_t)(32 * qt + l31) * ZW + 16 * st + 8 * hh);
  f32x16 o[QT][2];
  float m_run[QT], l_run[QT];
#pragma unroll
  for (int qt = 0; qt < QT; ++qt) {
    m_run[qt] = a.m0; l_run[qt] = a.l0;
#pragma unroll
    for (int dt = 0; dt < 2; ++dt)
#pragma unroll
      for (int r = 0; r < 16; ++r) o[qt][dt][r] = 0.f;
  }
  const int nblk = a.nblk1 + a.nblk2;
  u32x4 rk[2], rv[2];
  auto load_blk = [&](int b) {
    if (b < a.nblk1) {
      if (a.f32_1) {
        const float* kb = (const float*)a.k1 + (size_t)(b * 64 + 2 * kp) * a.stride1 + 8 * dg;
        const float* vb = (const float*)a.v1 + (size_t)(b * 64 + 2 * kp) * a.stride1 + 8 * dg;
#pragma unroll
        for (int i = 0; i < 2; ++i) {
          f32x4 k0 = *(const f32x4*)(kb + (size_t)i * a.stride1), k1 = *(const f32x4*)(kb + (size_t)i * a.stride1 + 4);
          f32x4 v0 = *(const f32x4*)(vb + (size_t)i * a.stride1), v1 = *(const f32x4*)(vb + (size_t)i * a.stride1 + 4);
          rk[i] = u32x4{pk2(k0[0], k0[1]), pk2(k0[2], k0[3]), pk2(k1[0], k1[1]), pk2(k1[2], k1[3])};
          rv[i] = u32x4{pk2(v0[0], v0[1]), pk2(v0[2], v0[3]), pk2(v1[0], v1[1]), pk2(v1[2], v1[3])};
        }
      } else {
        const bf16_t* kb = (const bf16_t*)a.k1 + (size_t)(b * 64 + 2 * kp) * a.stride1 + 8 * dg;
        const bf16_t* vb = (const bf16_t*)a.v1 + (size_t)(b * 64 + 2 * kp) * a.stride1 + 8 * dg;
#pragma unroll
        for (int i = 0; i < 2; ++i) { rk[i] = *(const u32x4*)(kb + (size_t)i * a.stride1); rv[i] = *(const u32x4*)(vb + (size_t)i * a.stride1); }
      }
    } else {
      const int kb0 = (a.blk0_2 + (b - a.nblk1)) * 64 + 2 * kp;
      const bf16_t* kb = a.k2 + (size_t)kb0 * ZW + 8 * dg;
      const bf16_t* vb = a.v2 + (size_t)kb0 * ZW + 8 * dg;
#pragma unroll
      for (int i = 0; i < 2; ++i) { rk[i] = *(const u32x4*)(kb + (size_t)i * ZW); rv[i] = *(const u32x4*)(vb + (size_t)i * ZW); }
    }
  };
  auto store_blk = [&](int buf) {
    bf16_t* k = sK + buf * 64 * 72; bf16_t* v = sVt + buf * 64 * 72;
    *(u32x4*)(k + (2 * kp) * 72 + 8 * dg) = rk[0];
    *(u32x4*)(k + (2 * kp + 1) * 72 + 8 * dg) = rk[1];
#pragma unroll
    for (int e = 0; e < 4; ++e) {
      unsigned a0 = rv[0][e], a1 = rv[1][e];
      *(unsigned*)(v + (8 * dg + 2 * e) * 72 + 2 * (kp ^ (4 * dg))) = (a0 & 0xffffu) | (a1 << 16);
      *(unsigned*)(v + (8 * dg + 2 * e + 1) * 72 + 2 * (kp ^ (4 * dg))) = (a0 >> 16) | (a1 & 0xffff0000u);
    }
  };
  load_blk(0);
  store_blk(0);
  if (nblk > 1) load_blk(1);
  __syncthreads();
  for (int b = 0; b < nblk; ++b) {
    const bf16_t* cK = sK + (b & 1) * 64 * 72;
    const bf16_t* cV = sVt + (b & 1) * 64 * 72;
    f32x16 s[QT][2];
#pragma unroll
    for (int qt = 0; qt < QT; ++qt)
#pragma unroll
      for (int kt = 0; kt < 2; ++kt)
#pragma unroll
        for (int r = 0; r < 16; ++r) s[qt][kt][r] = 0.f;
#pragma unroll
    for (int st = 0; st < 4; ++st) {
      bf16x8 k0 = *(const bf16x8*)(cK + l31 * 72 + 16 * st + 8 * hh);
      bf16x8 k1 = *(const bf16x8*)(cK + (32 + l31) * 72 + 16 * st + 8 * hh);
#pragma unroll
      for (int qt = 0; qt < QT; ++qt) {
        s[qt][0] = MFMA(k0, qf[qt][st], s[qt][0]);
        s[qt][1] = MFMA(k1, qf[qt][st], s[qt][1]);
      }
    }
    const bool seg2 = b >= a.nblk1;
#pragma unroll
    for (int qt = 0; qt < QT; ++qt) {
      if (seg2 && a.mode == 1) {
        const int kbase = (a.blk0_2 + (b - a.nblk1)) * 64;
        const int qpos = a.qpos0 + 32 * qt + l31;
#pragma unroll
        for (int kt = 0; kt < 2; ++kt)
#pragma unroll
          for (int r = 0; r < 16; ++r) {
            int kpos = kbase + 32 * kt + 8 * (r >> 2) + 4 * hh + (r & 3);
            int dd = qpos - kpos; dd = dd < 0 ? -dd : dd;
            s[qt][kt][r] = dd <= 128 ? s[qt][kt][r] : -INFINITY;
          }
      } else if (seg2 && a.mode == 2) {
        const int kr = a.blk0_2 + (b - a.nblk1);
        const int qpos = a.qpos0 + 32 * qt + l31;
        const int qr = qpos >> 6, qc = qpos & 63;
        int rs = qr - 4; rs = rs < 0 ? 0 : (rs > 56 ? 56 : rs);
        int cs = qc - 8; cs = cs < 0 ? 0 : (cs > 48 ? 48 : cs);
        const bool rowok = kr >= rs && kr <= rs + 7;
        const int bbase = (kr - qr + 7) * 31 - qc + 15;
#pragma unroll
        for (int kt = 0; kt < 2; ++kt)
#pragma unroll
          for (int r = 0; r < 16; ++r) {
            int kc = 32 * kt + 8 * (r >> 2) + 4 * hh + (r & 3);
            bool ok = rowok && (unsigned)(kc - cs) < 16u;
            const float bias = sRpb[ok ? bbase + kc : 0];
            s[qt][kt][r] = ok ? s[qt][kt][r] + bias : -INFINITY;
          }
      }
      float mx = -INFINITY;
#pragma unroll
      for (int kt = 0; kt < 2; ++kt)
#pragma unroll
        for (int r = 0; r < 16; ++r) mx = fmaxf(mx, s[qt][kt][r]);
      mx = fmaxf(mx, shfl_xor_(mx, 32, lane));
      const float m_new = fmaxf(m_run[qt], mx);
      if (__builtin_amdgcn_ballot_w64(m_new > m_run[qt]) != 0ull) {
        const float alpha = __builtin_amdgcn_exp2f(m_run[qt] - m_new);
        l_run[qt] *= alpha;
#pragma unroll
        for (int dt = 0; dt < 2; ++dt)
#pragma unroll
          for (int r = 0; r < 16; ++r) o[qt][dt][r] *= alpha;
        m_run[qt] = m_new;
      }
      float ps = 0.f;
#pragma unroll
      for (int kt = 0; kt < 2; ++kt)
#pragma unroll
        for (int r = 0; r < 16; ++r) { float e = __builtin_amdgcn_exp2f(s[qt][kt][r] - m_run[qt]); s[qt][kt][r] = e; ps += e; }
      ps += shfl_xor_(ps, 32, lane);
      l_run[qt] += ps;
    }
#pragma unroll
    for (int kt = 0; kt < 2; ++kt)
#pragma unroll
      for (int s2 = 0; s2 < 2; ++s2) {
        u32x4 pb[QT];
#pragma unroll
        for (int qt = 0; qt < QT; ++qt)
          pb[qt] = u32x4{pk2(s[qt][kt][8 * s2 + 0], s[qt][kt][8 * s2 + 1]), pk2(s[qt][kt][8 * s2 + 2], s[qt][kt][8 * s2 + 3]),
                         pk2(s[qt][kt][8 * s2 + 4], s[qt][kt][8 * s2 + 5]), pk2(s[qt][kt][8 * s2 + 6], s[qt][kt][8 * s2 + 7])};
#pragma unroll
        for (int dt = 0; dt < 2; ++dt) {
          const int rg = (4 * dt + (l31 >> 3)) & 7;
          const bf16_t* vrow = cV + (32 * dt + l31) * 72 + 4 * hh;
          u32x2 lo = *(const u32x2*)(vrow + 8 * ((4 * kt + 2 * s2) ^ rg)), hi = *(const u32x2*)(vrow + 8 * ((4 * kt + 2 * s2 + 1) ^ rg));
          const bf16x8 vfr = as_bf8(u32x4{lo[0], lo[1], hi[0], hi[1]});
#pragma unroll
          for (int qt = 0; qt < QT; ++qt) o[qt][dt] = MFMA(vfr, as_bf8(pb[qt]), o[qt][dt]);
        }
      }
    if (b + 1 < nblk) store_blk((b + 1) & 1);
    if (b + 2 < nblk) load_blk(b + 2);
    __builtin_amdgcn_sched_barrier(0);
    __syncthreads();
  }
#pragma unroll
  for (int qt = 0; qt < QT; ++qt) {
    const float inv = 1.f / l_run[qt];
#pragma unroll
    for (int dt = 0; dt < 2; ++dt)
#pragma unroll
      for (int g = 0; g < 4; ++g) {
        *(u32x2*)(a.qo + (size_t)(32 * qt + l31) * ZW + 32 * dt + 8 * g + 4 * hh) =
            u32x2{pk2(o[qt][dt][4 * g] * inv, o[qt][dt][4 * g + 1] * inv), pk2(o[qt][dt][4 * g + 2] * inv, o[qt][dt][4 * g + 3] * inv)};
      }
  }
}

DI float wave_scan_sum(float v, int lane) {
#pragma unroll
  for (int o = 1; o < 64; o <<= 1) { float t = shfl_up_(v, o, lane); if (lane >= o) v += t; }
  return v;
}
DI float wave_scan_max(float v, int lane) {
#pragma unroll
  for (int o = 1; o < 64; o <<= 1) { float t = shfl_up_(v, o, lane); if (lane >= o) v = fmaxf(v, t); }
  return v;
}

#define RLX_AGENT __ATOMIC_RELAXED, __HIP_MEMORY_SCOPE_AGENT
DI void mlstm_item(const Params& p, char* smem, int l, int b, int h, int eh, int dir, bool latent, int* prog_self, int* prog_partner) {
  bf16_t* sQ = (bf16_t*)smem;
  bf16_t* sK = sQ + 64 * 136;
  bf16_t* sKw = sK + 64 * 136;
  bf16_t* sVt = sKw + 128 * 72;
  float* sN = (float*)(sVt + 64 * 72);
  float* sA = sN + 128;
  const int tid = get_tid();
  const int S = latent ? 4096 : 256, nc = S >> 6, half = nc >> 1;
  const int rowbase = latent ? TC + b * 4096 : b * 256;
  bf16_t* Z = (bf16_t*)(p.ws + WS_Z);
  bf16_t* HB = (bf16_t*)(p.ws + WS_HB);
  const float* IF = (const float*)(p.ws + WS_IF);
  f32x16 C[4];
  float m_state = 0.f;
  __syncthreads();
  {
    const int lane = tid & 63, w = tid >> 6, l31 = lane & 31, hh = lane >> 5, et = w & 1;
    if (latent) {
      const size_t sidx = (size_t)((b * 2 + l) * 2 + dir) * 4 + h;
      const float* C0 = p.st_C + sidx * 128 * 128;
      int cidx0 = 4 * hh * 128 + 64 * eh + 32 * et + l31; asm volatile("" : "+v"(cidx0));
#pragma unroll
      for (int dt = 0; dt < 4; ++dt) {
#pragma unroll
        for (int r = 0; r < 16; ++r) C[dt][r] = C0[(unsigned)(cidx0 + (32 * dt + 8 * (r >> 2) + (r & 3)) * 128)];
        __builtin_amdgcn_sched_barrier(0);
      }
      if (tid < 128) sN[tid] = p.st_n[sidx * 128 + tid];
      m_state = p.st_m[sidx];
    } else {
#pragma unroll
      for (int dt = 0; dt < 4; ++dt)
#pragma unroll
        for (int r = 0; r < 16; ++r) C[dt][r] = 0.f;
      if (tid < 128) sN[tid] = 0.f;
    }
  }
  float ip_n, lf_n;
  u32x4 rq[4], rkk[4], rvv[2];
  auto prefetch = [&](int c) {
    const int cbase = rowbase + (dir ? (nc - 1 - c) * 64 : c * 64);
    int tidc = tid; asm volatile("" : "+v"(tidc));
    const int lane = tidc & 63;
    const int tokp = cbase + (dir ? 63 - lane : lane);
    ip_n = IF[(size_t)tokp * 16 + dir * 4 + h];
    lf_n = IF[(size_t)tokp * 16 + 8 + dir * 4 + h];
#pragma unroll
    for (int i = 0; i < 4; ++i) {
      int id = tidc + 256 * i, pr = id >> 4, seg = (id & 15) * 8;
      int tok = cbase + (dir ? 63 - pr : pr);
      rq[i] = *(const u32x4*)(Z + (size_t)tok * ZW + MQ + h * 128 + seg);
    }
    const int dgp = (tidc & 15) * 8;
#pragma unroll
    for (int i = 0; i < 2; ++i) {
      const int s0 = 2 * ((tidc >> 4) + 16 * i), s1 = s0 + 1;
      const int t0 = cbase + (dir ? 63 - s0 : s0), t1 = cbase + (dir ? 63 - s1 : s1);
      rkk[2 * i] = *(const u32x4*)(Z + (size_t)t0 * ZW + MK + h * 128 + dgp);
      rkk[2 * i + 1] = *(const u32x4*)(Z + (size_t)t1 * ZW + MK + h * 128 + dgp);
    }
    {
      const int dgv = (tidc & 7) * 8, s0 = 2 * (tidc >> 3), s1 = s0 + 1;
      const int t0 = cbase + (dir ? 63 - s0 : s0), t1 = cbase + (dir ? 63 - s1 : s1);
      rvv[0] = *(const u32x4*)(Z + (size_t)t0 * ZW + MV + h * 128 + 64 * eh + dgv);
      rvv[1] = *(const u32x4*)(Z + (size_t)t1 * ZW + MV + h * 128 + 64 * eh + dgv);
    }
  };
  prefetch(0);
#pragma unroll 1
  for (int c = 0; c < nc; ++c) {
    const int cbase = rowbase + (dir ? (nc - 1 - c) * 64 : c * 64);
    int tidc = tid; asm volatile("" : "+v"(tidc));
    const int lane = tidc & 63, w = tidc >> 6, l31 = lane & 31, hh = lane >> 5, et = w & 1, tt = w >> 1;
    const float ip = ip_n, lf = lf_n;
    const float bcum = wave_scan_sum(lf, lane);
    const float av = ip - bcum;
    const float pm = wave_scan_max(av, lane);
    const float Mv = fmaxf(m_state, pm);
    const float Mlast = shfl_(Mv, 63), blast = shfl_(bcum, 63);
    const float wsv = __expf(av - Mlast);
    const float decay = __expf(m_state - Mlast);
    __syncthreads();
#pragma unroll
    for (int i = 0; i < 4; ++i) {
      int id = tidc + 256 * i, pr = id >> 4, seg = (id & 15) * 8;
      *(u32x4*)(sQ + pr * 136 + seg) = rq[i];
    }
    {
      const int dgp = (tidc & 15) * 8;
#pragma unroll
      for (int i = 0; i < 2; ++i) {
        const int s0 = 2 * ((tidc >> 4) + 16 * i), s1 = s0 + 1;
        const u32x4 k0 = rkk[2 * i], k1 = rkk[2 * i + 1];
        *(u32x4*)(sK + s0 * 136 + dgp) = k0;
        *(u32x4*)(sK + s1 * 136 + dgp) = k1;
        const float w0 = shfl_(wsv, s0), w1 = shfl_(wsv, s1);
#pragma unroll
        for (int e = 0; e < 4; ++e) {
          const int sw = 2 * ((s0 >> 1) ^ (4 * ((tidc & 15) & 7)));
          *(unsigned*)(sKw + (dgp + 2 * e) * 72 + sw) = pk2(bflo(k0[e]) * w0, bflo(k1[e]) * w1);
          *(unsigned*)(sKw + (dgp + 2 * e + 1) * 72 + sw) = pk2(bfhi(k0[e]) * w0, bfhi(k1[e]) * w1);
        }
      }
      const int dgv = (tidc & 7) * 8, sv0 = 2 * (tidc >> 3);
#pragma unroll
      for (int e = 0; e < 4; ++e) {
        const int svw = 2 * ((sv0 >> 1) ^ (4 * (tidc & 7)));
        *(unsigned*)(sVt + (dgv + 2 * e) * 72 + svw) = (rvv[0][e] & 0xffffu) | (rvv[1][e] << 16);
        *(unsigned*)(sVt + (dgv + 2 * e + 1) * 72 + svw) = (rvv[0][e] >> 16) | (rvv[1][e] & 0xffff0000u);
      }
    }
    if (w == 0) sA[lane] = av;
    __syncthreads();
    if (c + 1 < nc) prefetch(c + 1);
    __builtin_amdgcn_sched_barrier(0);
    const int t = 32 * tt + l31;
    const int tok = cbase + (dir ? 63 - t : t);
    const bool finisher = c >= half;
    u32x2 og[4];
    if (finisher) {
#pragma unroll
      for (int g = 0; g < 4; ++g) og[g] = *(const u32x2*)(Z + (size_t)tok * ZW + MO + h * 128 + 64 * eh + 32 * et + 8 * g + 4 * hh);
    }
    float inv;
    f32x16 acc;
    {
      const float Mt = shfl_(Mv, t), bt = shfl_(bcum, t);
      const float winter = __expf(m_state - Mt);
#pragma unroll
      for (int r = 0; r < 16; ++r) acc[r] = 0.f;
#pragma unroll
      for (int dt = 0; dt < 4; ++dt)
#pragma unroll
        for (int s2 = 0; s2 < 2; ++s2) {
          u32x4 ca = {pk2(C[dt][8 * s2 + 0], C[dt][8 * s2 + 1]), pk2(C[dt][8 * s2 + 2], C[dt][8 * s2 + 3]),
                      pk2(C[dt][8 * s2 + 4], C[dt][8 * s2 + 5]), pk2(C[dt][8 * s2 + 6], C[dt][8 * s2 + 7])};
          const bf16_t* qp = sQ + t * 136 + 32 * dt + 16 * s2 + 4 * hh;
          u32x2 lo = *(const u32x2*)qp, hi = *(const u32x2*)(qp + 8);
          acc = MFMA(as_bf8(ca), as_bf8(u32x4{lo[0], lo[1], hi[0], hi[1]}), acc);
        }
#pragma unroll
      for (int r = 0; r < 16; ++r) acc[r] *= winter;
      float qv = 0.f;
#pragma unroll
      for (int j = 0; j < 8; ++j) {
        u32x4 q8 = *(const u32x4*)(sQ + t * 136 + 64 * hh + 8 * j);
        f32x4 n0 = *(const f32x4*)(sN + 64 * hh + 8 * j), n1 = *(const f32x4*)(sN + 64 * hh + 8 * j + 4);
        qv += bflo(q8[0]) * n0[0] + bfhi(q8[0]) * n0[1] + bflo(q8[1]) * n0[2] + bfhi(q8[1]) * n0[3] +
              bflo(q8[2]) * n1[0] + bfhi(q8[2]) * n1[1] + bflo(q8[3]) * n1[2] + bfhi(q8[3]) * n1[3];
      }
      qv += shfl_xor_(qv, 32, lane);
      float rsv = 0.f;
#pragma unroll
      for (int st = 0; st < 2; ++st) {
        f32x16 sm;
#pragma unroll
        for (int r = 0; r < 16; ++r) sm[r] = 0.f;
#pragma unroll
        for (int ks = 0; ks < 8; ++ks) {
          bf16x8 ka = *(const bf16x8*)(sK + (32 * st + l31) * 136 + 16 * ks + 8 * hh);
          bf16x8 qb = *(const bf16x8*)(sQ + t * 136 + 16 * ks + 8 * hh);
          sm = MFMA(ka, qb, sm);
        }
#pragma unroll
        for (int g = 0; g < 4; ++g) {
          f32x4 a4 = *(const f32x4*)(sA + 32 * st + 8 * g + 4 * hh);
#pragma unroll
          for (int e = 0; e < 4; ++e) {
            const int s = 32 * st + 8 * g + 4 * hh + e;
            float wgt = s <= t ? __expf(a4[e] - Mt) : 0.f;
            float v = sm[4 * g + e] * wgt;
            sm[4 * g + e] = v;
            rsv += v;
          }
        }
#pragma unroll
        for (int s2 = 0; s2 < 2; ++s2) {
          const int rgv = (4 * et + (l31 >> 3)) & 7;
          const bf16_t* vrow = sVt + (32 * et + l31) * 72 + 4 * hh;
          u32x2 lo = *(const u32x2*)(vrow + 8 * ((4 * st + 2 * s2) ^ rgv)), hi = *(const u32x2*)(vrow + 8 * ((4 * st + 2 * s2 + 1) ^ rgv));
          u32x4 pb = {pk2(sm[8 * s2 + 0], sm[8 * s2 + 1]), pk2(sm[8 * s2 + 2], sm[8 * s2 + 3]),
                      pk2(sm[8 * s2 + 4], sm[8 * s2 + 5]), pk2(sm[8 * s2 + 6], sm[8 * s2 + 7])};
          acc = MFMA(as_bf8(u32x4{lo[0], lo[1], hi[0], hi[1]}), as_bf8(pb), acc);
        }
      }
      rsv += shfl_xor_(rsv, 32, lane);
      const float den = winter * qv + rsv;
      inv = 1.f / fmaxf(fabsf(den), __expf(-(bt + Mt)));
    }
#pragma unroll
    for (int dt = 0; dt < 4; ++dt) {
#pragma unroll
      for (int r = 0; r < 16; ++r) C[dt][r] *= decay;
#pragma unroll
      for (int ks = 0; ks < 4; ++ks) {
        bf16x8 ka = *(const bf16x8*)(sKw + (32 * dt + l31) * 72 + 8 * ((2 * ks + hh) ^ ((4 * dt + (l31 >> 3)) & 7)));
        bf16x8 vb = *(const bf16x8*)(sVt + (32 * et + l31) * 72 + 8 * ((2 * ks + hh) ^ ((4 * et + (l31 >> 3)) & 7)));
        C[dt] = MFMA(ka, vb, C[dt]);
      }
    }
    {
      unsigned long long* hbp = (unsigned long long*)(HB + (size_t)tok * 512 + h * 128 + 64 * eh + 32 * et + 4 * hh);
      if (!finisher) {
#pragma unroll
        for (int g = 0; g < 4; ++g) {
          const unsigned lo = pk2(acc[4 * g] * inv, acc[4 * g + 1] * inv), hi = pk2(acc[4 * g + 2] * inv, acc[4 * g + 3] * inv);
          __hip_atomic_store(hbp + 2 * g, ((unsigned long long)hi << 32) | lo, RLX_AGENT);
        }
        asm volatile("s_waitcnt vmcnt(0)" ::: "memory");
      } else {
        const int need = nc - c;
        unsigned spins = 0;
        while (__builtin_amdgcn_readfirstlane(__hip_atomic_load(prog_partner, RLX_AGENT)) < need) {
          __builtin_amdgcn_s_sleep(1);
          if (++spins > (1u << 24)) break;
        }
        __builtin_amdgcn_fence(__ATOMIC_ACQUIRE, "agent");
#pragma unroll
        for (int g = 0; g < 4; ++g) {
          const unsigned long long hb = hbp[2 * g];
          const unsigned hlo = (unsigned)hb, hhi = (unsigned)(hb >> 32);
          const float y0 = (acc[4 * g] * inv + bflo(hlo)) * sigmoidf_(bflo(og[g][0]));
          const float y1 = (acc[4 * g + 1] * inv + bfhi(hlo)) * sigmoidf_(bfhi(og[g][0]));
          const float y2 = (acc[4 * g + 2] * inv + bflo(hhi)) * sigmoidf_(bflo(og[g][1]));
          const float y3 = (acc[4 * g + 3] * inv + bfhi(hhi)) * sigmoidf_(bfhi(og[g][1]));
          hbp[2 * g] = ((unsigned long long)pk2(y2, y3) << 32) | pk2(y0, y1);
        }
      }
    }
    __syncthreads();
    if (!finisher && tidc == 0) __hip_atomic_store(prog_self, c + 1, RLX_AGENT);
    if (tidc < 128) {
      float sum = 0.f;
#pragma unroll
      for (int j = 0; j < 8; ++j) {
        u32x4 k8 = *(const u32x4*)(sKw + tidc * 72 + 8 * j);
        sum += bflo(k8[0]) + bfhi(k8[0]) + bflo(k8[1]) + bfhi(k8[1]) + bflo(k8[2]) + bfhi(k8[2]) + bflo(k8[3]) + bfhi(k8[3]);
      }
      sN[tidc] = decay * sN[tidc] + sum;
    }
    m_state = blast + Mlast;
  }
  if (!latent) {
    const int lane = tid & 63, w = tid >> 6, l31 = lane & 31, hh = lane >> 5, et = w & 1, tt = w >> 1;
    const size_t sidx = (size_t)((b * 2 + l) * 2 + dir) * 4 + h;
    float* Co = p.out + OUT_C + sidx * 128 * 128;
    if (tt == 0) {
      int cidx1 = 4 * hh * 128 + 64 * eh + 32 * et + l31; asm volatile("" : "+v"(cidx1));
#pragma unroll
      for (int dt = 0; dt < 4; ++dt) {
#pragma unroll
        for (int r = 0; r < 16; ++r) Co[(unsigned)(cidx1 + (32 * dt + 8 * (r >> 2) + (r & 3)) * 128)] = C[dt][r];
        __builtin_amdgcn_sched_barrier(0);
      }
    }
    __syncthreads();
    if (eh == 0) {
      if (tid < 128) p.out[OUT_N + sidx * 128 + tid] = sN[tid];
      if (tid == 0) p.out[OUT_M + sidx] = m_state;
    }
  }
}

DI void mlstm_norm_phase(const Params& p, int l) {
  const int tid = get_tid(), lane = tid & 63, w = tid >> 6;
  const bf16_t* HB = (const bf16_t*)(p.ws + WS_HB);
  bf16_t* Z = (bf16_t*)(p.ws + WS_Z);
  const float* g = p.ml_g + l * 512 + lane * 8;
  const f32x4 g0 = *(const f32x4*)g, g1 = *(const f32x4*)(g + 4);
  for (int row = blockIdx.x * 4 + w; row < TT; row += gridDim.x * 4) {
    u32x4 y = *(const u32x4*)(HB + (size_t)row * 512 + lane * 8);
    float v[8] = {bflo(y[0]), bfhi(y[0]), bflo(y[1]), bfhi(y[1]), bflo(y[2]), bfhi(y[2]), bflo(y[3]), bfhi(y[3])};
    float ss = 0.f;
#pragma unroll
    for (int e = 0; e < 8; ++e) ss += v[e] * v[e];
#pragma unroll
    for (int o = 8; o >= 1; o >>= 1) ss += shfl_xor_(ss, o, lane);
    const float rstd = rsqrtf(ss * (1.f / 128.f) + 1e-6f);
    *(u32x4*)(Z + (size_t)row * ZW + MQ + lane * 8) =
        u32x4{pk2(v[0] * rstd * g0[0], v[1] * rstd * g0[1]), pk2(v[2] * rstd * g0[2], v[3] * rstd * g0[3]),
              pk2(v[4] * rstd * g1[0], v[5] * rstd * g1[1]), pk2(v[6] * rstd * g1[2], v[7] * rstd * g1[3])};
  }
}

constexpr int MIX_ITEMS = 4224;
DI void phase_mixers(const Params& p, int l, char* smem) {
  __shared__ int s_item;
  const int tid = get_tid();
  int* cnt = (int*)(p.ws + WS_CNT) + l;
  auto draw = [&]() -> int {
    __syncthreads();
    if (tid == 0) s_item = atomicAdd(cnt, 1);
    __syncthreads();
    return __builtin_amdgcn_readfirstlane(s_item);
  };
  int item = draw();
  while (item < 384) {
    const bool lat = item < 128;
    const int j = lat ? item : item - 128;
    int* prog = (int*)(p.ws + WS_CNT) + 16 + l * 384;
    mlstm_item(p, smem, l, j >> 4, (j >> 2) & 3, (j >> 1) & 1, j & 1, lat, prog + item, prog + (item ^ 1));
    item = draw();
  }
#ifndef NO_ATTN
  const int w = __builtin_amdgcn_readfirstlane(get_tid() >> 6);
  bf16_t* Z = (bf16_t*)(p.ws + WS_Z);
  for (; item < MIX_ITEMS; item = draw()) {
    AttnArgs a;
    a.k2 = nullptr; a.v2 = nullptr; a.blk0_2 = 0; a.nblk2 = 0; a.mode = 0; a.m0 = -INFINITY; a.l0 = 0.f; a.rpb = nullptr; a.qpos0 = 0;
    a.nblk1 = 4;
    if (item < 1408) {
      int j = item - 384, qt = j & 63, kv = (j >> 6) & 1, b = j >> 7;
      const float* cb = p.cache_gqa + (size_t)((b * 2 + l) * 2) * 256 * 128 + kv * 64;
      a.k1 = cb; a.v1 = cb + 256 * 128; a.stride1 = 128; a.f32_1 = 1;
      bf16_t* zb = Z + (size_t)(TC + b * 4096) * ZW;
      a.k2 = zb + GK + kv * 64; a.v2 = zb + GV + kv * 64; a.blk0_2 = 0; a.nblk2 = 64;
      a.qo = zb + (size_t)(qt * 64) * ZW + GQ + (kv * 4 + w) * 64;
      attn_item<2>(a, smem);
      continue;
    } else if (item < 2432) {
      int j = item - 1408, qt = j & 63, kv = (j >> 6) & 1, b = j >> 7;
      const float* cb = p.cache_swa + (size_t)((b * 2 + l) * 2) * 256 * 128 + kv * 64;
      a.k1 = cb; a.v1 = cb + 256 * 128; a.stride1 = 128; a.f32_1 = 1;
      bf16_t* zb = Z + (size_t)(TC + b * 4096) * ZW;
      a.k2 = zb + SK + kv * 64; a.v2 = zb + SV + kv * 64;
      const int q0 = qt * 64;
      int lo = q0 - 128; lo = lo < 0 ? 0 : lo;
      int hi = q0 + 63 + 128; hi = hi > 4095 ? 4095 : hi;
      a.blk0_2 = lo >> 6; a.nblk2 = (hi >> 6) - (lo >> 6) + 1;
      a.qo = zb + (size_t)q0 * ZW + SQ + (kv * 4 + w) * 64;
      a.qpos0 = q0; a.mode = 1;
      a.m0 = p.swa_sink[l * 8 + kv * 4 + w] * LOG2E; a.l0 = 1.f;
      attn_item<2>(a, smem);
      continue;
    } else if (item < 3456) {
      int j = item - 2432, rq = j & 15, h = (j >> 4) & 7, b = j >> 7;
      const float* cb = p.cache_na + (size_t)((b * 2 + l) * 2) * 256 * 512 + h * 64;
      a.k1 = cb; a.v1 = cb + 256 * 512; a.stride1 = 512; a.f32_1 = 1;
      bf16_t* zb = Z + (size_t)(TC + b * 4096) * ZW;
      a.k2 = zb + NAK + h * 64; a.v2 = zb + NAV + h * 64;
      int r0 = 4 * rq, r1 = r0 + 3;
      int rs0 = r0 - 4; rs0 = rs0 < 0 ? 0 : (rs0 > 56 ? 56 : rs0);
      int rs1 = r1 - 4; rs1 = rs1 < 0 ? 0 : (rs1 > 56 ? 56 : rs1);
      a.blk0_2 = rs0; a.nblk2 = rs1 + 8 - rs0;
      const int q0 = (r0 + w) * 64;
      a.qo = zb + (size_t)q0 * ZW + NAQ + h * 64;
      a.qpos0 = q0; a.mode = 2; a.rpb = p.na_rpb + (size_t)(l * 8 + h) * 465;
      attn_item<2>(a, smem);
      continue;
    } else if (item < 3712) {
      int j = item - 3456, qtile = j & 1, h = (j >> 1) & 7, b = j >> 4;
      bf16_t* zb = Z + (size_t)(b * 256) * ZW;
      a.k1 = zb + NAK + h * 64; a.v1 = zb + NAV + h * 64; a.stride1 = ZW; a.f32_1 = 0;
      a.qo = zb + (size_t)(qtile * 128 + 32 * w) * ZW + NAQ + h * 64;
    } else if (item < 3968) {
      int j = item - 3712, qt = j & 7, kv = (j >> 3) & 1, b = j >> 4;
      bf16_t* zb = Z + (size_t)(b * 256) * ZW;
      a.k1 = zb + GK + kv * 64; a.v1 = zb + GV + kv * 64; a.stride1 = ZW; a.f32_1 = 0;
      a.qo = zb + (size_t)(qt * 32) * ZW + GQ + (kv * 4 + w) * 64;
    } else {
      int j = item - 3968, qt = j & 7, kv = (j >> 3) & 1, b = j >> 4;
      bf16_t* zb = Z + (size_t)(b * 256) * ZW;
      a.k1 = zb + SK + kv * 64; a.v1 = zb + SV + kv * 64; a.stride1 = ZW; a.f32_1 = 0;
      a.qo = zb + (size_t)(qt * 32) * ZW + SQ + (kv * 4 + w) * 64;
      a.m0 = p.swa_sink[l * 8 + kv * 4 + w] * LOG2E; a.l0 = 1.f;
    }
    attn_item<1>(a, smem);
  }
#endif
}

#define XB_TMO      128
#define XB_XCNT(j)  (256  + 64 * (j))
#define XB_XSUB(j)  (1280 + 64 * (j))
#define XB_XGEN(j)  (2304 + 64 * (j))
#define XB_TOP      3328
#define XB_TOPGEN   3392
#define XCD_BAR_WORDS 3456
#define XB_SPIN_CAP (1u << 18)
#define LAS __attribute__((address_space(3)))
DI unsigned xb_ld(unsigned* p) { return __hip_atomic_load(p, __ATOMIC_RELAXED, __HIP_MEMORY_SCOPE_AGENT); }
DI unsigned xb_add(unsigned* p, unsigned v) { return __hip_atomic_fetch_add(p, v, __ATOMIC_RELAXED, __HIP_MEMORY_SCOPE_AGENT); }
DI unsigned xb_xcc_id() { return (unsigned)__builtin_amdgcn_s_getreg((3 << 11) | 20) & 0xFu; }
#define XB_SPIN(cond, bar) do { unsigned _sp = 0; while (cond) { __builtin_amdgcn_s_sleep(1); \
    if ((++_sp & 255u) == 0u) { if (xb_ld(&(bar)[XB_TMO])) break; if (_sp > XB_SPIN_CAP) { atomicAdd(&(bar)[XB_TMO], 1u); break; } } } } while (0)
struct XcdBarrier { unsigned* bar; unsigned x; volatile LAS unsigned* st; };
DI XcdBarrier xcd_barrier_post(unsigned* bar, volatile LAS unsigned* st) {
  XcdBarrier b; b.bar = bar; b.x = xb_xcc_id(); b.st = st;
  if (threadIdx.x == 0) (void)xb_add(&bar[XB_XCNT(b.x)], 1u);
  return b;
}
DI void xcd_barrier_complete(unsigned* bar, unsigned x, unsigned& nloc, unsigned& nx) {
  const unsigned G = gridDim.x * gridDim.y * gridDim.z;
  unsigned sum, cnt, mine, sp = 0u;
  for (;;) {
    sum = 0u; cnt = 0u; mine = 0u;
#pragma unroll
    for (unsigned j = 0; j < 16; ++j) { const unsigned c = xb_ld(&bar[XB_XCNT(j)]); sum += c; cnt += (c > 0u) ? 1u : 0u; mine = (j == x) ? c : mine; }
    if (sum == G) break;
    __builtin_amdgcn_s_sleep(1);
    if ((++sp & 255u) == 0u) { if (xb_ld(&bar[XB_TMO])) break; if (sp > XB_SPIN_CAP) { atomicAdd(&bar[XB_TMO], 1u); break; } }
  }
  nloc = mine > 0u ? mine : 1u; nx = cnt > 0u ? cnt : 1u;
}
DI void xcd_barrier(const XcdBarrier& b) {
  asm volatile("s_waitcnt vmcnt(0)" ::: "memory");
  __syncthreads();
  if (threadIdx.x == 0) {
    unsigned* bar = b.bar;
    __builtin_amdgcn_s_waitcnt(0);
    unsigned nloc = b.st[0], nx = b.st[1];
    if (nloc == 0u) { xcd_barrier_complete(bar, b.x, nloc, nx); b.st[0] = nloc; b.st[1] = nx; }
    const unsigned old = xb_add(&bar[XB_XSUB(b.x)], 1u);
    const unsigned gen = old / nloc;
    if (old + 1u == (gen + 1u) * nloc) {
      __builtin_amdgcn_fence(__ATOMIC_RELEASE, "agent");
      asm volatile("s_waitcnt vmcnt(0)" ::: "memory");
      const unsigned og = xb_add(&bar[XB_TOP], 1u);
      const unsigned tg = og / nx;
      if (og + 1u == (tg + 1u) * nx) xb_add(&bar[XB_TOPGEN], 1u);
      else XB_SPIN(xb_ld(&bar[XB_TOPGEN]) == tg, bar);
      __builtin_amdgcn_fence(__ATOMIC_ACQUIRE, "agent");
      xb_add(&bar[XB_XGEN(b.x)], 1u);
      asm volatile("s_waitcnt vmcnt(0)" ::: "memory");
    } else {
      XB_SPIN(xb_ld(&bar[XB_XGEN(b.x)]) == gen, bar);
      __builtin_amdgcn_fence(__ATOMIC_ACQUIRE, "agent");
      asm volatile("s_waitcnt vmcnt(0)" ::: "memory");
    }
  }
  __syncthreads();
}

constexpr int N_PHASES = 20;
DI void run_phase(const Params& p, int ph, char* smem) {
  if (ph == 0) { phase0(p, smem); return; }
  if (ph == 19) { norm_phase(p, 0, 2); return; }
  const int l = (ph - 1) / 9, s = (ph - 1) % 9;
  switch (s) {
    case 0: convert_weights(p, l, smem); norm_phase(p, l, 0); break;
    case 1: phase_inproj(p, l, smem); break;
    case 2: phase_mixers(p, l, smem); break;
    case 3: mlstm_norm_phase(p, l); break;
    case 4: phase_merge(p, l, smem); break;
    case 5: phase_resid(p, l, 0, smem); break;
    case 6: norm_phase(p, l, 1); break;
    case 7: phase_ffn1(p, l, smem); break;
    default: phase_resid(p, l, 1, smem); break;
  }
}

#ifndef MK_TEST
template <bool COOP>
__global__ void __launch_bounds__(256, 2) hybrid_fwd(Params p, int ph_lo, int ph_hi) {
  extern __shared__ __attribute__((aligned(16))) char smem[];
  __shared__ uint4 xb_words;
  if (COOP) {
    if (threadIdx.x == 0) xb_words = make_uint4(0u, 0u, 0u, 0u);
    __syncthreads();
    run_phase(p, 0, smem);
    cg::this_grid().sync();
    XcdBarrier xb = xcd_barrier_post((unsigned*)(p.ws + WS_BAR), (volatile LAS unsigned*)&xb_words);
    for (int ph = 1; ph < ph_hi; ++ph) {
      run_phase(p, ph, smem);
#ifdef PROBE_DUP
      if (ph >= 1 && ph <= 18 && ((PROBE_DUP >> ((ph - 1) % 9)) & 1)) run_phase(p, ph, smem);
#endif
      if (ph + 1 < ph_hi) xcd_barrier(xb);
    }
  } else {
    for (int ph = ph_lo; ph < ph_hi; ++ph) run_phase(p, ph, smem);
  }
}

extern "C" void kernel_launch(void* const* d_in, const int* in_sizes, int n_in, void* d_out, int out_size, void* d_ws, size_t ws_size, hipStream_t stream) {
  static int grid = 0;
  if (grid == 0) {
    if (n_in != 26 || ws_size < WS_END) { fprintf(stderr, "kernel_launch: bad n_in %d or ws_size %zu (need %zu)\n", n_in, ws_size, (size_t)WS_END); grid = -1; return; }
    int dev = 0, cus = 0, per_cu = 0;
    hipGetDevice(&dev);
    hipDeviceGetAttribute(&cus, hipDeviceAttributeMultiprocessorCount, dev);
    hipFuncSetAttribute((const void*)hybrid_fwd<true>, hipFuncAttributeMaxDynamicSharedMemorySize, SMEM_BYTES);
    hipFuncSetAttribute((const void*)hybrid_fwd<false>, hipFuncAttributeMaxDynamicSharedMemorySize, SMEM_BYTES);
    hipOccupancyMaxActiveBlocksPerMultiprocessor(&per_cu, (const void*)hybrid_fwd<true>, 256, SMEM_BYTES);
    if (per_cu < 1) per_cu = 1;
    if (per_cu > 2) per_cu = 2;
    grid = cus * per_cu;
  }
  if (grid < 0) return;
  Params p{};
  const float** pp = (const float**)&p;
  for (int i = 0; i < 26; ++i) pp[i] = (const float*)d_in[i];
  p.out = (float*)d_out;
  p.ws = (char*)d_ws;
#if MK_COOP
  int lo = 0, hi = N_PHASES;
  void* args[] = {&p, &lo, &hi};
  hipError_t e = hipLaunchCooperativeKernel((const void*)hybrid_fwd<true>, dim3(grid), dim3(256), args, SMEM_BYTES, stream);
  if (e != hipSuccess) fprintf(stderr, "cooperative launch failed: %s (grid %d)\n", hipGetErrorString(e), grid);
#else
  for (int ph = 0; ph < N_PHASES; ++ph) hybrid_fwd<false><<<grid, 256, SMEM_BYTES, stream>>>(p, ph, ph + 1);
#endif
}
#endif
```

```cpp
#include <hip/hip_runtime.h>
#include <hip/hip_cooperative_groups.h>
#include <stdint.h>
#include <stdio.h>
namespace cg = cooperative_groups;

#ifndef MK_COOP
#define MK_COOP 1
#endif

typedef unsigned short bf16_t;
typedef __attribute__((ext_vector_type(8))) short bf16x8;
typedef __attribute__((ext_vector_type(16))) float f32x16;
typedef __attribute__((ext_vector_type(4))) float f32x4;
typedef __attribute__((ext_vector_type(4))) unsigned u32x4;
typedef __attribute__((ext_vector_type(2))) unsigned u32x2;

#define DI __device__ __forceinline__
#define MFMA(a, b, c) __builtin_amdgcn_mfma_f32_32x32x16_bf16((a), (b), (c), 0, 0, 0)

typedef __attribute__((ext_vector_type(2))) __bf16 bf16x2_t;
typedef __attribute__((ext_vector_type(2))) float f32x2;
DI unsigned pk2(float lo, float hi) { f32x2 v = {lo, hi}; bf16x2_t b = __builtin_convertvector(v, bf16x2_t); return __builtin_bit_cast(unsigned, b); }
DI float bflo(unsigned u) { return __uint_as_float(u << 16); }
DI float bfhi(unsigned u) { return __uint_as_float(u & 0xffff0000u); }
DI bf16x8 as_bf8(u32x4 v) { return __builtin_bit_cast(bf16x8, v); }
DI int get_tid() { int t = (int)__builtin_amdgcn_workitem_id_x(); asm volatile("" : "+v"(t)); return t; }
DI float shfl_(float v, int src) { return __int_as_float(__builtin_amdgcn_ds_bpermute(src << 2, __float_as_int(v))); }
DI float shfl_xor_(float v, int o, int lane) { return shfl_(v, lane ^ o); }
DI float shfl_up_(float v, int o, int lane) { int s = lane - o; return shfl_(v, s < 0 ? lane : s); }
DI float sigmoidf_(float x) { return 1.f / (1.f + __expf(-x)); }

constexpr int TC = 4096;
constexpr int TL = 32768;
constexpr int TT = TC + TL;
constexpr int DM = 1024;
constexpr int NIN = 9232;
constexpr int NZ = 5136;
constexpr int ZW = 5120;
constexpr int DFF = 2816;
constexpr int NAQ = 0, NAK = 512, NAV = 1024, GQ = 1536, GK = 2048, GV = 2176, SQ = 2304, SK = 2816, SV = 2944,
              MQ = 3072, MK = 3584, MV = 4096, MO = 4608;
constexpr int MGC = 512;
constexpr size_t WS_WIN = 0;
constexpr size_t WS_WBR = WS_WIN + (size_t)NIN * DM * 2;
constexpr size_t WS_WOUT = WS_WBR + (size_t)4 * 1024 * 512 * 2;
constexpr size_t WS_WF1 = WS_WOUT + (size_t)1024 * 1024 * 2;
constexpr size_t WS_WF2 = WS_WF1 + (size_t)5632 * 1024 * 2;
constexpr size_t WS_Z = WS_WF2 + (size_t)1024 * DFF * 2;
constexpr size_t WS_H = WS_Z + (size_t)TT * ZW * 2;
constexpr size_t WS_HB = WS_H + (size_t)TT * DM * 2;
constexpr size_t WS_IF = WS_HB + (size_t)TT * 512 * 2;
constexpr size_t WS_MODS = WS_IF + (size_t)TT * 16 * 4;
constexpr size_t WS_ROPE = WS_MODS + (size_t)2 * 9 * 6144 * 4;
constexpr size_t WS_CNT = WS_ROPE + 2 * 1024 * 4;
constexpr size_t WS_BAR = WS_CNT + 4096;
constexpr size_t WS_END = WS_BAR + 16384;
constexpr size_t OUT_YP = 0, OUT_YS = 4194304, OUT_NA = 37748736, OUT_GQA = 46137344, OUT_SWA = 48234496,
                 OUT_C = 50331648, OUT_N = 54525952, OUT_M = 54558720;

constexpr int SMEM_BYTES = 74752;
constexpr float LOG2E = 1.4426950408889634f;

struct Params {
  const float *x_prompt, *x_sample, *cache_na, *cache_gqa, *cache_swa, *st_C, *st_n, *st_m, *c, *c_ctx,
      *w_mod, *b_mod, *norm1_g, *norm2_g, *w_in, *b_in, *na_rpb, *gqa_q_g, *gqa_k_g, *swa_sink, *ml_g,
      *w_branch, *w_out, *w_f1, *w_f2, *final_g;
  float* out;
  char* ws;
};

DI int cond_of_row(int grow) { return grow < TC ? 0 : 1 + ((grow - TC) >> 12); }

DI void phase0(const Params& p, char* smem) {
  const int tid = get_tid();
  if (blockIdx.x == 0) {
    int* cnt = (int*)(p.ws + WS_CNT);
    for (int i = tid; i < 1024 + 4096; i += 256) cnt[i] = 0;
    float* rc = (float*)(p.ws + WS_ROPE);
    for (int idx = tid; idx < 1024; idx += 256) {
      int pos = idx >> 4, j = idx & 15;
      float freq = exp2f(-(float)j * (13.287712379549449f / 16.f));
      float ang = (float)pos * freq;
      float k = rintf(ang * 0.15915494309189535f);
      float r = fmaf(-k, 6.2831854820251465f, ang);
      r = fmaf(k, 1.7484555e-7f, r);
      rc[idx] = __cosf(r);
      rc[1024 + idx] = __sinf(r);
    }
  }
  float* sS = (float*)smem;
  float* sR = (float*)(smem + 36864);
  for (int idx = tid; idx < 9 * 1024; idx += 256) {
    int cv = idx >> 10, k = idx & 1023;
    float v = cv == 0 ? p.c_ctx[k] : p.c[(cv - 1) * 1024 + k];
    sS[idx] = v / (1.f + __expf(-v));
  }
  __syncthreads();
  for (int item = blockIdx.x; item < 192; item += gridDim.x) {
    int l = item / 96, n0 = (item % 96) * 64, n = n0 + (tid & 63), kg = tid >> 6;
    const float* w = p.w_mod + (size_t)l * 1024 * 6144 + n;
    float acc[9];
#pragma unroll
    for (int cv = 0; cv < 9; ++cv) acc[cv] = 0.f;
#pragma unroll 4
    for (int k = kg * 256; k < kg * 256 + 256; ++k) {
      float wv = w[(size_t)k * 6144];
#pragma unroll
      for (int cv = 0; cv < 9; ++cv) acc[cv] = fmaf(sS[cv * 1024 + k], wv, acc[cv]);
    }
#pragma unroll
    for (int cv = 0; cv < 9; ++cv) sR[(kg * 9 + cv) * 64 + (tid & 63)] = acc[cv];
    __syncthreads();
    if (tid < 64) {
      float* mods = (float*)(p.ws + WS_MODS);
      float bm = p.b_mod[l * 6144 + n];
#pragma unroll
      for (int cv = 0; cv < 9; ++cv) {
        float s = sR[(0 * 9 + cv) * 64 + tid] + sR[(1 * 9 + cv) * 64 + tid] + sR[(2 * 9 + cv) * 64 + tid] + sR[(3 * 9 + cv) * 64 + tid];
        mods[(size_t)(l * 9 + cv) * 6144 + n] = s + bm;
      }
    }
    __syncthreads();
  }
}

DI void convert_tile(const float* __restrict__ src, int K, int N, bf16_t* __restrict__ dst, int kt, int nt, int f1perm, char* smem) {
  float* sT = (float*)smem;
  const int tid = get_tid();
  __syncthreads();
  {
    int n4 = (tid & 15) * 4, kr = tid >> 4;
#pragma unroll
    for (int i = 0; i < 4; ++i) {
      int k = kr + 16 * i;
      int n = nt * 64 + n4;
      f32x4 v = {0.f, 0.f, 0.f, 0.f};
      if (n < N) v = *(const f32x4*)(src + (size_t)(kt * 64 + k) * N + n);
      sT[k * 65 + n4 + 0] = v[0]; sT[k * 65 + n4 + 1] = v[1]; sT[k * 65 + n4 + 2] = v[2]; sT[k * 65 + n4 + 3] = v[3];
    }
  }
  __syncthreads();
  {
    int nl = tid >> 2, seg = (tid & 3) * 16;
    int n = nt * 64 + nl;
    if (n < N) {
      int drow = n;
      if (f1perm) { int j = n < DFF ? n : n - DFF; drow = (j >> 6) * 128 + (n < DFF ? 0 : 64) + (j & 63); }
      unsigned o[8];
#pragma unroll
      for (int q = 0; q < 8; ++q) o[q] = pk2(sT[(seg + 2 * q) * 65 + nl], sT[(seg + 2 * q + 1) * 65 + nl]);
      u32x4* d = (u32x4*)(dst + (size_t)drow * K + kt * 64 + seg);
      d[0] = u32x4{o[0], o[1], o[2], o[3]};
      d[1] = u32x4{o[4], o[5], o[6], o[7]};
    }
  }
}

DI void convert_weights(const Params& p, int l, char* smem) {
  for (int item = blockIdx.x; item < 5200; item += gridDim.x) {
    const float* src; bf16_t* dst; int K, N, kt, nt, perm = 0;
    int j = item;
    if (j < 2320) { src = p.w_in + (size_t)l * 1024 * NIN; K = 1024; N = NIN; dst = (bf16_t*)(p.ws + WS_WIN); kt = j / 145; nt = j % 145; }
    else if (j < 2832) { j -= 2320; int i = j >> 7; j &= 127; src = p.w_branch + (size_t)(l * 4 + i) * 512 * 1024; K = 512; N = 1024; dst = (bf16_t*)(p.ws + WS_WBR) + (size_t)i * 1024 * 512; kt = j >> 4; nt = j & 15; }
    else if (j < 3088) { j -= 2832; src = p.w_out + (size_t)l * 1024 * 1024; K = 1024; N = 1024; dst = (bf16_t*)(p.ws + WS_WOUT); kt = j >> 4; nt = j & 15; }
    else if (j < 4496) { j -= 3088; src = p.w_f1 + (size_t)l * 1024 * 5632; K = 1024; N = 5632; dst = (bf16_t*)(p.ws + WS_WF1); kt = j / 88; nt = j % 88; perm = 1; }
    else { j -= 4496; src = p.w_f2 + (size_t)l * DFF * 1024; K = DFF; N = 1024; dst = (bf16_t*)(p.ws + WS_WF2); kt = j >> 4; nt = j & 15; }
    convert_tile(src, K, N, dst, kt, nt, perm, smem);
  }
}

DI void norm_phase(const Params& p, int l, int which) {
  const int tid = get_tid(), lane = tid & 63, w = tid >> 6;
  const float* g = which == 0 ? p.norm1_g + l * 1024 : (which == 1 ? p.norm2_g + l * 1024 : p.final_g);
  const float* mods = (const float*)(p.ws + WS_MODS);
  bf16_t* H = (bf16_t*)(p.ws + WS_H);
  for (int row = blockIdx.x * 4 + w; row < TT; row += gridDim.x * 4) {
    const float* xr;
    if (which == 0 && l == 0) xr = row < TC ? p.x_prompt + (size_t)row * 1024 : p.x_sample + (size_t)(row - TC) * 1024;
    else xr = p.out + (size_t)row * 1024;
    f32x4 v[4];
    float ss = 0.f;
#pragma unroll
    for (int i = 0; i < 4; ++i) {
      v[i] = *(const f32x4*)(xr + 4 * lane + 256 * i);
      ss += v[i][0] * v[i][0] + v[i][1] * v[i][1] + v[i][2] * v[i][2] + v[i][3] * v[i][3];
    }
#pragma unroll
    for (int o = 32; o >= 1; o >>= 1) ss += shfl_xor_(ss, o, lane);
    float rstd = rsqrtf(ss * (1.f / 1024.f) + 1e-6f);
    if (which == 2) {
      float* yo = p.out + (size_t)row * 1024;
#pragma unroll
      for (int i = 0; i < 4; ++i) {
        int k = 4 * lane + 256 * i;
        f32x4 g4 = *(const f32x4*)(g + k);
        f32x4 y;
#pragma unroll
        for (int e = 0; e < 4; ++e) y[e] = v[i][e] * rstd * g4[e];
        *(f32x4*)(yo + k) = y;
      }
    } else {
      const float* mr = mods + (size_t)(l * 9 + cond_of_row(row)) * 6144 + (which == 0 ? 0 : 3072);
#pragma unroll
      for (int i = 0; i < 4; ++i) {
        int k = 4 * lane + 256 * i;
        f32x4 g4 = *(const f32x4*)(g + k);
        f32x4 sh = *(const f32x4*)(mr + k);
        f32x4 sc = *(const f32x4*)(mr + 1024 + k);
        float y[4];
#pragma unroll
        for (int e = 0; e < 4; ++e) y[e] = (v[i][e] * rstd * g4[e]) * (1.f + sc[e]) + sh[e];
        *(u32x2*)(H + (size_t)row * 1024 + k) = u32x2{pk2(y[0], y[1]), pk2(y[2], y[3])};
      }
    }
  }
}

template <bool DB = true>
DI void gemm_core(const bf16_t* __restrict__ A, int lda, const bf16_t* __restrict__ B, int ldb, int K, f32x16 (&acc)[2][2], char* smem) {
  bf16_t* sA = (bf16_t*)smem;
  bf16_t* sB = sA + (DB ? 2 : 1) * 128 * 72;
  const int tid = get_tid(), lane = tid & 63, w = tid >> 6, wm = w >> 1, wn = w & 1, l31 = lane & 31, hh = lane >> 5;
  const int lrow = tid >> 3, lseg = (tid & 7) * 8;
  const char* Ab = (const char*)A;
  const char* Bb = (const char*)B;
  const unsigned offA = (unsigned)(lrow * lda + lseg) * 2u, offB = (unsigned)(lrow * ldb + lseg) * 2u;
  const unsigned stepA = (unsigned)lda * 64u, stepB = (unsigned)ldb * 64u;
  u32x4 ra[4], rb[4];
#pragma unroll
  for (int i = 0; i < 4; ++i) { ra[i] = *(const u32x4*)(Ab + (offA + i * stepA)); rb[i] = *(const u32x4*)(Bb + (offB + i * stepB)); }
  __syncthreads();
#pragma unroll
  for (int i = 0; i < 4; ++i) { *(u32x4*)(sA + (lrow + 32 * i) * 72 + lseg) = ra[i]; *(u32x4*)(sB + (lrow + 32 * i) * 72 + lseg) = rb[i]; }
  __syncthreads();
  const int nk = K >> 6;
  for (int kt = 0; kt < nk; ++kt) {
    const int buf = DB ? (kt & 1) : 0;
    if (kt + 1 < nk) {
#pragma unroll
      for (int i = 0; i < 4; ++i) { ra[i] = *(const u32x4*)(Ab + (offA + i * stepA + (unsigned)(kt + 1) * 128u)); rb[i] = *(const u32x4*)(Bb + (offB + i * stepB + (unsigned)(kt + 1) * 128u)); }
    }
    __builtin_amdgcn_sched_barrier(0);
    const bf16_t* pa = sA + (buf * 128 + 64 * wm + l31) * 72 + 8 * hh;
    const bf16_t* pb = sB + (buf * 128 + 64 * wn + l31) * 72 + 8 * hh;
    bf16x8 a0 = *(const bf16x8*)(pa), a1 = *(const bf16x8*)(pa + 32 * 72);
    bf16x8 b0 = *(const bf16x8*)(pb), b1 = *(const bf16x8*)(pb + 32 * 72);
#pragma unroll
    for (int ks = 0; ks < 4; ++ks) {
      bf16x8 na0 = a0, na1 = a1, nb0 = b0, nb1 = b1;
      if (ks < 3) {
        na0 = *(const bf16x8*)(pa + (ks + 1) * 16); na1 = *(const bf16x8*)(pa + 32 * 72 + (ks + 1) * 16);
        nb0 = *(const bf16x8*)(pb + (ks + 1) * 16); nb1 = *(const bf16x8*)(pb + 32 * 72 + (ks + 1) * 16);
      }
      __builtin_amdgcn_sched_barrier(0);
      acc[0][0] = MFMA(a0, b0, acc[0][0]);
      acc[0][1] = MFMA(a0, b1, acc[0][1]);
      acc[1][0] = MFMA(a1, b0, acc[1][0]);
      acc[1][1] = MFMA(a1, b1, acc[1][1]);
      __builtin_amdgcn_sched_barrier(0);
      a0 = na0; a1 = na1; b0 = nb0; b1 = nb1;
    }
    if (kt + 1 < nk) {
      const int nb = DB ? (buf ^ 1) : 0;
      if (!DB) __syncthreads();
#pragma unroll
      for (int i = 0; i < 4; ++i) { *(u32x4*)(sA + (nb * 128 + lrow + 32 * i) * 72 + lseg) = ra[i]; *(u32x4*)(sB + (nb * 128 + lrow + 32 * i) * 72 + lseg) = rb[i]; }
    }
    __syncthreads();
  }
}

DI void zero_acc(f32x16 (&acc)[2][2]) {
#pragma unroll
  for (int i = 0; i < 2; ++i)
#pragma unroll
    for (int j = 0; j < 2; ++j)
#pragma unroll
      for (int r = 0; r < 16; ++r) acc[i][j][r] = 0.f;
}

DI void acc_to_lds(const f32x16 (&acc)[2][2], float* sC) {
  const int tid = get_tid(), lane = tid & 63, w = tid >> 6, wm = w >> 1, wn = w & 1, l31 = lane & 31, hh = lane >> 5;
#pragma unroll
  for (int i = 0; i < 2; ++i)
#pragma unroll
    for (int j = 0; j < 2; ++j)
#pragma unroll
      for (int r = 0; r < 16; ++r) {
        int row = 64 * wm + 32 * i + 8 * (r >> 2) + 4 * hh + (r & 3), col = 64 * wn + 32 * j + l31;
        sC[row * 132 + col] = acc[i][j][r];
      }
  __syncthreads();
}

struct TileIter {
  int local, step, total, nN, xcd; bool swz;
  DI void init(int nN_) {
    nN = nN_;
    swz = (gridDim.x & 7) == 0;
    if (swz) { xcd = blockIdx.x & 7; local = blockIdx.x >> 3; step = gridDim.x >> 3; total = 36 * nN; }
    else { xcd = 0; local = blockIdx.x; step = gridDim.x; total = 288 * nN; }
  }
  DI bool next(int& mt, int& nt) {
    if (local >= total) return false;
    if (swz) {
      const int per_sr = 8 * nN;
      const int sr = local / per_sr, r = local - sr * per_sr;
      const int rows = (36 - 8 * sr) < 8 ? (36 - 8 * sr) : 8;
      nt = r / rows; mt = 36 * xcd + 8 * sr + (r - nt * rows);
    } else { mt = local / nN; nt = local - mt * nN; }
    local += step;
    return true;
  }
};

DI void epi_inproj(const Params& p, int l, int mt, int nt, const float* sC) {
  const int tid = get_tid();
  const int chunk = tid & 15, lane = tid & 63;
  const int half = chunk >> 3, d0 = (chunk & 7) * 8;
  const int c0 = nt * 128 + half * 64;
  if (c0 >= NZ && c0 != 5120) return;
  bf16_t* Z = (bf16_t*)(p.ws + WS_Z);
  const float* bias = p.b_in + (size_t)l * NIN + c0;
  if (c0 == 5120) {
    if (chunk >= 2) return;
    const f32x4 b0 = *(const f32x4*)(bias + d0), b1 = *(const f32x4*)(bias + d0 + 4);
#pragma unroll
    for (int it = 0; it < 8; ++it) {
      const int rt = (tid >> 4) + 16 * it, grow = mt * 128 + rt;
      const float* crow = sC + rt * 132 + d0;
      f32x4 v0 = *(const f32x4*)crow + b0, v1 = *(const f32x4*)(crow + 4) + b1;
      if (chunk == 1) {
#pragma unroll
        for (int e = 0; e < 4; ++e) {
          v0[e] = fminf(v0[e], 0.f) - log1pf(__expf(-fabsf(v0[e])));
          v1[e] = fminf(v1[e], 0.f) - log1pf(__expf(-fabsf(v1[e])));
        }
      }
      float* IF = (float*)(p.ws + WS_IF) + (size_t)grow * 16 + d0;
      *(f32x4*)IF = v0; *(f32x4*)(IF + 4) = v1;
    }
    return;
  }
  bool hn = false, rope = false;
  const float* hg = nullptr;
  float scale = 1.f;
  int kvsel = -1, kvh = 0, kvH = 0; size_t kvbase = 0;
  if (c0 < NAK) {}
  else if (c0 < NAV) { kvbase = OUT_NA; kvsel = 0; kvh = (c0 - NAK) >> 6; kvH = 8; }
  else if (c0 < GQ) { kvbase = OUT_NA; kvsel = 1; kvh = (c0 - NAV) >> 6; kvH = 8; }
  else if (c0 < GK) { hn = true; hg = p.gqa_q_g + l * 64; rope = true; }
  else if (c0 < GV) { hn = true; hg = p.gqa_k_g + l * 64; rope = true; kvbase = OUT_GQA; kvsel = 0; kvh = (c0 - GK) >> 6; kvH = 2; }
  else if (c0 < SQ) { kvbase = OUT_GQA; kvsel = 1; kvh = (c0 - GV) >> 6; kvH = 2; }
  else if (c0 < SK) { rope = true; }
  else if (c0 < SV) { rope = true; kvbase = OUT_SWA; kvsel = 0; kvh = (c0 - SK) >> 6; kvH = 2; }
  else if (c0 < MQ) { kvbase = OUT_SWA; kvsel = 1; kvh = (c0 - SV) >> 6; kvH = 2; }
  else if (c0 >= MK && c0 < MV) { scale = 0.08838834764831845f; }
  if (c0 < NAK || (c0 >= GQ && c0 < GK) || (c0 >= SQ && c0 < SK)) scale = 0.125f * LOG2E;
  const bool latent_tile = mt >= 32;
  if (latent_tile) kvsel = -1; else rope = false;
  const int dp = d0 ^ 16;
  const bool second = (d0 & 16) != 0;
  const f32x4 b0 = *(const f32x4*)(bias + d0), b1 = *(const f32x4*)(bias + d0 + 4);
  f32x4 pb0 = b0, pb1 = b1, g0 = {1.f, 1.f, 1.f, 1.f}, g1 = g0, pg0 = g0, pg1 = g0;
  if (rope) { pb0 = *(const f32x4*)(bias + dp); pb1 = *(const f32x4*)(bias + dp + 4); }
  if (hn) {
    g0 = *(const f32x4*)(hg + d0); g1 = *(const f32x4*)(hg + d0 + 4);
    pg0 = *(const f32x4*)(hg + dp); pg1 = *(const f32x4*)(hg + dp + 4);
  }
  const float* rcos = (const float*)(p.ws + WS_ROPE);
  const float* rsin = rcos + 1024;
#pragma unroll 4
  for (int it = 0; it < 8; ++it) {
    const int rt = (tid >> 4) + 16 * it, grow = mt * 128 + rt;
    const float* crow = sC + rt * 132 + half * 64;
    f32x4 x0 = *(const f32x4*)(crow + d0) + b0, x1 = *(const f32x4*)(crow + d0 + 4) + b1;
    float rs = 1.f;
    if (hn) {
      float ss = x0[0] * x0[0] + x0[1] * x0[1] + x0[2] * x0[2] + x0[3] * x0[3] + x1[0] * x1[0] + x1[1] * x1[1] + x1[2] * x1[2] + x1[3] * x1[3];
      ss += shfl_xor_(ss, 1, lane); ss += shfl_xor_(ss, 2, lane); ss += shfl_xor_(ss, 4, lane);
      rs = rsqrtf(ss * (1.f / 64.f) + 1e-6f);
    }
    const float sc = rs * scale;
    x0 = x0 * sc * g0; x1 = x1 * sc * g1;
    if (rope) {
      f32x4 y0 = (*(const f32x4*)(crow + dp) + pb0) * sc * pg0, y1 = (*(const f32x4*)(crow + dp + 4) + pb1) * sc * pg1;
      const int t = (grow - TC) & 4095;
      const int pos = (d0 & 32) ? (t & 63) : (t >> 6);
      const int fj = d0 & 15;
      const f32x4 c0v = *(const f32x4*)(rcos + pos * 16 + fj), c1v = *(const f32x4*)(rcos + pos * 16 + fj + 4);
      const f32x4 s0v = *(const f32x4*)(rsin + pos * 16 + fj), s1v = *(const f32x4*)(rsin + pos * 16 + fj + 4);
      if (second) { x0 = x0 * c0v + y0 * s0v; x1 = x1 * c1v + y1 * s1v; }
      else { x0 = x0 * c0v - y0 * s0v; x1 = x1 * c1v - y1 * s1v; }
    }
    __builtin_nontemporal_store(u32x4{pk2(x0[0], x0[1]), pk2(x0[2], x0[3]), pk2(x1[0], x1[1]), pk2(x1[2], x1[3])}, (u32x4*)(Z + (size_t)grow * ZW + c0 + d0));
    if (kvsel >= 0) {
      const int cb = grow >> 8, cs = grow & 255;
      float* kv = p.out + kvbase + ((((size_t)(cb * 2 + l) * 2 + kvsel) * 256 + cs) * kvH + kvh) * 64 + d0;
      *(f32x4*)kv = x0; *(f32x4*)(kv + 4) = x1;
    }
  }
}

DI void phase_inproj(const Params& p, int l, char* smem) {
  const bf16_t* H = (const bf16_t*)(p.ws + WS_H);
  const bf16_t* W = (const bf16_t*)(p.ws + WS_WIN);
  TileIter ti; ti.init(41);
  for (int mt, nt; ti.next(mt, nt);) {
    f32x16 acc[2][2];
    zero_acc(acc);
    gemm_core(H + (size_t)mt * 128 * DM, DM, W + (size_t)nt * 128 * DM, DM, DM, acc, smem);
    acc_to_lds(acc, (float*)smem);
    epi_inproj(p, l, mt, nt, (const float*)smem);
  }
}

DI void phase_merge(const Params& p, int l, char* smem) {
  const int tid = get_tid(), lane = tid & 63, w = tid >> 6, wn = w & 1, l31 = lane & 31;
  const bf16_t* H = (const bf16_t*)(p.ws + WS_H);
  const bf16_t* W = (const bf16_t*)(p.ws + WS_WIN);
  const bf16_t* WB = (const bf16_t*)(p.ws + WS_WBR);
  bf16_t* Z = (bf16_t*)(p.ws + WS_Z);
  TileIter ti; ti.init(8);
  for (int mt, nt; ti.next(mt, nt);) {
    f32x16 mg[2][2];
    zero_acc(mg);
#pragma unroll 1
    for (int i = 0; i < 4; ++i) {
      f32x16 acc[2][2];
      zero_acc(acc);
      gemm_core<false>(H + (size_t)mt * 128 * DM, DM, W + (size_t)(NZ + i * 1024 + nt * 128) * DM, DM, DM, acc, smem);
      unsigned* sG = (unsigned*)(smem + 36864) + tid;
#pragma unroll
      for (int j = 0; j < 2; ++j) {
        float bj = p.b_in[(size_t)l * NIN + NZ + i * 1024 + nt * 128 + 64 * wn + 32 * j + l31];
#pragma unroll
        for (int ii = 0; ii < 2; ++ii)
#pragma unroll
          for (int r = 0; r < 8; ++r) sG[((ii * 2 + j) * 8 + r) * 256] = pk2(sigmoidf_(acc[ii][j][2 * r] + bj), sigmoidf_(acc[ii][j][2 * r + 1] + bj));
      }
      zero_acc(acc);
      const int colA = i == 0 ? NAQ : (i == 1 ? GQ : (i == 2 ? SQ : MQ));
      gemm_core<false>(Z + (size_t)mt * 128 * ZW + colA, ZW, WB + (size_t)(i * 1024 + nt * 128) * 512, 512, 512, acc, smem);
#pragma unroll
      for (int ii = 0; ii < 2; ++ii)
#pragma unroll
        for (int j = 0; j < 2; ++j)
#pragma unroll
          for (int r = 0; r < 8; ++r) {
            const unsigned gpv = sG[((ii * 2 + j) * 8 + r) * 256];
            mg[ii][j][2 * r] += bflo(gpv) * acc[ii][j][2 * r];
            mg[ii][j][2 * r + 1] += bfhi(gpv) * acc[ii][j][2 * r + 1];
          }
    }
    float* sC = (float*)smem;
    __syncthreads();
    acc_to_lds(mg, sC);
#pragma unroll
    for (int it = 0; it < 8; ++it) {
      const int rt = (tid >> 4) + 16 * it, ch = (tid & 15) * 8;
      const float* crow = sC + rt * 132 + ch;
      f32x4 a = *(const f32x4*)crow, b = *(const f32x4*)(crow + 4);
      __builtin_nontemporal_store(u32x4{pk2(a[0], a[1]), pk2(a[2], a[3]), pk2(b[0], b[1]), pk2(b[2], b[3])}, (u32x4*)(Z + (size_t)(mt * 128 + rt) * ZW + MGC + nt * 128 + ch));
    }
  }
}

DI void phase_resid(const Params& p, int l, int which, char* smem) {
  const int tid = get_tid();
  const bf16_t* Z = (const bf16_t*)(p.ws + WS_Z);
  const bf16_t* W = (const bf16_t*)(p.ws + (which == 0 ? WS_WOUT : WS_WF2));
  const int K = which == 0 ? 1024 : DFF;
  const int acol = which == 0 ? MGC : 0;
  const int goff = which == 0 ? 2048 : 5120;
  const float* mods = (const float*)(p.ws + WS_MODS);
  TileIter ti; ti.init(8);
  for (int mt, nt; ti.next(mt, nt);) {
    f32x16 acc[2][2];
    zero_acc(acc);
    gemm_core(Z + (size_t)mt * 128 * ZW + acol, ZW, W + (size_t)nt * 128 * K, K, K, acc, smem);
    float* sC = (float*)smem;
    acc_to_lds(acc, sC);
    const int n = nt * 128 + (tid & 31) * 4;
    const f32x4 g4 = *(const f32x4*)(mods + (size_t)(l * 9 + cond_of_row(mt * 128)) * 6144 + goff + n);
    const float* xbase = (which == 0 && l == 0) ? (mt < 32 ? p.x_prompt + (size_t)mt * 128 * 1024 : p.x_sample + (size_t)(mt * 128 - TC) * 1024)
                                                : p.out + (size_t)mt * 128 * 1024;
#pragma unroll 4
    for (int it = 0; it < 16; ++it) {
      const int rt = (tid >> 5) + 8 * it, grow = mt * 128 + rt;
      const f32x4 x4 = *(const f32x4*)(xbase + (size_t)rt * 1024 + n);
      const f32x4 c4 = *(const f32x4*)(sC + rt * 132 + (tid & 31) * 4);
      __builtin_nontemporal_store(x4 + g4 * c4, (f32x4*)(p.out + (size_t)grow * 1024 + n));
    }
  }
}

DI void phase_ffn1(const Params& p, int l, char* smem) {
  const int tid = get_tid();
  const bf16_t* H = (const bf16_t*)(p.ws + WS_H);
  const bf16_t* W = (const bf16_t*)(p.ws + WS_WF1);
  bf16_t* Z = (bf16_t*)(p.ws + WS_Z);
  TileIter ti; ti.init(44);
  for (int mt, nt; ti.next(mt, nt);) {
    f32x16 acc[2][2];
    zero_acc(acc);
    gemm_core(H + (size_t)mt * 128 * DM, DM, W + (size_t)nt * 128 * DM, DM, DM, acc, smem);
    float* sC = (float*)smem;
    acc_to_lds(acc, sC);
#pragma unroll
    for (int it = 0; it < 4; ++it) {
      const int rt = (tid >> 3) + 32 * it, ch = (tid & 7) * 8;
      const float* crow = sC + rt * 132 + ch;
      float o[8];
#pragma unroll
      for (int hq = 0; hq < 2; ++hq) {
        f32x4 gt = *(const f32x4*)(crow + 4 * hq), up = *(const f32x4*)(crow + 64 + 4 * hq);
#pragma unroll
        for (int e = 0; e < 4; ++e) o[4 * hq + e] = gt[e] / (1.f + __expf(-gt[e])) * up[e];
      }
      __builtin_nontemporal_store(u32x4{pk2(o[0], o[1]), pk2(o[2], o[3]), pk2(o[4], o[5]), pk2(o[6], o[7])}, (u32x4*)(Z + (size_t)(mt * 128 + rt) * ZW + nt * 64 + ch));
    }
  }
}

struct AttnArgs {
  const void* k1; const void* v1; int stride1; int f32_1; int nblk1;
  const bf16_t* k2; const bf16_t* v2; int blk0_2; int nblk2;
  bf16_t* qo;
  int qpos0;
  int mode;
  float m0, l0;
  const float* rpb;
};

template <int QT>
DI void attn_item(const AttnArgs& a, char* smem) {
  bf16_t* sK = (bf16_t*)smem;
  bf16_t* sVt = sK + 2 * 64 * 72;
  float* sRpb = (float*)(smem + 4 * 64 * 72 * 2);
  const int tid = get_tid(), lane = tid & 63, l31 = lane & 31, hh = lane >> 5;
  const int dg = tid & 7, kp = tid >> 3;
  __syncthreads();
  if (a.mode == 2) for (int i = tid; i < 465; i += 256) sRpb[i] = a.rpb[i] * LOG2E;
  bf16x8 qf[QT][4];
#pragma unroll
  for (int qt = 0; qt < QT; ++qt)
#pragma unroll
    for (int st = 0; st < 4; ++st) qf[qt][st] = *(const bf16x8*)(a.qo + (size_t)(32 * qt + l31) * ZW + 16 * st + 8 * hh);
  f32x16 o[QT][2];
  float m_run[QT], l_run[QT];
#pragma unroll
  for (int qt = 0; qt < QT; ++qt) {
    m_run[qt] = a.m0; l_run[qt] = a.l0;
#pragma unroll
    for (int dt = 0; dt < 2; ++dt)
#pragma unroll
      for (int r = 0; r < 16; ++r) o[qt][dt][r] = 0.f;
  }
  const int nblk = a.nblk1 + a.nblk2;
  u32x4 rk[2], rv[2];
  auto load_blk = [&](int b) {
    if (b < a.nblk1) {
      if (a.f32_1) {
        const float* kb = (const float*)a.k1 + (size_t)(b * 64 + 2 * kp) * a.stride1 + 8 * dg;
        const float* vb = (const float*)a.v1 + (size_t)(b * 64 + 2 * kp) * a.stride1 + 8 * dg;
#pragma unroll
        for (int i = 0; i < 2; ++i) {
          f32x4 k0 = *(const f32x4*)(kb + (size_t)i * a.stride1), k1 = *(const f32x4*)(kb + (size_t)i * a.stride1 + 4);
          f32x4 v0 = *(const f32x4*)(vb + (size_t)i * a.stride1), v1 = *(const f32x4*)(vb + (size_t)i * a.stride1 + 4);
          rk[i] = u32x4{pk2(k0[0], k0[1]), pk2(k0[2], k0[3]), pk2(k1[0], k1[1]), pk2(k1[2], k1[3])};
          rv[i] = u32x4{pk2(v0[0], v0[1]), pk2(v0[2], v0[3]), pk2(v1[0], v1[1]), pk2(v1[2], v1[3])};
        }
      } else {
        const bf16_t* kb = (const bf16_t*)a.k1 + (size_t)(b * 64 + 2 * kp) * a.stride1 + 8 * dg;
        const bf16_t* vb = (const bf16_t*)a.v1 + (size_t)(b * 64 + 2 * kp) * a.stride1 + 8 * dg;
#pragma unroll
        for (int i = 0; i < 2; ++i) { rk[i] = *(const u32x4*)(kb + (size_t)i * a.stride1); rv[i] = *(const u32x4*)(vb + (size_t)i * a.stride1); }
      }
    } else {
      const int kb0 = (a.blk0_2 + (b - a.nblk1)) * 64 + 2 * kp;
      const bf16_t* kb = a.k2 + (size_t)kb0 * ZW + 8 * dg;
      const bf16_t* vb = a.v2 + (size_t)kb0 * ZW + 8 * dg;
#pragma unroll
      for (int i = 0; i < 2; ++i) { rk[i] = *(const u32x4*)(kb + (size_t)i * ZW); rv[i] = *(const u32x4*)(vb + (size_t)i * ZW); }
    }
  };
  auto store_blk = [&](int buf) {
    bf16_t* k = sK + buf * 64 * 72; bf16_t* v = sVt + buf * 64 * 72;
    *(u32x4*)(k + (2 * kp) * 72 + 8 * dg) = rk[0];
    *(u32x4*)(k + (2 * kp + 1) * 72 + 8 * dg) = rk[1];
#pragma unroll
    for (int e = 0; e < 4; ++e) {
      unsigned a0 = rv[0][e], a1 = rv[1][e];
      *(unsigned*)(v + (8 * dg + 2 * e) * 72 + 2 * (kp ^ (4 * dg))) = (a0 & 0xffffu) | (a1 << 16);
      *(unsigned*)(v + (8 * dg + 2 * e + 1) * 72 + 2 * (kp ^ (4 * dg))) = (a0 >> 16) | (a1 & 0xffff0000u);
    }
  };
  load_blk(0);
  store_blk(0);
  if (nblk > 1) load_blk(1);
  __syncthreads();
  for (int b = 0; b < nblk; ++b) {
    const bf16_t* cK = sK + (b & 1) * 64 * 72;
    const bf16_t* cV = sVt + (b & 1) * 64 * 72;
    f32x16 s[QT][2];
#pragma unroll
    for (int qt = 0; qt < QT; ++qt)
#pragma unroll
      for (int kt = 0; kt < 2; ++kt)
#pragma unroll
        for (int r = 0; r < 16; ++r) s[qt][kt][r] = 0.f;
#pragma unroll
    for (int st = 0; st < 4; ++st) {
      bf16x8 k0 = *(const bf16x8*)(cK + l31 * 72 + 16 * st + 8 * hh);
      bf16x8 k1 = *(const bf16x8*)(cK + (32 + l31) * 72 + 16 * st + 8 * hh);
#pragma unroll
      for (int qt = 0; qt < QT; ++qt) {
        s[qt][0] = MFMA(k0, qf[qt][st], s[qt][0]);
        s[qt][1] = MFMA(k1, qf[qt][st], s[qt][1]);
      }
    }
    const bool seg2 = b >= a.nblk1;
#pragma unroll
    for (int qt = 0; qt < QT; ++qt) {
      if (seg2 && a.mode == 1) {
        const int kbase = (a.blk0_2 + (b - a.nblk1)) * 64;
        const int qpos = a.qpos0 + 32 * qt + l31;
#pragma unroll
        for (int kt = 0; kt < 2; ++kt)
#pragma unroll
          for (int r = 0; r < 16; ++r) {
            int kpos = kbase + 32 * kt + 8 * (r >> 2) + 4 * hh + (r & 3);
            int dd = qpos - kpos; dd = dd < 0 ? -dd : dd;
            s[qt][kt][r] = dd <= 128 ? s[qt][kt][r] : -INFINITY;
          }
      } else if (seg2 && a.mode == 2) {
        const int kr = a.blk0_2 + (b - a.nblk1);
        const int qpos = a.qpos0 + 32 * qt + l31;
        const int qr = qpos >> 6, qc = qpos & 63;
        int rs = qr - 4; rs = rs < 0 ? 0 : (rs > 56 ? 56 : rs);
        int cs = qc - 8; cs = cs < 0 ? 0 : (cs > 48 ? 48 : cs);
        const bool rowok = kr >= rs && kr <= rs + 7;
        const int bbase = (kr - qr + 7) * 31 - qc + 15;
#pragma unroll
        for (int kt = 0; kt < 2; ++kt)
#pragma unroll
          for (int r = 0; r < 16; ++r) {
            int kc = 32 * kt + 8 * (r >> 2) + 4 * hh + (r & 3);
            bool ok = rowok && (unsigned)(kc - cs) < 16u;
            const float bias = sRpb[ok ? bbase + kc : 0];
            s[qt][kt][r] = ok ? s[qt][kt][r] + bias : -INFINITY;
          }
      }
      float mx = -INFINITY;
#pragma unroll
      for (int kt = 0; kt < 2; ++kt)
#pragma unroll
        for (int r = 0; r < 16; ++r) mx = fmaxf(mx, s[qt][kt][r]);
      mx = fmaxf(mx, shfl_xor_(mx, 32, lane));
      const float m_new = fmaxf(m_run[qt], mx);
      if (__builtin_amdgcn_ballot_w64(m_new > m_run[qt]) != 0ull) {
        const float alpha = __builtin_amdgcn_exp2f(m_run[qt] - m_new);
        l_run[qt] *= alpha;
#pragma unroll
        for (int dt = 0; dt < 2; ++dt)
#pragma unroll
          for (int r = 0; r < 16; ++r) o[qt][dt][r] *= alpha;
        m_run[qt] = m_new;
      }
      float ps = 0.f;
#pragma unroll
      for (int kt = 0; kt < 2; ++kt)
#pragma unroll
        for (int r = 0; r < 16; ++r) { float e = __builtin_amdgcn_exp2f(s[qt][kt][r] - m_run[qt]); s[qt][kt][r] = e; ps += e; }
      ps += shfl_xor_(ps, 32, lane);
      l_run[qt] += ps;
    }
#pragma unroll
    for (int kt = 0; kt < 2; ++kt)
#pragma unroll
      for (int s2 = 0; s2 < 2; ++s2) {
        u32x4 pb[QT];
#pragma unroll
        for (int qt = 0; qt < QT; ++qt)
          pb[qt] = u32x4{pk2(s[qt][kt][8 * s2 + 0], s[qt][kt][8 * s2 + 1]), pk2(s[qt][kt][8 * s2 + 2], s[qt][kt][8 * s2 + 3]),
                         pk2(s[qt][kt][8 * s2 + 4], s[qt][kt][8 * s2 + 5]), pk2(s[qt][kt][8 * s2 + 6], s[qt][kt][8 * s2 + 7])};
#pragma unroll
        for (int dt = 0; dt < 2; ++dt) {
          const int rg = (4 * dt + (l31 >> 3)) & 7;
          const bf16_t* vrow = cV + (32 * dt + l31) * 72 + 4 * hh;
          u32x2 lo = *(const u32x2*)(vrow + 8 * ((4 * kt + 2 * s2) ^ rg)), hi = *(const u32x2*)(vrow + 8 * ((4 * kt + 2 * s2 + 1) ^ rg));
          const bf16x8 vfr = as_bf8(u32x4{lo[0], lo[1], hi[0], hi[1]});
#pragma unroll
          for (int qt = 0; qt < QT; ++qt) o[qt][dt] = MFMA(vfr, as_bf8(pb[qt]), o[qt][dt]);
        }
      }
    if (b + 1 < nblk) store_blk((b + 1) & 1);
    if (b + 2 < nblk) load_blk(b + 2);
    __builtin_amdgcn_sched_barrier(0);
    __syncthreads();
  }
#pragma unroll
  for (int qt = 0; qt < QT; ++qt) {
    const float inv = 1.f / l_run[qt];
#pragma unroll
    for (int dt = 0; dt < 2; ++dt)
#pragma unroll
      for (int g = 0; g < 4; ++g) {
        *(u32x2*)(a.qo + (size_t)(32 * qt + l31) * ZW + 32 * dt + 8 * g + 4 * hh) =
            u32x2{pk2(o[qt][dt][4 * g] * inv, o[qt][dt][4 * g + 1] * inv), pk2(o[qt][dt][4 * g + 2] * inv, o[qt][dt][4 * g + 3] * inv)};
      }
  }
}

DI float wave_scan_sum(float v, int lane) {
#pragma unroll
  for (int o = 1; o < 64; o <<= 1) { float t = shfl_up_(v, o, lane); if (lane >= o) v += t; }
  return v;
}
DI float wave_scan_max(float v, int lane) {
#pragma unroll
  for (int o = 1; o < 64; o <<= 1) { float t = shfl_up_(v, o, lane); if (lane >= o) v = fmaxf(v, t); }
  return v;
}

#define RLX_AGENT __ATOMIC_RELAXED, __HIP_MEMORY_SCOPE_AGENT
DI void mlstm_item(const Params& p, char* smem, int l, int b, int h, int eh, int dir, bool latent, int* prog_self, int* prog_partner) {
  bf16_t* sQ = (bf16_t*)smem;
  bf16_t* sK = sQ + 64 * 136;
  bf16_t* sKw = sK + 64 * 136;
  bf16_t* sVt = sKw + 128 * 72;
  float* sN = (float*)(sVt + 64 * 72);
  float* sA = sN + 128;
  const int tid = get_tid();
  const int S = latent ? 4096 : 256, nc = S >> 6, half = nc >> 1;
  const int rowbase = latent ? TC + b * 4096 : b * 256;
  bf16_t* Z = (bf16_t*)(p.ws + WS_Z);
  bf16_t* HB = (bf16_t*)(p.ws + WS_HB);
  const float* IF = (const float*)(p.ws + WS_IF);
  f32x16 C[4];
  float m_state = 0.f;
  __syncthreads();
  {
    const int lane = tid & 63, w = tid >> 6, l31 = lane & 31, hh = lane >> 5, et = w & 1;
    if (latent) {
      const size_t sidx = (size_t)((b * 2 + l) * 2 + dir) * 4 + h;
      const float* C0 = p.st_C + sidx * 128 * 128;
      int cidx0 = 4 * hh * 128 + 64 * eh + 32 * et + l31; asm volatile("" : "+v"(cidx0));
#pragma unroll
      for (int dt = 0; dt < 4; ++dt) {
#pragma unroll
        for (int r = 0; r < 16; ++r) C[dt][r] = C0[(unsigned)(cidx0 + (32 * dt + 8 * (r >> 2) + (r & 3)) * 128)];
        __builtin_amdgcn_sched_barrier(0);
      }
      if (tid < 128) sN[tid] = p.st_n[sidx * 128 + tid];
      m_state = p.st_m[sidx];
    } else {
#pragma unroll
      for (int dt = 0; dt < 4; ++dt)
#pragma unroll
        for (int r = 0; r < 16; ++r) C[dt][r] = 0.f;
      if (tid < 128) sN[tid] = 0.f;
    }
  }
  float ip_n, lf_n;
  u32x4 rq[4], rkk[4], rvv[2];
  auto prefetch = [&](int c) {
    const int cbase = rowbase + (dir ? (nc - 1 - c) * 64 : c * 64);
    int tidc = tid; asm volatile("" : "+v"(tidc));
    const int lane = tidc & 63;
    const int tokp = cbase + (dir ? 63 - lane : lane);
    ip_n = IF[(size_t)tokp * 16 + dir * 4 + h];
    lf_n = IF[(size_t)tokp * 16 + 8 + dir * 4 + h];
#pragma unroll
    for (int i = 0; i < 4; ++i) {
      int id = tidc + 256 * i, pr = id >> 4, seg = (id & 15) * 8;
      int tok = cbase + (dir ? 63 - pr : pr);
      rq[i] = *(const u32x4*)(Z + (size_t)tok * ZW + MQ + h * 128 + seg);
    }
    const int dgp = (tidc & 15) * 8;
#pragma unroll
    for (int i = 0; i < 2; ++i) {
      const int s0 = 2 * ((tidc >> 4) + 16 * i), s1 = s0 + 1;
      const int t0 = cbase + (dir ? 63 - s0 : s0), t1 = cbase + (dir ? 63 - s1 : s1);
      rkk[2 * i] = *(const u32x4*)(Z + (size_t)t0 * ZW + MK + h * 128 + dgp);
      rkk[2 * i + 1] = *(const u32x4*)(Z + (size_t)t1 * ZW + MK + h * 128 + dgp);
    }
    {
      const int dgv = (tidc & 7) * 8, s0 = 2 * (tidc >> 3), s1 = s0 + 1;
      const int t0 = cbase + (dir ? 63 - s0 : s0), t1 = cbase + (dir ? 63 - s1 : s1);
      rvv[0] = *(const u32x4*)(Z + (size_t)t0 * ZW + MV + h * 128 + 64 * eh + dgv);
      rvv[1] = *(const u32x4*)(Z + (size_t)t1 * ZW + MV + h * 128 + 64 * eh + dgv);
    }
  };
  prefetch(0);
#pragma unroll 1
  for (int c = 0; c < nc; ++c) {
    const int cbase = rowbase + (dir ? (nc - 1 - c) * 64 : c * 64);
    int tidc = tid; asm volatile("" : "+v"(tidc));
    const int lane = tidc & 63, w = tidc >> 6, l31 = lane & 31, hh = lane >> 5, et = w & 1, tt = w >> 1;
    const float ip = ip_n, lf = lf_n;
    const float bcum = wave_scan_sum(lf, lane);
    const float av = ip - bcum;
    const float pm = wave_scan_max(av, lane);
    const float Mv = fmaxf(m_state, pm);
    const float Mlast = shfl_(Mv, 63), blast = shfl_(bcum, 63);
    const float wsv = __expf(av - Mlast);
    const float decay = __expf(m_state - Mlast);
    __syncthreads();
#pragma unroll
    for (int i = 0; i < 4; ++i) {
      int id = tidc + 256 * i, pr = id >> 4, seg = (id & 15) * 8;
      *(u32x4*)(sQ + pr * 136 + seg) = rq[i];
    }
    {
      const int dgp = (tidc & 15) * 8;
#pragma unroll
      for (int i = 0; i < 2; ++i) {
        const int s0 = 2 * ((tidc >> 4) + 16 * i), s1 = s0 + 1;
        const u32x4 k0 = rkk[2 * i], k1 = rkk[2 * i + 1];
        *(u32x4*)(sK + s0 * 136 + dgp) = k0;
        *(u32x4*)(sK + s1 * 136 + dgp) = k1;
        const float w0 = shfl_(wsv, s0), w1 = shfl_(wsv, s1);
#pragma unroll
        for (int e = 0; e < 4; ++e) {
          const int sw = 2 * ((s0 >> 1) ^ (4 * ((tidc & 15) & 7)));
          *(unsigned*)(sKw + (dgp + 2 * e) * 72 + sw) = pk2(bflo(k0[e]) * w0, bflo(k1[e]) * w1);
          *(unsigned*)(sKw + (dgp + 2 * e + 1) * 72 + sw) = pk2(bfhi(k0[e]) * w0, bfhi(k1[e]) * w1);
        }
      }
      const int dgv = (tidc & 7) * 8, sv0 = 2 * (tidc >> 3);
#pragma unroll
      for (int e = 0; e < 4; ++e) {
        const int svw = 2 * ((sv0 >> 1) ^ (4 * (tidc & 7)));
        *(unsigned*)(sVt + (dgv + 2 * e) * 72 + svw) = (rvv[0][e] & 0xffffu) | (rvv[1][e] << 16);
        *(unsigned*)(sVt + (dgv + 2 * e + 1) * 72 + svw) = (rvv[0][e] >> 16) | (rvv[1][e] & 0xffff0000u);
      }
    }
    if (w == 0) sA[lane] = av;
    __syncthreads();
    if (c + 1 < nc) prefetch(c + 1);
    __builtin_amdgcn_sched_barrier(0);
    const int t = 32 * tt + l31;
    const int tok = cbase + (dir ? 63 - t : t);
    const bool finisher = c >= half;
    u32x2 og[4];
    if (finisher) {
#pragma unroll
      for (int g = 0; g < 4; ++g) og[g] = *(const u32x2*)(Z + (size_t)tok * ZW + MO + h * 128 + 64 * eh + 32 * et + 8 * g + 4 * hh);
    }
    float inv;
    f32x16 acc;
    {
      const float Mt = shfl_(Mv, t), bt = shfl_(bcum, t);
      const float winter = __expf(m_state - Mt);
#pragma unroll
      for (int r = 0; r < 16; ++r) acc[r] = 0.f;
#pragma unroll
      for (int dt = 0; dt < 4; ++dt)
#pragma unroll
        for (int s2 = 0; s2 < 2; ++s2) {
          u32x4 ca = {pk2(C[dt][8 * s2 + 0], C[dt][8 * s2 + 1]), pk2(C[dt][8 * s2 + 2], C[dt][8 * s2 + 3]),
                      pk2(C[dt][8 * s2 + 4], C[dt][8 * s2 + 5]), pk2(C[dt][8 * s2 + 6], C[dt][8 * s2 + 7])};
          const bf16_t* qp = sQ + t * 136 + 32 * dt + 16 * s2 + 4 * hh;
          u32x2 lo = *(const u32x2*)qp, hi = *(const u32x2*)(qp + 8);
          acc = MFMA(as_bf8(ca), as_bf8(u32x4{lo[0], lo[1], hi[0], hi[1]}), acc);
        }
#pragma unroll
      for (int r = 0; r < 16; ++r) acc[r] *= winter;
      float qv = 0.f;
#pragma unroll
      for (int j = 0; j < 8; ++j) {
        u32x4 q8 = *(const u32x4*)(sQ + t * 136 + 64 * hh + 8 * j);
        f32x4 n0 = *(const f32x4*)(sN + 64 * hh + 8 * j), n1 = *(const f32x4*)(sN + 64 * hh + 8 * j + 4);
        qv += bflo(q8[0]) * n0[0] + bfhi(q8[0]) * n0[1] + bflo(q8[1]) * n0[2] + bfhi(q8[1]) * n0[3] +
              bflo(q8[2]) * n1[0] + bfhi(q8[2]) * n1[1] + bflo(q8[3]) * n1[2] + bfhi(q8[3]) * n1[3];
      }
      qv += shfl_xor_(qv, 32, lane);
      float rsv = 0.f;
#pragma unroll
      for (int st = 0; st < 2; ++st) {
        f32x16 sm;
#pragma unroll
        for (int r = 0; r < 16; ++r) sm[r] = 0.f;
#pragma unroll
        for (int ks = 0; ks < 8; ++ks) {
          bf16x8 ka = *(const bf16x8*)(sK + (32 * st + l31) * 136 + 16 * ks + 8 * hh);
          bf16x8 qb = *(const bf16x8*)(sQ + t * 136 + 16 * ks + 8 * hh);
          sm = MFMA(ka, qb, sm);
        }
#pragma unroll
        for (int g = 0; g < 4; ++g) {
          f32x4 a4 = *(const f32x4*)(sA + 32 * st + 8 * g + 4 * hh);
#pragma unroll
          for (int e = 0; e < 4; ++e) {
            const int s = 32 * st + 8 * g + 4 * hh + e;
            float wgt = s <= t ? __expf(a4[e] - Mt) : 0.f;
            float v = sm[4 * g + e] * wgt;
            sm[4 * g + e] = v;
            rsv += v;
          }
        }
#pragma unroll
        for (int s2 = 0; s2 < 2; ++s2) {
          const int rgv = (4 * et + (l31 >> 3)) & 7;
          const bf16_t* vrow = sVt + (32 * et + l31) * 72 + 4 * hh;
          u32x2 lo = *(const u32x2*)(vrow + 8 * ((4 * st + 2 * s2) ^ rgv)), hi = *(const u32x2*)(vrow + 8 * ((4 * st + 2 * s2 + 1) ^ rgv));
          u32x4 pb = {pk2(sm[8 * s2 + 0], sm[8 * s2 + 1]), pk2(sm[8 * s2 + 2], sm[8 * s2 + 3]),
                      pk2(sm[8 * s2 + 4], sm[8 * s2 + 5]), pk2(sm[8 * s2 + 6], sm[8 * s2 + 7])};
          acc = MFMA(as_bf8(u32x4{lo[0], lo[1], hi[0], hi[1]}), as_bf8(pb), acc);
        }
      }
      rsv += shfl_xor_(rsv, 32, lane);
      const float den = winter * qv + rsv;
      inv = 1.f / fmaxf(fabsf(den), __expf(-(bt + Mt)));
    }
#pragma unroll
    for (int dt = 0; dt < 4; ++dt) {
#pragma unroll
      for (int r = 0; r < 16; ++r) C[dt][r] *= decay;
#pragma unroll
      for (int ks = 0; ks < 4; ++ks) {
        bf16x8 ka = *(const bf16x8*)(sKw + (32 * dt + l31) * 72 + 8 * ((2 * ks + hh) ^ ((4 * dt + (l31 >> 3)) & 7)));
        bf16x8 vb = *(const bf16x8*)(sVt + (32 * et + l31) * 72 + 8 * ((2 * ks + hh) ^ ((4 * et + (l31 >> 3)) & 7)));
        C[dt] = MFMA(ka, vb, C[dt]);
      }
    }
    {
      unsigned long long* hbp = (unsigned long long*)(HB + (size_t)tok * 512 + h * 128 + 64 * eh + 32 * et + 4 * hh);
      if (!finisher) {
#pragma unroll
        for (int g = 0; g < 4; ++g) {
          const unsigned lo = pk2(acc[4 * g] * inv, acc[4 * g + 1] * inv), hi = pk2(acc[4 * g + 2] * inv, acc[4 * g + 3] * inv);
          __hip_atomic_store(hbp + 2 * g, ((unsigned long long)hi << 32) | lo, RLX_AGENT);
        }
        asm volatile("s_waitcnt vmcnt(0)" ::: "memory");
      } else {
        const int need = nc - c;
        unsigned spins = 0;
        while (__builtin_amdgcn_readfirstlane(__hip_atomic_load(prog_partner, RLX_AGENT)) < need) {
          __builtin_amdgcn_s_sleep(1);
          if (++spins > (1u << 24)) break;
        }
        asm volatile("" ::: "memory");
#pragma unroll
        for (int g = 0; g < 4; ++g) {
          const unsigned long long hb = __hip_atomic_load(hbp + 2 * g, RLX_AGENT);
          const unsigned hlo = (unsigned)hb, hhi = (unsigned)(hb >> 32);
          const float y0 = (acc[4 * g] * inv + bflo(hlo)) * sigmoidf_(bflo(og[g][0]));
          const float y1 = (acc[4 * g + 1] * inv + bfhi(hlo)) * sigmoidf_(bfhi(og[g][0]));
          const float y2 = (acc[4 * g + 2] * inv + bflo(hhi)) * sigmoidf_(bflo(og[g][1]));
          const float y3 = (acc[4 * g + 3] * inv + bfhi(hhi)) * sigmoidf_(bfhi(og[g][1]));
          hbp[2 * g] = ((unsigned long long)pk2(y2, y3) << 32) | pk2(y0, y1);
        }
      }
    }
    __syncthreads();
    if (!finisher && tidc == 0) __hip_atomic_store(prog_self, c + 1, RLX_AGENT);
    if (tidc < 128) {
      float sum = 0.f;
#pragma unroll
      for (int j = 0; j < 8; ++j) {
        u32x4 k8 = *(const u32x4*)(sKw + tidc * 72 + 8 * j);
        sum += bflo(k8[0]) + bfhi(k8[0]) + bflo(k8[1]) + bfhi(k8[1]) + bflo(k8[2]) + bfhi(k8[2]) + bflo(k8[3]) + bfhi(k8[3]);
      }
      sN[tidc] = decay * sN[tidc] + sum;
    }
    m_state = blast + Mlast;
  }
  if (!latent) {
    const int lane = tid & 63, w = tid >> 6, l31 = lane & 31, hh = lane >> 5, et = w & 1, tt = w >> 1;
    const size_t sidx = (size_t)((b * 2 + l) * 2 + dir) * 4 + h;
    float* Co = p.out + OUT_C + sidx * 128 * 128;
    if (tt == 0) {
      int cidx1 = 4 * hh * 128 + 64 * eh + 32 * et + l31; asm volatile("" : "+v"(cidx1));
#pragma unroll
      for (int dt = 0; dt < 4; ++dt) {
#pragma unroll
        for (int r = 0; r < 16; ++r) Co[(unsigned)(cidx1 + (32 * dt + 8 * (r >> 2) + (r & 3)) * 128)] = C[dt][r];
        __builtin_amdgcn_sched_barrier(0);
      }
    }
    __syncthreads();
    if (eh == 0) {
      if (tid < 128) p.out[OUT_N + sidx * 128 + tid] = sN[tid];
      if (tid == 0) p.out[OUT_M + sidx] = m_state;
    }
  }
}

DI void mlstm_norm_phase(const Params& p, int l) {
  const int tid = get_tid(), lane = tid & 63, w = tid >> 6;
  const bf16_t* HB = (const bf16_t*)(p.ws + WS_HB);
  bf16_t* Z = (bf16_t*)(p.ws + WS_Z);
  const float* g = p.ml_g + l * 512 + lane * 8;
  const f32x4 g0 = *(const f32x4*)g, g1 = *(const f32x4*)(g + 4);
  for (int row = blockIdx.x * 4 + w; row < TT; row += gridDim.x * 4) {
    u32x4 y = *(const u32x4*)(HB + (size_t)row * 512 + lane * 8);
    float v[8] = {bflo(y[0]), bfhi(y[0]), bflo(y[1]), bfhi(y[1]), bflo(y[2]), bfhi(y[2]), bflo(y[3]), bfhi(y[3])};
    float ss = 0.f;
#pragma unroll
    for (int e = 0; e < 8; ++e) ss += v[e] * v[e];
#pragma unroll
    for (int o = 8; o >= 1; o >>= 1) ss += shfl_xor_(ss, o, lane);
    const float rstd = rsqrtf(ss * (1.f / 128.f) + 1e-6f);
    *(u32x4*)(Z + (size_t)row * ZW + MQ + lane * 8) =
        u32x4{pk2(v[0] * rstd * g0[0], v[1] * rstd * g0[1]), pk2(v[2] * rstd * g0[2], v[3] * rstd * g0[3]),
              pk2(v[4] * rstd * g1[0], v[5] * rstd * g1[1]), pk2(v[6] * rstd * g1[2], v[7] * rstd * g1[3])};
  }
}

constexpr int MIX_ITEMS = 4224;
DI void phase_mixers(const Params& p, int l, char* smem) {
  __shared__ int s_item;
  const int tid = get_tid();
  int* cnt = (int*)(p.ws + WS_CNT) + l;
  auto draw = [&]() -> int {
    __syncthreads();
    if (tid == 0) s_item = atomicAdd(cnt, 1);
    __syncthreads();
    return __builtin_amdgcn_readfirstlane(s_item);
  };
  int item = draw();
  while (item < 384) {
    const bool lat = item < 128;
    const int j = lat ? item : item - 128;
    int* prog = (int*)(p.ws + WS_CNT) + 16 + l * 384;
    mlstm_item(p, smem, l, j >> 4, (j >> 2) & 3, (j >> 1) & 1, j & 1, lat, prog + item, prog + (item ^ 1));
    item = draw();
  }
#ifndef NO_ATTN
  const int w = __builtin_amdgcn_readfirstlane(get_tid() >> 6);
  bf16_t* Z = (bf16_t*)(p.ws + WS_Z);
  for (; item < MIX_ITEMS; item = draw()) {
    AttnArgs a;
    a.k2 = nullptr; a.v2 = nullptr; a.blk0_2 = 0; a.nblk2 = 0; a.mode = 0; a.m0 = -INFINITY; a.l0 = 0.f; a.rpb = nullptr; a.qpos0 = 0;
    a.nblk1 = 4;
    if (item < 1408) {
      int j = item - 384, qt = j & 63, kv = (j >> 6) & 1, b = j >> 7;
      const float* cb = p.cache_gqa + (size_t)((b * 2 + l) * 2) * 256 * 128 + kv * 64;
      a.k1 = cb; a.v1 = cb + 256 * 128; a.stride1 = 128; a.f32_1 = 1;
      bf16_t* zb = Z + (size_t)(TC + b * 4096) * ZW;
      a.k2 = zb + GK + kv * 64; a.v2 = zb + GV + kv * 64; a.blk0_2 = 0; a.nblk2 = 64;
      a.qo = zb + (size_t)(qt * 64) * ZW + GQ + (kv * 4 + w) * 64;
      attn_item<2>(a, smem);
      continue;
    } else if (item < 2432) {
      int j = item - 1408, qt = j & 63, kv = (j >> 6) & 1, b = j >> 7;
      const float* cb = p.cache_swa + (size_t)((b * 2 + l) * 2) * 256 * 128 + kv * 64;
      a.k1 = cb; a.v1 = cb + 256 * 128; a.stride1 = 128; a.f32_1 = 1;
      bf16_t* zb = Z + (size_t)(TC + b * 4096) * ZW;
      a.k2 = zb + SK + kv * 64; a.v2 = zb + SV + kv * 64;
      const int q0 = qt * 64;
      int lo = q0 - 128; lo = lo < 0 ? 0 : lo;
      int hi = q0 + 63 + 128; hi = hi > 4095 ? 4095 : hi;
      a.blk0_2 = lo >> 6; a.nblk2 = (hi >> 6) - (lo >> 6) + 1;
      a.qo = zb + (size_t)q0 * ZW + SQ + (kv * 4 + w) * 64;
      a.qpos0 = q0; a.mode = 1;
      a.m0 = p.swa_sink[l * 8 + kv * 4 + w] * LOG2E; a.l0 = 1.f;
      attn_item<2>(a, smem);
      continue;
    } else if (item < 3456) {
      int j = item - 2432, rq = j & 15, h = (j >> 4) & 7, b = j >> 7;
      const float* cb = p.cache_na + (size_t)((b * 2 + l) * 2) * 256 * 512 + h * 64;
      a.k1 = cb; a.v1 = cb + 256 * 512; a.stride1 = 512; a.f32_1 = 1;
      bf16_t* zb = Z + (size_t)(TC + b * 4096) * ZW;
      a.k2 = zb + NAK + h * 64; a.v2 = zb + NAV + h * 64;
      int r0 = 4 * rq, r1 = r0 + 3;
      int rs0 = r0 - 4; rs0 = rs0 < 0 ? 0 : (rs0 > 56 ? 56 : rs0);
      int rs1 = r1 - 4; rs1 = rs1 < 0 ? 0 : (rs1 > 56 ? 56 : rs1);
      a.blk0_2 = rs0; a.nblk2 = rs1 + 8 - rs0;
      const int q0 = (r0 + w) * 64;
      a.qo = zb + (size_t)q0 * ZW + NAQ + h * 64;
      a.qpos0 = q0; a.mode = 2; a.rpb = p.na_rpb + (size_t)(l * 8 + h) * 465;
      attn_item<2>(a, smem);
      continue;
    } else if (item < 3712) {
      int j = item - 3456, qtile = j & 1, h = (j >> 1) & 7, b = j >> 4;
      bf16_t* zb = Z + (size_t)(b * 256) * ZW;
      a.k1 = zb + NAK + h * 64; a.v1 = zb + NAV + h * 64; a.stride1 = ZW; a.f32_1 = 0;
      a.qo = zb + (size_t)(qtile * 128 + 32 * w) * ZW + NAQ + h * 64;
    } else if (item < 3968) {
      int j = item - 3712, qt = j & 7, kv = (j >> 3) & 1, b = j >> 4;
      bf16_t* zb = Z + (size_t)(b * 256) * ZW;
      a.k1 = zb + GK + kv * 64; a.v1 = zb + GV + kv * 64; a.stride1 = ZW; a.f32_1 = 0;
      a.qo = zb + (size_t)(qt * 32) * ZW + GQ + (kv * 4 + w) * 64;
    } else {
      int j = item - 3968, qt = j & 7, kv = (j >> 3) & 1, b = j >> 4;
      bf16_t* zb = Z + (size_t)(b * 256) * ZW;
      a.k1 = zb + SK + kv * 64; a.v1 = zb + SV + kv * 64; a.stride1 = ZW; a.f32_1 = 0;
      a.qo = zb + (size_t)(qt * 32) * ZW + SQ + (kv * 4 + w) * 64;
      a.m0 = p.swa_sink[l * 8 + kv * 4 + w] * LOG2E; a.l0 = 1.f;
    }
    attn_item<1>(a, smem);
  }
#endif
}

#define XB_TMO      128
#define XB_XCNT(j)  (256  + 64 * (j))
#define XB_XSUB(j)  (1280 + 64 * (j))
#define XB_XGEN(j)  (2304 + 64 * (j))
#define XB_TOP      3328
#define XB_TOPGEN   3392
#define XCD_BAR_WORDS 3456
#define XB_SPIN_CAP (1u << 18)
#define LAS __attribute__((address_space(3)))
DI unsigned xb_ld(unsigned* p) { return __hip_atomic_load(p, __ATOMIC_RELAXED, __HIP_MEMORY_SCOPE_AGENT); }
DI unsigned xb_add(unsigned* p, unsigned v) { return __hip_atomic_fetch_add(p, v, __ATOMIC_RELAXED, __HIP_MEMORY_SCOPE_AGENT); }
DI unsigned xb_xcc_id() { return (unsigned)__builtin_amdgcn_s_getreg((3 << 11) | 20) & 0xFu; }
#define XB_SPIN(cond, bar) do { unsigned _sp = 0; while (cond) { __builtin_amdgcn_s_sleep(1); \
    if ((++_sp & 255u) == 0u) { if (xb_ld(&(bar)[XB_TMO])) break; if (_sp > XB_SPIN_CAP) { atomicAdd(&(bar)[XB_TMO], 1u); break; } } } } while (0)
struct XcdBarrier { unsigned* bar; unsigned x; volatile LAS unsigned* st; };
DI XcdBarrier xcd_barrier_post(unsigned* bar, volatile LAS unsigned* st) {
  XcdBarrier b; b.bar = bar; b.x = xb_xcc_id(); b.st = st;
  if (threadIdx.x == 0) (void)xb_add(&bar[XB_XCNT(b.x)], 1u);
  return b;
}
DI void xcd_barrier_complete(unsigned* bar, unsigned x, unsigned& nloc, unsigned& nx) {
  const unsigned G = gridDim.x * gridDim.y * gridDim.z;
  unsigned sum, cnt, mine, sp = 0u;
  for (;;) {
    sum = 0u; cnt = 0u; mine = 0u;
#pragma unroll
    for (unsigned j = 0; j < 16; ++j) { const unsigned c = xb_ld(&bar[XB_XCNT(j)]); sum += c; cnt += (c > 0u) ? 1u : 0u; mine = (j == x) ? c : mine; }
    if (sum == G) break;
    __builtin_amdgcn_s_sleep(1);
    if ((++sp & 255u) == 0u) { if (xb_ld(&bar[XB_TMO])) break; if (sp > XB_SPIN_CAP) { atomicAdd(&bar[XB_TMO], 1u); break; } }
  }
  nloc = mine > 0u ? mine : 1u; nx = cnt > 0u ? cnt : 1u;
}
DI void xcd_barrier(const XcdBarrier& b) {
  asm volatile("s_waitcnt vmcnt(0)" ::: "memory");
  __syncthreads();
  if (threadIdx.x == 0) {
    unsigned* bar = b.bar;
    __builtin_amdgcn_s_waitcnt(0);
    unsigned nloc = b.st[0], nx = b.st[1];
    if (nloc == 0u) { xcd_barrier_complete(bar, b.x, nloc, nx); b.st[0] = nloc; b.st[1] = nx; }
    const unsigned old = xb_add(&bar[XB_XSUB(b.x)], 1u);
    const unsigned gen = old / nloc;
    if (old + 1u == (gen + 1u) * nloc) {
      __builtin_amdgcn_fence(__ATOMIC_RELEASE, "agent");
      asm volatile("s_waitcnt vmcnt(0)" ::: "memory");
      const unsigned og = xb_add(&bar[XB_TOP], 1u);
      const unsigned tg = og / nx;
      if (og + 1u == (tg + 1u) * nx) xb_add(&bar[XB_TOPGEN], 1u);
      else XB_SPIN(xb_ld(&bar[XB_TOPGEN]) == tg, bar);
      __builtin_amdgcn_fence(__ATOMIC_ACQUIRE, "agent");
      xb_add(&bar[XB_XGEN(b.x)], 1u);
      asm volatile("s_waitcnt vmcnt(0)" ::: "memory");
    } else {
      XB_SPIN(xb_ld(&bar[XB_XGEN(b.x)]) == gen, bar);
      __builtin_amdgcn_fence(__ATOMIC_ACQUIRE, "agent");
      asm volatile("s_waitcnt vmcnt(0)" ::: "memory");
    }
  }
  __syncthreads();
}

constexpr int N_PHASES = 20;
DI void run_phase(const Params& p, int ph, char* smem) {
  if (ph == 0) { phase0(p, smem); return; }
  if (ph == 19) { norm_phase(p, 0, 2); return; }
  const int l = (ph - 1) / 9, s = (ph - 1) % 9;
  switch (s) {
    case 0: convert_weights(p, l, smem); norm_phase(p, l, 0); break;
    case 1: phase_inproj(p, l, smem); break;
    case 2: phase_mixers(p, l, smem); break;
    case 3: mlstm_norm_phase(p, l); break;
    case 4: phase_merge(p, l, smem); break;
    case 5: phase_resid(p, l, 0, smem); break;
    case 6: norm_phase(p, l, 1); break;
    case 7: phase_ffn1(p, l, smem); break;
    default: phase_resid(p, l, 1, smem); break;
  }
}

#ifndef MK_TEST
template <bool COOP>
__global__ void __launch_bounds__(256, 2) hybrid_fwd(Params p, int ph_lo, int ph_hi) {
  extern __shared__ __attribute__((aligned(16))) char smem[];
  __shared__ uint4 xb_words;
  if (COOP) {
    if (threadIdx.x == 0) xb_words = make_uint4(0u, 0u, 0u, 0u);
    __syncthreads();
    run_phase(p, 0, smem);
    cg::this_grid().sync();
    XcdBarrier xb = xcd_barrier_post((unsigned*)(p.ws + WS_BAR), (volatile LAS unsigned*)&xb_words);
    for (int ph = 1; ph < ph_hi; ++ph) {
      run_phase(p, ph, smem);
#ifdef PROBE_DUP
      if (ph >= 1 && ph <= 18 && ((PROBE_DUP >> ((ph - 1) % 9)) & 1)) run_phase(p, ph, smem);
#endif
      if (ph + 1 < ph_hi) xcd_barrier(xb);
    }
  } else {
    for (int ph = ph_lo; ph < ph_hi; ++ph) run_phase(p, ph, smem);
  }
}

extern "C" void kernel_launch(void* const* d_in, const int* in_sizes, int n_in, void* d_out, int out_size, void* d_ws, size_t ws_size, hipStream_t stream) {
  static int grid = 0;
  if (grid == 0) {
    if (n_in != 26 || ws_size < WS_END) { fprintf(stderr, "kernel_launch: bad n_in %d or ws_size %zu (need %zu)\n", n_in, ws_size, (size_t)WS_END); grid = -1; return; }
    int dev = 0, cus = 0, per_cu = 0;
    hipGetDevice(&dev);
    hipDeviceGetAttribute(&cus, hipDeviceAttributeMultiprocessorCount, dev);
    hipFuncSetAttribute((const void*)hybrid_fwd<true>, hipFuncAttributeMaxDynamicSharedMemorySize, SMEM_BYTES);
    hipFuncSetAttribute((const void*)hybrid_fwd<false>, hipFuncAttributeMaxDynamicSharedMemorySize, SMEM_BYTES);
    hipOccupancyMaxActiveBlocksPerMultiprocessor(&per_cu, (const void*)hybrid_fwd<true>, 256, SMEM_BYTES);
    if (per_cu < 1) per_cu = 1;
    if (per_cu > 2) per_cu = 2;
    grid = cus * per_cu;
  }
  if (grid < 0) return;
  Params p{};
  const float** pp = (const float**)&p;
  for (int i = 0; i < 26; ++i) pp[i] = (const float*)d_in[i];
  p.out = (float*)d_out;
  p.ws = (char*)d_ws;
#if MK_COOP
  int lo = 0, hi = N_PHASES;
  void* args[] = {&p, &lo, &hi};
  hipError_t e = hipLaunchCooperativeKernel((const void*)hybrid_fwd<true>, dim3(grid), dim3(256), args, SMEM_BYTES, stream);
  if (e != hipSuccess) fprintf(stderr, "cooperative launch failed: %s (grid %d)\n", hipGetErrorString(e), grid);
#else
  for (int ph = 0; ph < N_PHASES; ++ph) hybrid_fwd<false><<<grid, 256, SMEM_BYTES, stream>>>(p, ph, ph + 1);
#endif
}
#endif
```

```cpp
#include <hip/hip_runtime.h>
#include <hip/hip_cooperative_groups.h>
#include <stdint.h>
#include <stdio.h>
namespace cg = cooperative_groups;

#ifndef MK_COOP
#define MK_COOP 1
#endif

typedef unsigned short bf16_t;
typedef __attribute__((ext_vector_type(8))) short bf16x8;
typedef __attribute__((ext_vector_type(16))) float f32x16;
typedef __attribute__((ext_vector_type(4))) float f32x4;
typedef __attribute__((ext_vector_type(4))) unsigned u32x4;
typedef __attribute__((ext_vector_type(2))) unsigned u32x2;

#define DI __device__ __forceinline__
#define MFMA(a, b, c) __builtin_amdgcn_mfma_f32_32x32x16_bf16((a), (b), (c), 0, 0, 0)

typedef __attribute__((ext_vector_type(2))) __bf16 bf16x2_t;
typedef __attribute__((ext_vector_type(2))) float f32x2;
DI unsigned pk2(float lo, float hi) { f32x2 v = {lo, hi}; bf16x2_t b = __builtin_convertvector(v, bf16x2_t); return __builtin_bit_cast(unsigned, b); }
DI float bflo(unsigned u) { return __uint_as_float(u << 16); }
DI float bfhi(unsigned u) { return __uint_as_float(u & 0xffff0000u); }
DI bf16x8 as_bf8(u32x4 v) { return __builtin_bit_cast(bf16x8, v); }
DI int get_tid() { int t = (int)__builtin_amdgcn_workitem_id_x(); asm volatile("" : "+v"(t)); return t; }
DI float shfl_(float v, int src) { return __int_as_float(__builtin_amdgcn_ds_bpermute(src << 2, __float_as_int(v))); }
DI float shfl_xor_(float v, int o, int lane) { return shfl_(v, lane ^ o); }
DI float shfl_up_(float v, int o, int lane) { int s = lane - o; return shfl_(v, s < 0 ? lane : s); }
DI float sigmoidf_(float x) { return 1.f / (1.f + __expf(-x)); }

constexpr int TC = 4096;
constexpr int TL = 32768;
constexpr int TT = TC + TL;
constexpr int DM = 1024;
constexpr int NIN = 9232;
constexpr int NZ = 5136;
constexpr int ZW = 5120;
constexpr int DFF = 2816;
constexpr int NAQ = 0, NAK = 512, NAV = 1024, GQ = 1536, GK = 2048, GV = 2176, SQ = 2304, SK = 2816, SV = 2944,
              MQ = 3072, MK = 3584, MV = 4096, MO = 4608;
constexpr int MGC = 512;
constexpr size_t WS_WIN = 0;
constexpr size_t WS_WBR = WS_WIN + (size_t)NIN * DM * 2;
constexpr size_t WS_WOUT = WS_WBR + (size_t)4 * 1024 * 512 * 2;
constexpr size_t WS_WF1 = WS_WOUT + (size_t)1024 * 1024 * 2;
constexpr size_t WS_WF2 = WS_WF1 + (size_t)5632 * 1024 * 2;
constexpr size_t WS_Z = WS_WF2 + (size_t)1024 * DFF * 2;
constexpr size_t WS_H = WS_Z + (size_t)TT * ZW * 2;
constexpr size_t WS_HB = WS_H + (size_t)TT * DM * 2;
constexpr size_t WS_IF = WS_HB + (size_t)TT * 512 * 2;
constexpr size_t WS_MODS = WS_IF + (size_t)TT * 16 * 4;
constexpr size_t WS_ROPE = WS_MODS + (size_t)2 * 9 * 6144 * 4;
constexpr size_t WS_CNT = WS_ROPE + 2 * 1024 * 4;
constexpr size_t WS_BAR = WS_CNT + 4096;
constexpr size_t WS_END = WS_BAR + 16384;
constexpr size_t OUT_YP = 0, OUT_YS = 4194304, OUT_NA = 37748736, OUT_GQA = 46137344, OUT_SWA = 48234496,
                 OUT_C = 50331648, OUT_N = 54525952, OUT_M = 54558720;

constexpr int SMEM_BYTES = 74752;
constexpr float LOG2E = 1.4426950408889634f;

struct Params {
  const float *x_prompt, *x_sample, *cache_na, *cache_gqa, *cache_swa, *st_C, *st_n, *st_m, *c, *c_ctx,
      *w_mod, *b_mod, *norm1_g, *norm2_g, *w_in, *b_in, *na_rpb, *gqa_q_g, *gqa_k_g, *swa_sink, *ml_g,
      *w_branch, *w_out, *w_f1, *w_f2, *final_g;
  float* out;
  char* ws;
};

DI int cond_of_row(int grow) { return grow < TC ? 0 : 1 + ((grow - TC) >> 12); }

DI void phase0(const Params& p, char* smem) {
  const int tid = get_tid();
  if (blockIdx.x == 0) {
    int* cnt = (int*)(p.ws + WS_CNT);
    for (int i = tid; i < 1024 + 4096; i += 256) cnt[i] = 0;
    float* rc = (float*)(p.ws + WS_ROPE);
    for (int idx = tid; idx < 1024; idx += 256) {
      int pos = idx >> 4, j = idx & 15;
      float freq = exp2f(-(float)j * (13.287712379549449f / 16.f));
      float ang = (float)pos * freq;
      float k = rintf(ang * 0.15915494309189535f);
      float r = fmaf(-k, 6.2831854820251465f, ang);
      r = fmaf(k, 1.7484555e-7f, r);
      rc[idx] = __cosf(r);
      rc[1024 + idx] = __sinf(r);
    }
  }
  float* sS = (float*)smem;
  float* sR = (float*)(smem + 36864);
  for (int idx = tid; idx < 9 * 1024; idx += 256) {
    int cv = idx >> 10, k = idx & 1023;
    float v = cv == 0 ? p.c_ctx[k] : p.c[(cv - 1) * 1024 + k];
    sS[idx] = v / (1.f + __expf(-v));
  }
  __syncthreads();
  for (int item = blockIdx.x; item < 192; item += gridDim.x) {
    int l = item / 96, n0 = (item % 96) * 64, n = n0 + (tid & 63), kg = tid >> 6;
    const float* w = p.w_mod + (size_t)l * 1024 * 6144 + n;
    float acc[9];
#pragma unroll
    for (int cv = 0; cv < 9; ++cv) acc[cv] = 0.f;
#pragma unroll 4
    for (int k = kg * 256; k < kg * 256 + 256; ++k) {
      float wv = w[(size_t)k * 6144];
#pragma unroll
      for (int cv = 0; cv < 9; ++cv) acc[cv] = fmaf(sS[cv * 1024 + k], wv, acc[cv]);
    }
#pragma unroll
    for (int cv = 0; cv < 9; ++cv) sR[(kg * 9 + cv) * 64 + (tid & 63)] = acc[cv];
    __syncthreads();
    if (tid < 64) {
      float* mods = (float*)(p.ws + WS_MODS);
      float bm = p.b_mod[l * 6144 + n];
#pragma unroll
      for (int cv = 0; cv < 9; ++cv) {
        float s = sR[(0 * 9 + cv) * 64 + tid] + sR[(1 * 9 + cv) * 64 + tid] + sR[(2 * 9 + cv) * 64 + tid] + sR[(3 * 9 + cv) * 64 + tid];
        mods[(size_t)(l * 9 + cv) * 6144 + n] = s + bm;
      }
    }
    __syncthreads();
  }
}

DI void convert_tile(const float* __restrict__ src, int K, int N, bf16_t* __restrict__ dst, int kt, int nt, int f1perm, char* smem) {
  float* sT = (float*)smem;
  const int tid = get_tid();
  __syncthreads();
  {
    int n4 = (tid & 15) * 4, kr = tid >> 4;
#pragma unroll
    for (int i = 0; i < 4; ++i) {
      int k = kr + 16 * i;
      int n = nt * 64 + n4;
      f32x4 v = {0.f, 0.f, 0.f, 0.f};
      if (n < N) v = *(const f32x4*)(src + (size_t)(kt * 64 + k) * N + n);
      sT[k * 65 + n4 + 0] = v[0]; sT[k * 65 + n4 + 1] = v[1]; sT[k * 65 + n4 + 2] = v[2]; sT[k * 65 + n4 + 3] = v[3];
    }
  }
  __syncthreads();
  {
    int nl = tid >> 2, seg = (tid & 3) * 16;
    int n = nt * 64 + nl;
    if (n < N) {
      int drow = n;
      if (f1perm) { int j = n < DFF ? n : n - DFF; drow = (j >> 6) * 128 + (n < DFF ? 0 : 64) + (j & 63); }
      unsigned o[8];
#pragma unroll
      for (int q = 0; q < 8; ++q) o[q] = pk2(sT[(seg + 2 * q) * 65 + nl], sT[(seg + 2 * q + 1) * 65 + nl]);
      u32x4* d = (u32x4*)(dst + (size_t)drow * K + kt * 64 + seg);
      d[0] = u32x4{o[0], o[1], o[2], o[3]};
      d[1] = u32x4{o[4], o[5], o[6], o[7]};
    }
  }
}

DI void convert_weights(const Params& p, int l, char* smem) {
  for (int item = blockIdx.x; item < 5200; item += gridDim.x) {
    const float* src; bf16_t* dst; int K, N, kt, nt, perm = 0;
    int j = item;
    if (j < 2320) { src = p.w_in + (size_t)l * 1024 * NIN; K = 1024; N = NIN; dst = (bf16_t*)(p.ws + WS_WIN); kt = j / 145; nt = j % 145; }
    else if (j < 2832) { j -= 2320; int i = j >> 7; j &= 127; src = p.w_branch + (size_t)(l * 4 + i) * 512 * 1024; K = 512; N = 1024; dst = (bf16_t*)(p.ws + WS_WBR) + (size_t)i * 1024 * 512; kt = j >> 4; nt = j & 15; }
    else if (j < 3088) { j -= 2832; src = p.w_out + (size_t)l * 1024 * 1024; K = 1024; N = 1024; dst = (bf16_t*)(p.ws + WS_WOUT); kt = j >> 4; nt = j & 15; }
    else if (j < 4496) { j -= 3088; src = p.w_f1 + (size_t)l * 1024 * 5632; K = 1024; N = 5632; dst = (bf16_t*)(p.ws + WS_WF1); kt = j / 88; nt = j % 88; perm = 1; }
    else { j -= 4496; src = p.w_f2 + (size_t)l * DFF * 1024; K = DFF; N = 1024; dst = (bf16_t*)(p.ws + WS_WF2); kt = j >> 4; nt = j & 15; }
    convert_tile(src, K, N, dst, kt, nt, perm, smem);
  }
}

DI void norm_phase(const Params& p, int l, int which) {
  const int tid = get_tid(), lane = tid & 63, w = tid >> 6;
  const float* g = which == 0 ? p.norm1_g + l * 1024 : (which == 1 ? p.norm2_g + l * 1024 : p.final_g);
  const float* mods = (const float*)(p.ws + WS_MODS);
  bf16_t* H = (bf16_t*)(p.ws + WS_H);
  for (int row = blockIdx.x * 4 + w; row < TT; row += gridDim.x * 4) {
    const float* xr;
    if (which == 0 && l == 0) xr = row < TC ? p.x_prompt + (size_t)row * 1024 : p.x_sample + (size_t)(row - TC) * 1024;
    else xr = p.out + (size_t)row * 1024;
    f32x4 v[4];
    float ss = 0.f;
#pragma unroll
    for (int i = 0; i < 4; ++i) {
      v[i] = *(const f32x4*)(xr + 4 * lane + 256 * i);
      ss += v[i][0] * v[i][0] + v[i][1] * v[i][1] + v[i][2] * v[i][2] + v[i][3] * v[i][3];
    }
#pragma unroll
    for (int o = 32; o >= 1; o >>= 1) ss += shfl_xor_(ss, o, lane);
    float rstd = rsqrtf(ss * (1.f / 1024.f) + 1e-6f);
    if (which == 2) {
      float* yo = p.out + (size_t)row * 1024;
#pragma unroll
      for (int i = 0; i < 4; ++i) {
        int k = 4 * lane + 256 * i;
        f32x4 g4 = *(const f32x4*)(g + k);
        f32x4 y;
#pragma unroll
        for (int e = 0; e < 4; ++e) y[e] = v[i][e] * rstd * g4[e];
        *(f32x4*)(yo + k) = y;
      }
    } else {
      const float* mr = mods + (size_t)(l * 9 + cond_of_row(row)) * 6144 + (which == 0 ? 0 : 3072);
#pragma unroll
      for (int i = 0; i < 4; ++i) {
        int k = 4 * lane + 256 * i;
        f32x4 g4 = *(const f32x4*)(g + k);
        f32x4 sh = *(const f32x4*)(mr + k);
        f32x4 sc = *(const f32x4*)(mr + 1024 + k);
        float y[4];
#pragma unroll
        for (int e = 0; e < 4; ++e) y[e] = (v[i][e] * rstd * g4[e]) * (1.f + sc[e]) + sh[e];
        *(u32x2*)(H + (size_t)row * 1024 + k) = u32x2{pk2(y[0], y[1]), pk2(y[2], y[3])};
      }
    }
  }
}

template <bool DB = true>
DI void gemm_core(const bf16_t* __restrict__ A, int lda, const bf16_t* __restrict__ B, int ldb, int K, f32x16 (&acc)[2][2], char* smem) {
  bf16_t* sA = (bf16_t*)smem;
  bf16_t* sB = sA + (DB ? 2 : 1) * 128 * 72;
  const int tid = get_tid(), lane = tid & 63, w = tid >> 6, wm = w >> 1, wn = w & 1, l31 = lane & 31, hh = lane >> 5;
  const int lrow = tid >> 3, lseg = (tid & 7) * 8;
  const char* Ab = (const char*)A;
  const char* Bb = (const char*)B;
  const unsigned offA = (unsigned)(lrow * lda + lseg) * 2u, offB = (unsigned)(lrow * ldb + lseg) * 2u;
  const unsigned stepA = (unsigned)lda * 64u, stepB = (unsigned)ldb * 64u;
  u32x4 ra[4], rb[4];
#pragma unroll
  for (int i = 0; i < 4; ++i) { ra[i] = *(const u32x4*)(Ab + (offA + i * stepA)); rb[i] = *(const u32x4*)(Bb + (offB + i * stepB)); }
  __syncthreads();
#pragma unroll
  for (int i = 0; i < 4; ++i) { *(u32x4*)(sA + (lrow + 32 * i) * 72 + lseg) = ra[i]; *(u32x4*)(sB + (lrow + 32 * i) * 72 + lseg) = rb[i]; }
  __syncthreads();
  const int nk = K >> 6;
  for (int kt = 0; kt < nk; ++kt) {
    const int buf = DB ? (kt & 1) : 0;
    if (kt + 1 < nk) {
#pragma unroll
      for (int i = 0; i < 4; ++i) { ra[i] = *(const u32x4*)(Ab + (offA + i * stepA + (unsigned)(kt + 1) * 128u)); rb[i] = *(const u32x4*)(Bb + (offB + i * stepB + (unsigned)(kt + 1) * 128u)); }
    }
    __builtin_amdgcn_sched_barrier(0);
    const bf16_t* pa = sA + (buf * 128 + 64 * wm + l31) * 72 + 8 * hh;
    const bf16_t* pb = sB + (buf * 128 + 64 * wn + l31) * 72 + 8 * hh;
    bf16x8 a0 = *(const bf16x8*)(pa), a1 = *(const bf16x8*)(pa + 32 * 72);
    bf16x8 b0 = *(const bf16x8*)(pb), b1 = *(const bf16x8*)(pb + 32 * 72);
#pragma unroll
    for (int ks = 0; ks < 4; ++ks) {
      bf16x8 na0 = a0, na1 = a1, nb0 = b0, nb1 = b1;
      if (ks < 3) {
        na0 = *(const bf16x8*)(pa + (ks + 1) * 16); na1 = *(const bf16x8*)(pa + 32 * 72 + (ks + 1) * 16);
        nb0 = *(const bf16x8*)(pb + (ks + 1) * 16); nb1 = *(const bf16x8*)(pb + 32 * 72 + (ks + 1) * 16);
      }
      __builtin_amdgcn_sched_barrier(0);
      acc[0][0] = MFMA(a0, b0, acc[0][0]);
      acc[0][1] = MFMA(a0, b1, acc[0][1]);
      acc[1][0] = MFMA(a1, b0, acc[1][0]);
      acc[1][1] = MFMA(a1, b1, acc[1][1]);
      __builtin_amdgcn_sched_barrier(0);
      a0 = na0; a1 = na1; b0 = nb0; b1 = nb1;
    }
    if (kt + 1 < nk) {
      const int nb = DB ? (buf ^ 1) : 0;
      if (!DB) __syncthreads();
#pragma unroll
      for (int i = 0; i < 4; ++i) { *(u32x4*)(sA + (nb * 128 + lrow + 32 * i) * 72 + lseg) = ra[i]; *(u32x4*)(sB + (nb * 128 + lrow + 32 * i) * 72 + lseg) = rb[i]; }
    }
    __syncthreads();
  }
}

DI void zero_acc(f32x16 (&acc)[2][2]) {
#pragma unroll
  for (int i = 0; i < 2; ++i)
#pragma unroll
    for (int j = 0; j < 2; ++j)
#pragma unroll
      for (int r = 0; r < 16; ++r) acc[i][j][r] = 0.f;
}

DI void acc_to_lds(const f32x16 (&acc)[2][2], float* sC) {
  const int tid = get_tid(), lane = tid & 63, w = tid >> 6, wm = w >> 1, wn = w & 1, l31 = lane & 31, hh = lane >> 5;
#pragma unroll
  for (int i = 0; i < 2; ++i)
#pragma unroll
    for (int j = 0; j < 2; ++j)
#pragma unroll
      for (int r = 0; r < 16; ++r) {
        int row = 64 * wm + 32 * i + 8 * (r >> 2) + 4 * hh + (r & 3), col = 64 * wn + 32 * j + l31;
        sC[row * 132 + col] = acc[i][j][r];
      }
  __syncthreads();
}

struct TileIter {
  int local, step, total, nN, xcd; bool swz;
  DI void init(int nN_) {
    nN = nN_;
    swz = (gridDim.x & 7) == 0;
    if (swz) { xcd = blockIdx.x & 7; local = blockIdx.x >> 3; step = gridDim.x >> 3; total = 36 * nN; }
    else { xcd = 0; local = blockIdx.x; step = gridDim.x; total = 288 * nN; }
  }
  DI bool next(int& mt, int& nt) {
    if (local >= total) return false;
    if (swz) {
      const int per_sr = 8 * nN;
      const int sr = local / per_sr, r = local - sr * per_sr;
      const int rows = (36 - 8 * sr) < 8 ? (36 - 8 * sr) : 8;
      nt = r / rows; mt = 36 * xcd + 8 * sr + (r - nt * rows);
    } else { mt = local / nN; nt = local - mt * nN; }
    local += step;
    return true;
  }
};

DI void epi_inproj(const Params& p, int l, int mt, int nt, const float* sC) {
  const int tid = get_tid();
  const int chunk = tid & 15, lane = tid & 63;
  const int half = chunk >> 3, d0 = (chunk & 7) * 8;
  const int c0 = nt * 128 + half * 64;
  if (c0 >= NZ && c0 != 5120) return;
  bf16_t* Z = (bf16_t*)(p.ws + WS_Z);
  const float* bias = p.b_in + (size_t)l * NIN + c0;
  if (c0 == 5120) {
    if (chunk >= 2) return;
    const f32x4 b0 = *(const f32x4*)(bias + d0), b1 = *(const f32x4*)(bias + d0 + 4);
#pragma unroll
    for (int it = 0; it < 8; ++it) {
      const int rt = (tid >> 4) + 16 * it, grow = mt * 128 + rt;
      const float* crow = sC + rt * 132 + d0;
      f32x4 v0 = *(const f32x4*)crow + b0, v1 = *(const f32x4*)(crow + 4) + b1;
      if (chunk == 1) {
#pragma unroll
        for (int e = 0; e < 4; ++e) {
          v0[e] = fminf(v0[e], 0.f) - log1pf(__expf(-fabsf(v0[e])));
          v1[e] = fminf(v1[e], 0.f) - log1pf(__expf(-fabsf(v1[e])));
        }
      }
      float* IF = (float*)(p.ws + WS_IF) + (size_t)grow * 16 + d0;
      *(f32x4*)IF = v0; *(f32x4*)(IF + 4) = v1;
    }
    return;
  }
  bool hn = false, rope = false;
  const float* hg = nullptr;
  float scale = 1.f;
  int kvsel = -1, kvh = 0, kvH = 0; size_t kvbase = 0;
  if (c0 < NAK) {}
  else if (c0 < NAV) { kvbase = OUT_NA; kvsel = 0; kvh = (c0 - NAK) >> 6; kvH = 8; }
  else if (c0 < GQ) { kvbase = OUT_NA; kvsel = 1; kvh = (c0 - NAV) >> 6; kvH = 8; }
  else if (c0 < GK) { hn = true; hg = p.gqa_q_g + l * 64; rope = true; }
  else if (c0 < GV) { hn = true; hg = p.gqa_k_g + l * 64; rope = true; kvbase = OUT_GQA; kvsel = 0; kvh = (c0 - GK) >> 6; kvH = 2; }
  else if (c0 < SQ) { kvbase = OUT_GQA; kvsel = 1; kvh = (c0 - GV) >> 6; kvH = 2; }
  else if (c0 < SK) { rope = true; }
  else if (c0 < SV) { rope = true; kvbase = OUT_SWA; kvsel = 0; kvh = (c0 - SK) >> 6; kvH = 2; }
  else if (c0 < MQ) { kvbase = OUT_SWA; kvsel = 1; kvh = (c0 - SV) >> 6; kvH = 2; }
  else if (c0 >= MK && c0 < MV) { scale = 0.08838834764831845f; }
  if (c0 < NAK || (c0 >= GQ && c0 < GK) || (c0 >= SQ && c0 < SK)) scale = 0.125f * LOG2E;
  const bool latent_tile = mt >= 32;
  if (latent_tile) kvsel = -1; else rope = false;
  const int dp = d0 ^ 16;
  const bool second = (d0 & 16) != 0;
  const f32x4 b0 = *(const f32x4*)(bias + d0), b1 = *(const f32x4*)(bias + d0 + 4);
  f32x4 pb0 = b0, pb1 = b1, g0 = {1.f, 1.f, 1.f, 1.f}, g1 = g0, pg0 = g0, pg1 = g0;
  if (rope) { pb0 = *(const f32x4*)(bias + dp); pb1 = *(const f32x4*)(bias + dp + 4); }
  if (hn) {
    g0 = *(const f32x4*)(hg + d0); g1 = *(const f32x4*)(hg + d0 + 4);
    pg0 = *(const f32x4*)(hg + dp); pg1 = *(const f32x4*)(hg + dp + 4);
  }
  const float* rcos = (const float*)(p.ws + WS_ROPE);
  const float* rsin = rcos + 1024;
#pragma unroll 4
  for (int it = 0; it < 8; ++it) {
    const int rt = (tid >> 4) + 16 * it, grow = mt * 128 + rt;
    const float* crow = sC + rt * 132 + half * 64;
    f32x4 x0 = *(const f32x4*)(crow + d0) + b0, x1 = *(const f32x4*)(crow + d0 + 4) + b1;
    float rs = 1.f;
    if (hn) {
      float ss = x0[0] * x0[0] + x0[1] * x0[1] + x0[2] * x0[2] + x0[3] * x0[3] + x1[0] * x1[0] + x1[1] * x1[1] + x1[2] * x1[2] + x1[3] * x1[3];
      ss += shfl_xor_(ss, 1, lane); ss += shfl_xor_(ss, 2, lane); ss += shfl_xor_(ss, 4, lane);
      rs = rsqrtf(ss * (1.f / 64.f) + 1e-6f);
    }
    const float sc = rs * scale;
    x0 = x0 * sc * g0; x1 = x1 * sc * g1;
    if (rope) {
      f32x4 y0 = (*(const f32x4*)(crow + dp) + pb0) * sc * pg0, y1 = (*(const f32x4*)(crow + dp + 4) + pb1) * sc * pg1;
      const int t = (grow - TC) & 4095;
      const int pos = (d0 & 32) ? (t & 63) : (t >> 6);
      const int fj = d0 & 15;
      const f32x4 c0v = *(const f32x4*)(rcos + pos * 16 + fj), c1v = *(const f32x4*)(rcos + pos * 16 + fj + 4);
      const f32x4 s0v = *(const f32x4*)(rsin + pos * 16 + fj), s1v = *(const f32x4*)(rsin + pos * 16 + fj + 4);
      if (second) { x0 = x0 * c0v + y0 * s0v; x1 = x1 * c1v + y1 * s1v; }
      else { x0 = x0 * c0v - y0 * s0v; x1 = x1 * c1v - y1 * s1v; }
    }
    __builtin_nontemporal_store(u32x4{pk2(x0[0], x0[1]), pk2(x0[2], x0[3]), pk2(x1[0], x1[1]), pk2(x1[2], x1[3])}, (u32x4*)(Z + (size_t)grow * ZW + c0 + d0));
    if (kvsel >= 0) {
      const int cb = grow >> 8, cs = grow & 255;
      float* kv = p.out + kvbase + ((((size_t)(cb * 2 + l) * 2 + kvsel) * 256 + cs) * kvH + kvh) * 64 + d0;
      *(f32x4*)kv = x0; *(f32x4*)(kv + 4) = x1;
    }
  }
}

DI void phase_inproj(const Params& p, int l, char* smem) {
  const bf16_t* H = (const bf16_t*)(p.ws + WS_H);
  const bf16_t* W = (const bf16_t*)(p.ws + WS_WIN);
  TileIter ti; ti.init(41);
  for (int mt, nt; ti.next(mt, nt);) {
    f32x16 acc[2][2];
    zero_acc(acc);
    gemm_core(H + (size_t)mt * 128 * DM, DM, W + (size_t)nt * 128 * DM, DM, DM, acc, smem);
    acc_to_lds(acc, (float*)smem);
    epi_inproj(p, l, mt, nt, (const float*)smem);
  }
}

DI void phase_merge(const Params& p, int l, char* smem) {
  const int tid = get_tid(), lane = tid & 63, w = tid >> 6, wn = w & 1, l31 = lane & 31;
  const bf16_t* H = (const bf16_t*)(p.ws + WS_H);
  const bf16_t* W = (const bf16_t*)(p.ws + WS_WIN);
  const bf16_t* WB = (const bf16_t*)(p.ws + WS_WBR);
  bf16_t* Z = (bf16_t*)(p.ws + WS_Z);
  TileIter ti; ti.init(8);
  for (int mt, nt; ti.next(mt, nt);) {
    f32x16 mg[2][2];
    zero_acc(mg);
#pragma unroll 1
    for (int i = 0; i < 4; ++i) {
      f32x16 acc[2][2];
      zero_acc(acc);
      gemm_core<false>(H + (size_t)mt * 128 * DM, DM, W + (size_t)(NZ + i * 1024 + nt * 128) * DM, DM, DM, acc, smem);
      unsigned* sG = (unsigned*)(smem + 36864) + tid;
#pragma unroll
      for (int j = 0; j < 2; ++j) {
        float bj = p.b_in[(size_t)l * NIN + NZ + i * 1024 + nt * 128 + 64 * wn + 32 * j + l31];
#pragma unroll
        for (int ii = 0; ii < 2; ++ii)
#pragma unroll
          for (int r = 0; r < 8; ++r) sG[((ii * 2 + j) * 8 + r) * 256] = pk2(sigmoidf_(acc[ii][j][2 * r] + bj), sigmoidf_(acc[ii][j][2 * r + 1] + bj));
      }
      zero_acc(acc);
      const int colA = i == 0 ? NAQ : (i == 1 ? GQ : (i == 2 ? SQ : MQ));
      gemm_core<false>(Z + (size_t)mt * 128 * ZW + colA, ZW, WB + (size_t)(i * 1024 + nt * 128) * 512, 512, 512, acc, smem);
#pragma unroll
      for (int ii = 0; ii < 2; ++ii)
#pragma unroll
        for (int j = 0; j < 2; ++j)
#pragma unroll
          for (int r = 0; r < 8; ++r) {
            const unsigned gpv = sG[((ii * 2 + j) * 8 + r) * 256];
            mg[ii][j][2 * r] += bflo(gpv) * acc[ii][j][2 * r];
            mg[ii][j][2 * r + 1] += bfhi(gpv) * acc[ii][j][2 * r + 1];
          }
    }
    float* sC = (float*)smem;
    __syncthreads();
    acc_to_lds(mg, sC);
#pragma unroll
    for (int it = 0; it < 8; ++it) {
      const int rt = (tid >> 4) + 16 * it, ch = (tid & 15) * 8;
      const float* crow = sC + rt * 132 + ch;
      f32x4 a = *(const f32x4*)crow, b = *(const f32x4*)(crow + 4);
      __builtin_nontemporal_store(u32x4{pk2(a[0], a[1]), pk2(a[2], a[3]), pk2(b[0], b[1]), pk2(b[2], b[3])}, (u32x4*)(Z + (size_t)(mt * 128 + rt) * ZW + MGC + nt * 128 + ch));
    }
  }
}

DI void phase_resid(const Params& p, int l, int which, char* smem) {
  const int tid = get_tid();
  const bf16_t* Z = (const bf16_t*)(p.ws + WS_Z);
  const bf16_t* W = (const bf16_t*)(p.ws + (which == 0 ? WS_WOUT : WS_WF2));
  const int K = which == 0 ? 1024 : DFF;
  const int acol = which == 0 ? MGC : 0;
  const int goff = which == 0 ? 2048 : 5120;
  const float* mods = (const float*)(p.ws + WS_MODS);
  TileIter ti; ti.init(8);
  for (int mt, nt; ti.next(mt, nt);) {
    f32x16 acc[2][2];
    zero_acc(acc);
    gemm_core(Z + (size_t)mt * 128 * ZW + acol, ZW, W + (size_t)nt * 128 * K, K, K, acc, smem);
    float* sC = (float*)smem;
    acc_to_lds(acc, sC);
    const int n = nt * 128 + (tid & 31) * 4;
    const f32x4 g4 = *(const f32x4*)(mods + (size_t)(l * 9 + cond_of_row(mt * 128)) * 6144 + goff + n);
    const float* xbase = (which == 0 && l == 0) ? (mt < 32 ? p.x_prompt + (size_t)mt * 128 * 1024 : p.x_sample + (size_t)(mt * 128 - TC) * 1024)
                                                : p.out + (size_t)mt * 128 * 1024;
#pragma unroll 4
    for (int it = 0; it < 16; ++it) {
      const int rt = (tid >> 5) + 8 * it, grow = mt * 128 + rt;
      const f32x4 x4 = *(const f32x4*)(xbase + (size_t)rt * 1024 + n);
      const f32x4 c4 = *(const f32x4*)(sC + rt * 132 + (tid & 31) * 4);
      __builtin_nontemporal_store(x4 + g4 * c4, (f32x4*)(p.out + (size_t)grow * 1024 + n));
    }
  }
}

DI void phase_ffn1(const Params& p, int l, char* smem) {
  const int tid = get_tid();
  const bf16_t* H = (const bf16_t*)(p.ws + WS_H);
  const bf16_t* W = (const bf16_t*)(p.ws + WS_WF1);
  bf16_t* Z = (bf16_t*)(p.ws + WS_Z);
  TileIter ti; ti.init(44);
  for (int mt, nt; ti.next(mt, nt);) {
    f32x16 acc[2][2];
    zero_acc(acc);
    gemm_core(H + (size_t)mt * 128 * DM, DM, W + (size_t)nt * 128 * DM, DM, DM, acc, smem);
    float* sC = (float*)smem;
    acc_to_lds(acc, sC);
#pragma unroll
    for (int it = 0; it < 4; ++it) {
      const int rt = (tid >> 3) + 32 * it, ch = (tid & 7) * 8;
      const float* crow = sC + rt * 132 + ch;
      float o[8];
#pragma unroll
      for (int hq = 0; hq < 2; ++hq) {
        f32x4 gt = *(const f32x4*)(crow + 4 * hq), up = *(const f32x4*)(crow + 64 + 4 * hq);
#pragma unroll
        for (int e = 0; e < 4; ++e) o[4 * hq + e] = gt[e] / (1.f + __expf(-gt[e])) * up[e];
      }
      __builtin_nontemporal_store(u32x4{pk2(o[0], o[1]), pk2(o[2], o[3]), pk2(o[4], o[5]), pk2(o[6], o[7])}, (u32x4*)(Z + (size_t)(mt * 128 + rt) * ZW + nt * 64 + ch));
    }
  }
}

struct AttnArgs {
  const void* k1; const void* v1; int stride1; int f32_1; int nblk1;
  const bf16_t* k2; const bf16_t* v2; int blk0_2; int nblk2;
  bf16_t* qo;
  int qpos0;
  int mode;
  float m0, l0;
  const float* rpb;
};

template <int QT>
DI void attn_item(const AttnArgs& a, char* smem) {
  bf16_t* sK = (bf16_t*)smem;
  bf16_t* sVt = sK + 2 * 64 * 72;
  float* sRpb = (float*)(smem + 4 * 64 * 72 * 2);
  const int tid = get_tid(), lane = tid & 63, l31 = lane & 31, hh = lane >> 5;
  const int dg = tid & 7, kp = tid >> 3;
  __syncthreads();
  if (a.mode == 2) for (int i = tid; i < 465; i += 256) sRpb[i] = a.rpb[i] * LOG2E;
  bf16x8 qf[QT][4];
#pragma unroll
  for (int qt = 0; qt < QT; ++qt)
#pragma unroll
    for (int st = 0; st < 4; ++st) qf[qt][st] = *(const bf16x8*)(a.qo + (size_t)(32 * qt + l31) * ZW + 16 * st + 8 * hh);
  f32x16 o[QT][2];
  float m_run[QT], l_run[QT];
#pragma unroll
  for (int qt = 0; qt < QT; ++qt) {
    m_run[qt] = a.m0; l_run[qt] = a.l0;
#pragma unroll
    for (int dt = 0; dt < 2; ++dt)
#pragma unroll
      for (int r = 0; r < 16; ++r) o[qt][dt][r] = 0.f;
  }
  const int nblk = a.nblk1 + a.nblk2;
  u32x4 rk[2], rv[2];
  auto load_blk = [&](int b) {
    if (b < a.nblk1) {
      if (a.f32_1) {
        const float* kb = (const float*)a.k1 + (size_t)(b * 64 + 2 * kp) * a.stride1 + 8 * dg;
        const float* vb = (const float*)a.v1 + (size_t)(b * 64 + 2 * kp) * a.stride1 + 8 * dg;
#pragma unroll
        for (int i = 0; i < 2; ++i) {
          f32x4 k0 = *(const f32x4*)(kb + (size_t)i * a.stride1), k1 = *(const f32x4*)(kb + (size_t)i * a.stride1 + 4);
          f32x4 v0 = *(const f32x4*)(vb + (size_t)i * a.stride1), v1 = *(const f32x4*)(vb + (size_t)i * a.stride1 + 4);
          rk[i] = u32x4{pk2(k0[0], k0[1]), pk2(k0[2], k0[3]), pk2(k1[0], k1[1]), pk2(k1[2], k1[3])};
          rv[i] = u32x4{pk2(v0[0], v0[1]), pk2(v0[2], v0[3]), pk2(v1[0], v1[1]), pk2(v1[2], v1[3])};
        }
      } else {
        const bf16_t* kb = (const bf16_t*)a.k1 + (size_t)(b * 64 + 2 * kp) * a.stride1 + 8 * dg;
        const bf16_t* vb = (const bf16_t*)a.v1 + (size_t)(b * 64 + 2 * kp) * a.stride1 + 8 * dg;
#pragma unroll
        for (int i = 0; i < 2; ++i) { rk[i] = *(const u32x4*)(kb + (size_t)i * a.stride1); rv[i] = *(const u32x4*)(vb + (size_t)i * a.stride1); }
      }
    } else {
      const int kb0 = (a.blk0_2 + (b - a.nblk1)) * 64 + 2 * kp;
      const bf16_t* kb = a.k2 + (size_t)kb0 * ZW + 8 * dg;
      const bf16_t* vb = a.v2 + (size_t)kb0 * ZW + 8 * dg;
#pragma unroll
      for (int i = 0; i < 2; ++i) { rk[i] = *(const u32x4*)(kb + (size_t)i * ZW); rv[i] = *(const u32x4*)(vb + (size_t)i * ZW); }
    }
  };
  auto store_blk = [&](int buf) {
    bf16_t* k = sK + buf * 64 * 72; bf16_t* v = sVt + buf * 64 * 72;
    *(u32x4*)(k + (2 * kp) * 72 + 8 * dg) = rk[0];
    *(u32x4*)(k + (2 * kp + 1) * 72 + 8 * dg) = rk[1];
#pragma unroll
    for (int e = 0; e < 4; ++e) {
      unsigned a0 = rv[0][e], a1 = rv[1][e];
      *(unsigned*)(v + (8 * dg + 2 * e) * 72 + 2 * (kp ^ (4 * dg))) = (a0 & 0xffffu) | (a1 << 16);
      *(unsigned*)(v + (8 * dg + 2 * e + 1) * 72 + 2 * (kp ^ (4 * dg))) = (a0 >> 16) | (a1 & 0xffff0000u);
    }
  };
  load_blk(0);
  store_blk(0);
  if (nblk > 1) load_blk(1);
  __syncthreads();
  for (int b = 0; b < nblk; ++b) {
    const bf16_t* cK = sK + (b & 1) * 64 * 72;
    const bf16_t* cV = sVt + (b & 1) * 64 * 72;
    f32x16 s[QT][2];
#pragma unroll
    for (int qt = 0; qt < QT; ++qt)
#pragma unroll
      for (int kt = 0; kt < 2; ++kt)
#pragma unroll
        for (int r = 0; r < 16; ++r) s[qt][kt][r] = 0.f;
#pragma unroll
    for (int st = 0; st < 4; ++st) {
      bf16x8 k0 = *(const bf16x8*)(cK + l31 * 72 + 16 * st + 8 * hh);
      bf16x8 k1 = *(const bf16x8*)(cK + (32 + l31) * 72 + 16 * st + 8 * hh);
#pragma unroll
      for (int qt = 0; qt < QT; ++qt) {
        s[qt][0] = MFMA(k0, qf[qt][st], s[qt][0]);
        s[qt][1] = MFMA(k1, qf[qt][st], s[qt][1]);
      }
    }
    const bool seg2 = b >= a.nblk1;
#pragma unroll
    for (int qt = 0; qt < QT; ++qt) {
      if (seg2 && a.mode == 1) {
        const int kbase = (a.blk0_2 + (b - a.nblk1)) * 64;
        const int qpos = a.qpos0 + 32 * qt + l31;
#pragma unroll
        for (int kt = 0; kt < 2; ++kt)
#pragma unroll
          for (int r = 0; r < 16; ++r) {
            int kpos = kbase + 32 * kt + 8 * (r >> 2) + 4 * hh + (r & 3);
            int dd = qpos - kpos; dd = dd < 0 ? -dd : dd;
            s[qt][kt][r] = dd <= 128 ? s[qt][kt][r] : -INFINITY;
          }
      } else if (seg2 && a.mode == 2) {
        const int kr = a.blk0_2 + (b - a.nblk1);
        const int qpos = a.qpos0 + 32 * qt + l31;
        const int qr = qpos >> 6, qc = qpos & 63;
        int rs = qr - 4; rs = rs < 0 ? 0 : (rs > 56 ? 56 : rs);
        int cs = qc - 8; cs = cs < 0 ? 0 : (cs > 48 ? 48 : cs);
        const bool rowok = kr >= rs && kr <= rs + 7;
        const int bbase = (kr - qr + 7) * 31 - qc + 15;
#pragma unroll
        for (int kt = 0; kt < 2; ++kt)
#pragma unroll
          for (int r = 0; r < 16; ++r) {
            int kc = 32 * kt + 8 * (r >> 2) + 4 * hh + (r & 3);
            bool ok = rowok && (unsigned)(kc - cs) < 16u;
            const float bias = sRpb[ok ? bbase + kc : 0];
            s[qt][kt][r] = ok ? s[qt][kt][r] + bias : -INFINITY;
          }
      }
      float mx = -INFINITY;
#pragma unroll
      for (int kt = 0; kt < 2; ++kt)
#pragma unroll
        for (int r = 0; r < 16; ++r) mx = fmaxf(mx, s[qt][kt][r]);
      mx = fmaxf(mx, shfl_xor_(mx, 32, lane));
      const float m_new = fmaxf(m_run[qt], mx);
      if (__builtin_amdgcn_ballot_w64(m_new > m_run[qt]) != 0ull) {
        const float alpha = __builtin_amdgcn_exp2f(m_run[qt] - m_new);
        l_run[qt] *= alpha;
#pragma unroll
        for (int dt = 0; dt < 2; ++dt)
#pragma unroll
          for (int r = 0; r < 16; ++r) o[qt][dt][r] *= alpha;
        m_run[qt] = m_new;
      }
      float ps = 0.f;
#pragma unroll
      for (int kt = 0; kt < 2; ++kt)
#pragma unroll
        for (int r = 0; r < 16; ++r) { float e = __builtin_amdgcn_exp2f(s[qt][kt][r] - m_run[qt]); s[qt][kt][r] = e; ps += e; }
      ps += shfl_xor_(ps, 32, lane);
      l_run[qt] += ps;
    }
#pragma unroll
    for (int kt = 0; kt < 2; ++kt)
#pragma unroll
      for (int s2 = 0; s2 < 2; ++s2) {
        u32x4 pb[QT];
#pragma unroll
        for (int qt = 0; qt < QT; ++qt)
          pb[qt] = u32x4{pk2(s[qt][kt][8 * s2 + 0], s[qt][kt][8 * s2 + 1]), pk2(s[qt][kt][8 * s2 + 2], s[qt][kt][8 * s2 + 3]),
                         pk2(s[qt][kt][8 * s2 + 4], s[qt][kt][8 * s2 + 5]), pk2(s[qt][kt][8 * s2 + 6], s[qt][kt][8 * s2 + 7])};
#pragma unroll
        for (int dt = 0; dt < 2; ++dt) {
          const int rg = (4 * dt + (l31 >> 3)) & 7;
          const bf16_t* vrow = cV + (32 * dt + l31) * 72 + 4 * hh;
          u32x2 lo = *(const u32x2*)(vrow + 8 * ((4 * kt + 2 * s2) ^ rg)), hi = *(const u32x2*)(vrow + 8 * ((4 * kt + 2 * s2 + 1) ^ rg));
          const bf16x8 vfr = as_bf8(u32x4{lo[0], lo[1], hi[0], hi[1]});
#pragma unroll
          for (int qt = 0; qt < QT; ++qt) o[qt][dt] = MFMA(vfr, as_bf8(pb[qt]), o[qt][dt]);
        }
      }
    if (b + 1 < nblk) store_blk((b + 1) & 1);
    if (b + 2 < nblk) load_blk(b + 2);
    __builtin_amdgcn_sched_barrier(0);
    __syncthreads();
  }
#pragma unroll
  for (int qt = 0; qt < QT; ++qt) {
    const float inv = 1.f / l_run[qt];
#pragma unroll
    for (int dt = 0; dt < 2; ++dt)
#pragma unroll
      for (int g = 0; g < 4; ++g) {
        *(u32x2*)(a.qo + (size_t)(32 * qt + l31) * ZW + 32 * dt + 8 * g + 4 * hh) =
            u32x2{pk2(o[qt][dt][4 * g] * inv, o[qt][dt][4 * g + 1] * inv), pk2(o[qt][dt][4 * g + 2] * inv, o[qt][dt][4 * g + 3] * inv)};
      }
  }
}

DI float wave_scan_sum(float v, int lane) {
#pragma unroll
  for (int o = 1; o < 64; o <<= 1) { float t = shfl_up_(v, o, lane); if (lane >= o) v += t; }
  return v;
}
DI float wave_scan_max(float v, int lane) {
#pragma unroll
  for (int o = 1; o < 64; o <<= 1) { float t = shfl_up_(v, o, lane); if (lane >= o) v = fmaxf(v, t); }
  return v;
}

#define RLX_AGENT __ATOMIC_RELAXED, __HIP_MEMORY_SCOPE_AGENT
DI void mlstm_item(const Params& p, char* smem, int l, int b, int h, int eh, int dir, bool latent, int* prog_self, int* prog_partner) {
  bf16_t* sQ = (bf16_t*)smem;
  bf16_t* sK = sQ + 64 * 136;
  bf16_t* sKw = sK + 64 * 136;
  bf16_t* sVt = sKw + 128 * 72;
  float* sN = (float*)(sVt + 64 * 72);
  float* sA = sN + 128;
  const int tid = get_tid();
  const int S = latent ? 4096 : 256, nc = S >> 6, half = nc >> 1;
  const int rowbase = latent ? TC + b * 4096 : b * 256;
  bf16_t* Z = (bf16_t*)(p.ws + WS_Z);
  bf16_t* HB = (bf16_t*)(p.ws + WS_HB);
  const float* IF = (const float*)(p.ws + WS_IF);
  f32x16 C[4];
  float m_state = 0.f;
  __syncthreads();
  {
    const int lane = tid & 63, w = tid >> 6, l31 = lane & 31, hh = lane >> 5, et = w & 1;
    if (latent) {
      const size_t sidx = (size_t)((b * 2 + l) * 2 + dir) * 4 + h;
      const float* C0 = p.st_C + sidx * 128 * 128;
      int cidx0 = 4 * hh * 128 + 64 * eh + 32 * et + l31; asm volatile("" : "+v"(cidx0));
#pragma unroll
      for (int dt = 0; dt < 4; ++dt) {
#pragma unroll
        for (int r = 0; r < 16; ++r) C[dt][r] = C0[(unsigned)(cidx0 + (32 * dt + 8 * (r >> 2) + (r & 3)) * 128)];
        __builtin_amdgcn_sched_barrier(0);
      }
      if (tid < 128) sN[tid] = p.st_n[sidx * 128 + tid];
      m_state = p.st_m[sidx];
    } else {
#pragma unroll
      for (int dt = 0; dt < 4; ++dt)
#pragma unroll
        for (int r = 0; r < 16; ++r) C[dt][r] = 0.f;
      if (tid < 128) sN[tid] = 0.f;
    }
  }
  float ip_n, lf_n;
  u32x4 rq[4], rkk[4], rvv[2];
  auto prefetch = [&](int c) {
    const int cbase = rowbase + (dir ? (nc - 1 - c) * 64 : c * 64);
    int tidc = tid; asm volatile("" : "+v"(tidc));
    const int lane = tidc & 63;
    const int tokp = cbase + (dir ? 63 - lane : lane);
    ip_n = IF[(size_t)tokp * 16 + dir * 4 + h];
    lf_n = IF[(size_t)tokp * 16 + 8 + dir * 4 + h];
#pragma unroll
    for (int i = 0; i < 4; ++i) {
      int id = tidc + 256 * i, pr = id >> 4, seg = (id & 15) * 8;
      int tok = cbase + (dir ? 63 - pr : pr);
      rq[i] = *(const u32x4*)(Z + (size_t)tok * ZW + MQ + h * 128 + seg);
    }
    const int dgp = (tidc & 15) * 8;
#pragma unroll
    for (int i = 0; i < 2; ++i) {
      const int s0 = 2 * ((tidc >> 4) + 16 * i), s1 = s0 + 1;
      const int t0 = cbase + (dir ? 63 - s0 : s0), t1 = cbase + (dir ? 63 - s1 : s1);
      rkk[2 * i] = *(const u32x4*)(Z + (size_t)t0 * ZW + MK + h * 128 + dgp);
      rkk[2 * i + 1] = *(const u32x4*)(Z + (size_t)t1 * ZW + MK + h * 128 + dgp);
    }
    {
      const int dgv = (tidc & 7) * 8, s0 = 2 * (tidc >> 3), s1 = s0 + 1;
      const int t0 = cbase + (dir ? 63 - s0 : s0), t1 = cbase + (dir ? 63 - s1 : s1);
      rvv[0] = *(const u32x4*)(Z + (size_t)t0 * ZW + MV + h * 128 + 64 * eh + dgv);
      rvv[1] = *(const u32x4*)(Z + (size_t)t1 * ZW + MV + h * 128 + 64 * eh + dgv);
    }
  };
  prefetch(0);
#pragma unroll 1
  for (int c = 0; c < nc; ++c) {
    const int cbase = rowbase + (dir ? (nc - 1 - c) * 64 : c * 64);
    int tidc = tid; asm volatile("" : "+v"(tidc));
    const int lane = tidc & 63, w = tidc >> 6, l31 = lane & 31, hh = lane >> 5, et = w & 1, tt = w >> 1;
    const float ip = ip_n, lf = lf_n;
    const float bcum = wave_scan_sum(lf, lane);
    const float av = ip - bcum;
    const float pm = wave_scan_max(av, lane);
    const float Mv = fmaxf(m_state, pm);
    const float Mlast = shfl_(Mv, 63), blast = shfl_(bcum, 63);
    const float wsv = __expf(av - Mlast);
    const float decay = __expf(m_state - Mlast);
    __syncthreads();
#pragma unroll
    for (int i = 0; i < 4; ++i) {
      int id = tidc + 256 * i, pr = id >> 4, seg = (id & 15) * 8;
      *(u32x4*)(sQ + pr * 136 + seg) = rq[i];
    }
    {
      const int dgp = (tidc & 15) * 8;
#pragma unroll
      for (int i = 0; i < 2; ++i) {
        const int s0 = 2 * ((tidc >> 4) + 16 * i), s1 = s0 + 1;
        const u32x4 k0 = rkk[2 * i], k1 = rkk[2 * i + 1];
        *(u32x4*)(sK + s0 * 136 + dgp) = k0;
        *(u32x4*)(sK + s1 * 136 + dgp) = k1;
        const float w0 = shfl_(wsv, s0), w1 = shfl_(wsv, s1);
#pragma unroll
        for (int e = 0; e < 4; ++e) {
          const int sw = 2 * ((s0 >> 1) ^ (4 * ((tidc & 15) & 7)));
          *(unsigned*)(sKw + (dgp + 2 * e) * 72 + sw) = pk2(bflo(k0[e]) * w0, bflo(k1[e]) * w1);
          *(unsigned*)(sKw + (dgp + 2 * e + 1) * 72 + sw) = pk2(bfhi(k0[e]) * w0, bfhi(k1[e]) * w1);
        }
      }
      const int dgv = (tidc & 7) * 8, sv0 = 2 * (tidc >> 3);
#pragma unroll
      for (int e = 0; e < 4; ++e) {
        const int svw = 2 * ((sv0 >> 1) ^ (4 * (tidc & 7)));
        *(unsigned*)(sVt + (dgv + 2 * e) * 72 + svw) = (rvv[0][e] & 0xffffu) | (rvv[1][e] << 16);
        *(unsigned*)(sVt + (dgv + 2 * e + 1) * 72 + svw) = (rvv[0][e] >> 16) | (rvv[1][e] & 0xffff0000u);
      }
    }
    if (w == 0) sA[lane] = av;
    __syncthreads();
    if (c + 1 < nc) prefetch(c + 1);
    __builtin_amdgcn_sched_barrier(0);
    const int t = 32 * tt + l31;
    const int tok = cbase + (dir ? 63 - t : t);
    const bool finisher = c >= half;
    unsigned long long* hbp = (unsigned long long*)(HB + (size_t)tok * 512 + h * 128 + 64 * eh + 32 * et + 4 * hh);
    int pflag = 0;
    if (finisher) pflag = __hip_atomic_load(prog_partner, RLX_AGENT);
    unsigned long long hbv[4] = {0ull, 0ull, 0ull, 0ull};
    bool have_hb = false;
    u32x2 og[4];
    if (finisher) {
#pragma unroll
      for (int g = 0; g < 4; ++g) og[g] = *(const u32x2*)(Z + (size_t)tok * ZW + MO + h * 128 + 64 * eh + 32 * et + 8 * g + 4 * hh);
    }
    float inv;
    f32x16 acc;
    {
      const float Mt = shfl_(Mv, t), bt = shfl_(bcum, t);
      const float winter = __expf(m_state - Mt);
#pragma unroll
      for (int r = 0; r < 16; ++r) acc[r] = 0.f;
#pragma unroll
      for (int dt = 0; dt < 4; ++dt)
#pragma unroll
        for (int s2 = 0; s2 < 2; ++s2) {
          u32x4 ca = {pk2(C[dt][8 * s2 + 0], C[dt][8 * s2 + 1]), pk2(C[dt][8 * s2 + 2], C[dt][8 * s2 + 3]),
                      pk2(C[dt][8 * s2 + 4], C[dt][8 * s2 + 5]), pk2(C[dt][8 * s2 + 6], C[dt][8 * s2 + 7])};
          const bf16_t* qp = sQ + t * 136 + 32 * dt + 16 * s2 + 4 * hh;
          u32x2 lo = *(const u32x2*)qp, hi = *(const u32x2*)(qp + 8);
          acc = MFMA(as_bf8(ca), as_bf8(u32x4{lo[0], lo[1], hi[0], hi[1]}), acc);
        }
#pragma unroll
      for (int r = 0; r < 16; ++r) acc[r] *= winter;
      float qv = 0.f;
#pragma unroll
      for (int j = 0; j < 8; ++j) {
        u32x4 q8 = *(const u32x4*)(sQ + t * 136 + 64 * hh + 8 * j);
        f32x4 n0 = *(const f32x4*)(sN + 64 * hh + 8 * j), n1 = *(const f32x4*)(sN + 64 * hh + 8 * j + 4);
        qv += bflo(q8[0]) * n0[0] + bfhi(q8[0]) * n0[1] + bflo(q8[1]) * n0[2] + bfhi(q8[1]) * n0[3] +
              bflo(q8[2]) * n1[0] + bfhi(q8[2]) * n1[1] + bflo(q8[3]) * n1[2] + bfhi(q8[3]) * n1[3];
      }
      qv += shfl_xor_(qv, 32, lane);
      if (finisher && __builtin_amdgcn_readfirstlane(pflag) >= nc - c) {
#pragma unroll
        for (int g = 0; g < 4; ++g) hbv[g] = __hip_atomic_load(hbp + 2 * g, RLX_AGENT);
        have_hb = true;
      }
      float rsv = 0.f;
#pragma unroll
      for (int st = 0; st < 2; ++st) {
        f32x16 sm;
#pragma unroll
        for (int r = 0; r < 16; ++r) sm[r] = 0.f;
#pragma unroll
        for (int ks = 0; ks < 8; ++ks) {
          bf16x8 ka = *(const bf16x8*)(sK + (32 * st + l31) * 136 + 16 * ks + 8 * hh);
          bf16x8 qb = *(const bf16x8*)(sQ + t * 136 + 16 * ks + 8 * hh);
          sm = MFMA(ka, qb, sm);
        }
#pragma unroll
        for (int g = 0; g < 4; ++g) {
          f32x4 a4 = *(const f32x4*)(sA + 32 * st + 8 * g + 4 * hh);
#pragma unroll
          for (int e = 0; e < 4; ++e) {
            const int s = 32 * st + 8 * g + 4 * hh + e;
            float wgt = s <= t ? __expf(a4[e] - Mt) : 0.f;
            float v = sm[4 * g + e] * wgt;
            sm[4 * g + e] = v;
            rsv += v;
          }
        }
#pragma unroll
        for (int s2 = 0; s2 < 2; ++s2) {
          const int rgv = (4 * et + (l31 >> 3)) & 7;
          const bf16_t* vrow = sVt + (32 * et + l31) * 72 + 4 * hh;
          u32x2 lo = *(const u32x2*)(vrow + 8 * ((4 * st + 2 * s2) ^ rgv)), hi = *(const u32x2*)(vrow + 8 * ((4 * st + 2 * s2 + 1) ^ rgv));
          u32x4 pb = {pk2(sm[8 * s2 + 0], sm[8 * s2 + 1]), pk2(sm[8 * s2 + 2], sm[8 * s2 + 3]),
                      pk2(sm[8 * s2 + 4], sm[8 * s2 + 5]), pk2(sm[8 * s2 + 6], sm[8 * s2 + 7])};
          acc = MFMA(as_bf8(u32x4{lo[0], lo[1], hi[0], hi[1]}), as_bf8(pb), acc);
        }
      }
      rsv += shfl_xor_(rsv, 32, lane);
      const float den = winter * qv + rsv;
      inv = 1.f / fmaxf(fabsf(den), __expf(-(bt + Mt)));
    }
#pragma unroll
    for (int dt = 0; dt < 4; ++dt) {
#pragma unroll
      for (int r = 0; r < 16; ++r) C[dt][r] *= decay;
#pragma unroll
      for (int ks = 0; ks < 4; ++ks) {
        bf16x8 ka = *(const bf16x8*)(sKw + (32 * dt + l31) * 72 + 8 * ((2 * ks + hh) ^ ((4 * dt + (l31 >> 3)) & 7)));
        bf16x8 vb = *(const bf16x8*)(sVt + (32 * et + l31) * 72 + 8 * ((2 * ks + hh) ^ ((4 * et + (l31 >> 3)) & 7)));
        C[dt] = MFMA(ka, vb, C[dt]);
      }
    }
    {
      if (!finisher) {
#pragma unroll
        for (int g = 0; g < 4; ++g) {
          const unsigned lo = pk2(acc[4 * g] * inv, acc[4 * g + 1] * inv), hi = pk2(acc[4 * g + 2] * inv, acc[4 * g + 3] * inv);
          __hip_atomic_store(hbp + 2 * g, ((unsigned long long)hi << 32) | lo, RLX_AGENT);
        }
        asm volatile("s_waitcnt vmcnt(0)" ::: "memory");
      } else {
        if (!have_hb) {
          const int need = nc - c;
          unsigned spins = 0;
          while (__builtin_amdgcn_readfirstlane(__hip_atomic_load(prog_partner, RLX_AGENT)) < need) {
            __builtin_amdgcn_s_sleep(1);
            if (++spins > (1u << 24)) break;
          }
          asm volatile("" ::: "memory");
#pragma unroll
          for (int g = 0; g < 4; ++g) hbv[g] = __hip_atomic_load(hbp + 2 * g, RLX_AGENT);
        }
#pragma unroll
        for (int g = 0; g < 4; ++g) {
          const unsigned long long hb = hbv[g];
          const unsigned hlo = (unsigned)hb, hhi = (unsigned)(hb >> 32);
          const float y0 = (acc[4 * g] * inv + bflo(hlo)) * sigmoidf_(bflo(og[g][0]));
          const float y1 = (acc[4 * g + 1] * inv + bfhi(hlo)) * sigmoidf_(bfhi(og[g][0]));
          const float y2 = (acc[4 * g + 2] * inv + bflo(hhi)) * sigmoidf_(bflo(og[g][1]));
          const float y3 = (acc[4 * g + 3] * inv + bfhi(hhi)) * sigmoidf_(bfhi(og[g][1]));
          hbp[2 * g] = ((unsigned long long)pk2(y2, y3) << 32) | pk2(y0, y1);
        }
      }
    }
    __syncthreads();
    if (!finisher && tidc == 0) __hip_atomic_store(prog_self, c + 1, RLX_AGENT);
    if (tidc < 128) {
      float sum = 0.f;
#pragma unroll
      for (int j = 0; j < 8; ++j) {
        u32x4 k8 = *(const u32x4*)(sKw + tidc * 72 + 8 * j);
        sum += bflo(k8[0]) + bfhi(k8[0]) + bflo(k8[1]) + bfhi(k8[1]) + bflo(k8[2]) + bfhi(k8[2]) + bflo(k8[3]) + bfhi(k8[3]);
      }
      sN[tidc] = decay * sN[tidc] + sum;
    }
    m_state = blast + Mlast;
  }
  if (!latent) {
    const int lane = tid & 63, w = tid >> 6, l31 = lane & 31, hh = lane >> 5, et = w & 1, tt = w >> 1;
    const size_t sidx = (size_t)((b * 2 + l) * 2 + dir) * 4 + h;
    float* Co = p.out + OUT_C + sidx * 128 * 128;
    if (tt == 0) {
      int cidx1 = 4 * hh * 128 + 64 * eh + 32 * et + l31; asm volatile("" : "+v"(cidx1));
#pragma unroll
      for (int dt = 0; dt < 4; ++dt) {
#pragma unroll
        for (int r = 0; r < 16; ++r) Co[(unsigned)(cidx1 + (32 * dt + 8 * (r >> 2) + (r & 3)) * 128)] = C[dt][r];
        __builtin_amdgcn_sched_barrier(0);
      }
    }
    __syncthreads();
    if (eh == 0) {
      if (tid < 128) p.out[OUT_N + sidx * 128 + tid] = sN[tid];
      if (tid == 0) p.out[OUT_M + sidx] = m_state;
    }
  }
}

DI void mlstm_norm_phase(const Params& p, int l) {
  const int tid = get_tid(), lane = tid & 63, w = tid >> 6;
  const bf16_t* HB = (const bf16_t*)(p.ws + WS_HB);
  bf16_t* Z = (bf16_t*)(p.ws + WS_Z);
  const float* g = p.ml_g + l * 512 + lane * 8;
  const f32x4 g0 = *(const f32x4*)g, g1 = *(const f32x4*)(g + 4);
  for (int row = blockIdx.x * 4 + w; row < TT; row += gridDim.x * 4) {
    u32x4 y = *(const u32x4*)(HB + (size_t)row * 512 + lane * 8);
    float v[8] = {bflo(y[0]), bfhi(y[0]), bflo(y[1]), bfhi(y[1]), bflo(y[2]), bfhi(y[2]), bflo(y[3]), bfhi(y[3])};
    float ss = 0.f;
#pragma unroll
    for (int e = 0; e < 8; ++e) ss += v[e] * v[e];
#pragma unroll
    for (int o = 8; o >= 1; o >>= 1) ss += shfl_xor_(ss, o, lane);
    const float rstd = rsqrtf(ss * (1.f / 128.f) + 1e-6f);
    *(u32x4*)(Z + (size_t)row * ZW + MQ + lane * 8) =
        u32x4{pk2(v[0] * rstd * g0[0], v[1] * rstd * g0[1]), pk2(v[2] * rstd * g0[2], v[3] * rstd * g0[3]),
              pk2(v[4] * rstd * g1[0], v[5] * rstd * g1[1]), pk2(v[6] * rstd * g1[2], v[7] * rstd * g1[3])};
  }
}

constexpr int MIX_ITEMS = 4224;
DI void phase_mixers(const Params& p, int l, char* smem) {
  __shared__ int s_item;
  const int tid = get_tid();
  int* cnt = (int*)(p.ws + WS_CNT) + l;
  auto draw = [&]() -> int {
    __syncthreads();
    if (tid == 0) s_item = atomicAdd(cnt, 1);
    __syncthreads();
    return __builtin_amdgcn_readfirstlane(s_item);
  };
  int item = draw();
  while (item < 384) {
    const bool lat = item < 128;
    const int j = lat ? item : item - 128;
    int* prog = (int*)(p.ws + WS_CNT) + 16 + l * 384;
    mlstm_item(p, smem, l, j >> 4, (j >> 2) & 3, (j >> 1) & 1, j & 1, lat, prog + item, prog + (item ^ 1));
    item = draw();
  }
#ifndef NO_ATTN
  const int w = __builtin_amdgcn_readfirstlane(get_tid() >> 6);
  bf16_t* Z = (bf16_t*)(p.ws + WS_Z);
  for (; item < MIX_ITEMS; item = draw()) {
    AttnArgs a;
    a.k2 = nullptr; a.v2 = nullptr; a.blk0_2 = 0; a.nblk2 = 0; a.mode = 0; a.m0 = -INFINITY; a.l0 = 0.f; a.rpb = nullptr; a.qpos0 = 0;
    a.nblk1 = 4;
    if (item < 1408) {
      int j = item - 384, qt = j & 63, kv = (j >> 6) & 1, b = j >> 7;
      const float* cb = p.cache_gqa + (size_t)((b * 2 + l) * 2) * 256 * 128 + kv * 64;
      a.k1 = cb; a.v1 = cb + 256 * 128; a.stride1 = 128; a.f32_1 = 1;
      bf16_t* zb = Z + (size_t)(TC + b * 4096) * ZW;
      a.k2 = zb + GK + kv * 64; a.v2 = zb + GV + kv * 64; a.blk0_2 = 0; a.nblk2 = 64;
      a.qo = zb + (size_t)(qt * 64) * ZW + GQ + (kv * 4 + w) * 64;
      attn_item<2>(a, smem);
      continue;
    } else if (item < 2432) {
      int j = item - 1408, qt = j & 63, kv = (j >> 6) & 1, b = j >> 7;
      const float* cb = p.cache_swa + (size_t)((b * 2 + l) * 2) * 256 * 128 + kv * 64;
      a.k1 = cb; a.v1 = cb + 256 * 128; a.stride1 = 128; a.f32_1 = 1;
      bf16_t* zb = Z + (size_t)(TC + b * 4096) * ZW;
      a.k2 = zb + SK + kv * 64; a.v2 = zb + SV + kv * 64;
      const int q0 = qt * 64;
      int lo = q0 - 128; lo = lo < 0 ? 0 : lo;
      int hi = q0 + 63 + 128; hi = hi > 4095 ? 4095 : hi;
      a.blk0_2 = lo >> 6; a.nblk2 = (hi >> 6) - (lo >> 6) + 1;
      a.qo = zb + (size_t)q0 * ZW + SQ + (kv * 4 + w) * 64;
      a.qpos0 = q0; a.mode = 1;
      a.m0 = p.swa_sink[l * 8 + kv * 4 + w] * LOG2E; a.l0 = 1.f;
      attn_item<2>(a, smem);
      continue;
    } else if (item < 3456) {
      int j = item - 2432, rq = j & 15, h = (j >> 4) & 7, b = j >> 7;
      const float* cb = p.cache_na + (size_t)((b * 2 + l) * 2) * 256 * 512 + h * 64;
      a.k1 = cb; a.v1 = cb + 256 * 512; a.stride1 = 512; a.f32_1 = 1;
      bf16_t* zb = Z + (size_t)(TC + b * 4096) * ZW;
      a.k2 = zb + NAK + h * 64; a.v2 = zb + NAV + h * 64;
      int r0 = 4 * rq, r1 = r0 + 3;
      int rs0 = r0 - 4; rs0 = rs0 < 0 ? 0 : (rs0 > 56 ? 56 : rs0);
      int rs1 = r1 - 4; rs1 = rs1 < 0 ? 0 : (rs1 > 56 ? 56 : rs1);
      a.blk0_2 = rs0; a.nblk2 = rs1 + 8 - rs0;
      const int q0 = (r0 + w) * 64;
      a.qo = zb + (size_t)q0 * ZW + NAQ + h * 64;
      a.qpos0 = q0; a.mode = 2; a.rpb = p.na_rpb + (size_t)(l * 8 + h) * 465;
      attn_item<2>(a, smem);
      continue;
    } else if (item < 3712) {
      int j = item - 3456, qtile = j & 1, h = (j >> 1) & 7, b = j >> 4;
      bf16_t* zb = Z + (size_t)(b * 256) * ZW;
      a.k1 = zb + NAK + h * 64; a.v1 = zb + NAV + h * 64; a.stride1 = ZW; a.f32_1 = 0;
      a.qo = zb + (size_t)(qtile * 128 + 32 * w) * ZW + NAQ + h * 64;
    } else if (item < 3968) {
      int j = item - 3712, qt = j & 7, kv = (j >> 3) & 1, b = j >> 4;
      bf16_t* zb = Z + (size_t)(b * 256) * ZW;
      a.k1 = zb + GK + kv * 64; a.v1 = zb + GV + kv * 64; a.stride1 = ZW; a.f32_1 = 0;
      a.qo = zb + (size_t)(qt * 32) * ZW + GQ + (kv * 4 + w) * 64;
    } else {
      int j = item - 3968, qt = j & 7, kv = (j >> 3) & 1, b = j >> 4;
      bf16_t* zb = Z + (size_t)(b * 256) * ZW;
      a.k1 = zb + SK + kv * 64; a.v1 = zb + SV + kv * 64; a.stride1 = ZW; a.f32_1 = 0;
      a.qo = zb + (size_t)(qt * 32) * ZW + SQ + (kv * 4 + w) * 64;
      a.m0 = p.swa_sink[l * 8 + kv * 4 + w] * LOG2E; a.l0 = 1.f;
    }
    attn_item<1>(a, smem);
  }
#endif
}

#define XB_TMO      128
#define XB_XCNT(j)  (256  + 64 * (j))
#define XB_XSUB(j)  (1280 + 64 * (j))
#define XB_XGEN(j)  (2304 + 64 * (j))
#define XB_TOP      3328
#define XB_TOPGEN   3392
#define XCD_BAR_WORDS 3456
#define XB_SPIN_CAP (1u << 18)
#define LAS __attribute__((address_space(3)))
DI unsigned xb_ld(unsigned* p) { return __hip_atomic_load(p, __ATOMIC_RELAXED, __HIP_MEMORY_SCOPE_AGENT); }
DI unsigned xb_add(unsigned* p, unsigned v) { return __hip_atomic_fetch_add(p, v, __ATOMIC_RELAXED, __HIP_MEMORY_SCOPE_AGENT); }
DI unsigned xb_xcc_id() { return (unsigned)__builtin_amdgcn_s_getreg((3 << 11) | 20) & 0xFu; }
#define XB_SPIN(cond, bar) do { unsigned _sp = 0; while (cond) { __builtin_amdgcn_s_sleep(1); \
    if ((++_sp & 255u) == 0u) { if (xb_ld(&(bar)[XB_TMO])) break; if (_sp > XB_SPIN_CAP) { atomicAdd(&(bar)[XB_TMO], 1u); break; } } } } while (0)
struct XcdBarrier { unsigned* bar; unsigned x; volatile LAS unsigned* st; };
DI XcdBarrier xcd_barrier_post(unsigned* bar, volatile LAS unsigned* st) {
  XcdBarrier b; b.bar = bar; b.x = xb_xcc_id(); b.st = st;
  if (threadIdx.x == 0) (void)xb_add(&bar[XB_XCNT(b.x)], 1u);
  return b;
}
DI void xcd_barrier_complete(unsigned* bar, unsigned x, unsigned& nloc, unsigned& nx) {
  const unsigned G = gridDim.x * gridDim.y * gridDim.z;
  unsigned sum, cnt, mine, sp = 0u;
  for (;;) {
    sum = 0u; cnt = 0u; mine = 0u;
#pragma unroll
    for (unsigned j = 0; j < 16; ++j) { const unsigned c = xb_ld(&bar[XB_XCNT(j)]); sum += c; cnt += (c > 0u) ? 1u : 0u; mine = (j == x) ? c : mine; }
    if (sum == G) break;
    __builtin_amdgcn_s_sleep(1);
    if ((++sp & 255u) == 0u) { if (xb_ld(&bar[XB_TMO])) break; if (sp > XB_SPIN_CAP) { atomicAdd(&bar[XB_TMO], 1u); break; } }
  }
  nloc = mine > 0u ? mine : 1u; nx = cnt > 0u ? cnt : 1u;
}
DI void xcd_barrier(const XcdBarrier& b) {
  asm volatile("s_waitcnt vmcnt(0)" ::: "memory");
  __syncthreads();
  if (threadIdx.x == 0) {
    unsigned* bar = b.bar;
    __builtin_amdgcn_s_waitcnt(0);
    unsigned nloc = b.st[0], nx = b.st[1];
    if (nloc == 0u) { xcd_barrier_complete(bar, b.x, nloc, nx); b.st[0] = nloc; b.st[1] = nx; }
    const unsigned old = xb_add(&bar[XB_XSUB(b.x)], 1u);
    const unsigned gen = old / nloc;
    if (old + 1u == (gen + 1u) * nloc) {
      __builtin_amdgcn_fence(__ATOMIC_RELEASE, "agent");
      asm volatile("s_waitcnt vmcnt(0)" ::: "memory");
      const unsigned og = xb_add(&bar[XB_TOP], 1u);
      const unsigned tg = og / nx;
      if (og + 1u == (tg + 1u) * nx) xb_add(&bar[XB_TOPGEN], 1u);
      else XB_SPIN(xb_ld(&bar[XB_TOPGEN]) == tg, bar);
      __builtin_amdgcn_fence(__ATOMIC_ACQUIRE, "agent");
      xb_add(&bar[XB_XGEN(b.x)], 1u);
      asm volatile("s_waitcnt vmcnt(0)" ::: "memory");
    } else {
      XB_SPIN(xb_ld(&bar[XB_XGEN(b.x)]) == gen, bar);
      __builtin_amdgcn_fence(__ATOMIC_ACQUIRE, "agent");
      asm volatile("s_waitcnt vmcnt(0)" ::: "memory");
    }
  }
  __syncthreads();
}

constexpr int N_PHASES = 20;
DI void run_phase(const Params& p, int ph, char* smem) {
  if (ph == 0) { phase0(p, smem); return; }
  if (ph == 19) { norm_phase(p, 0, 2); return; }
  const int l = (ph - 1) / 9, s = (ph - 1) % 9;
  switch (s) {
    case 0: convert_weights(p, l, smem); norm_phase(p, l, 0); break;
    case 1: phase_inproj(p, l, smem); break;
    case 2: phase_mixers(p, l, smem); break;
    case 3: mlstm_norm_phase(p, l); break;
    case 4: phase_merge(p, l, smem); break;
    case 5: phase_resid(p, l, 0, smem); break;
    case 6: norm_phase(p, l, 1); break;
    case 7: phase_ffn1(p, l, smem); break;
    default: phase_resid(p, l, 1, smem); break;
  }
}

#ifndef MK_TEST
template <bool COOP>
__global__ void __launch_bounds__(256, 2) hybrid_fwd(Params p, int ph_lo, int ph_hi) {
  extern __shared__ __attribute__((aligned(16))) char smem[];
  __shared__ uint4 xb_words;
  if (COOP) {
    if (threadIdx.x == 0) xb_words = make_uint4(0u, 0u, 0u, 0u);
    __syncthreads();
    run_phase(p, 0, smem);
    cg::this_grid().sync();
    XcdBarrier xb = xcd_barrier_post((unsigned*)(p.ws + WS_BAR), (volatile LAS unsigned*)&xb_words);
    for (int ph = 1; ph < ph_hi; ++ph) {
      run_phase(p, ph, smem);
#ifdef PROBE_DUP
      if (ph >= 1 && ph <= 18 && ((PROBE_DUP >> ((ph - 1) % 9)) & 1)) run_phase(p, ph, smem);
#endif
      if (ph + 1 < ph_hi) xcd_barrier(xb);
    }
  } else {
    for (int ph = ph_lo; ph < ph_hi; ++ph) run_phase(p, ph, smem);
  }
}

extern "C" void kernel_launch(void* const* d_in, const int* in_sizes, int n_in, void* d_out, int out_size, void* d_ws, size_t ws_size, hipStream_t stream) {
  static int grid = 0;
  if (grid == 0) {
    if (n_in != 26 || ws_size < WS_END) { fprintf(stderr, "kernel_launch: bad n_in %d or ws_size %zu (need %zu)\n", n_in, ws_size, (size_t)WS_END); grid = -1; return; }
    int dev = 0, cus = 0, per_cu = 0;
    hipGetDevice(&dev);
    hipDeviceGetAttribute(&cus, hipDeviceAttributeMultiprocessorCount, dev);
    hipFuncSetAttribute((const void*)hybrid_fwd<true>, hipFuncAttributeMaxDynamicSharedMemorySize, SMEM_BYTES);
    hipFuncSetAttribute((const void*)hybrid_fwd<false>, hipFuncAttributeMaxDynamicSharedMemorySize, SMEM_BYTES);
    hipOccupancyMaxActiveBlocksPerMultiprocessor(&per_cu, (const void*)hybrid_fwd<true>, 256, SMEM_BYTES);
    if (per_cu < 1) per_cu = 1;
    if (per_cu > 2) per_cu = 2;
    grid = cus * per_cu;
  }
  if (grid < 0) return;
  Params p{};
  const float** pp = (const float**)&p;
  for (int i = 0; i < 26; ++i) pp[i] = (const float*)d_in[i];
  p.out = (float*)d_out;
  p.ws = (char*)d_ws;
#if MK_COOP
  int lo = 0, hi = N_PHASES;
  void* args[] = {&p, &lo, &hi};
  hipError_t e = hipLaunchCooperativeKernel((const void*)hybrid_fwd<true>, dim3(grid), dim3(256), args, SMEM_BYTES, stream);
  if (e != hipSuccess) fprintf(stderr, "cooperative launch failed: %s (grid %d)\n", hipGetErrorString(e), grid);
#else
  for (int ph = 0; ph < N_PHASES; ++ph) hybrid_fwd<false><<<grid, 256, SMEM_BYTES, stream>>>(p, ph, ph + 1);
#endif
}
#endif
```
